# Optimizing an MI355X kernel written in HIP

```python
import math
import jax, jax.numpy as jnp
from jax import lax
import numpy as np

D_MODEL = 1024
BATCH = 16
SEQ = 2048
DEPTH = 1

HEAD_DIM = 64
N_HEADS = D_MODEL // HEAD_DIM
DSA_HEADS = N_HEADS // 2
NSA_HEADS = N_HEADS - DSA_HEADS
DSA_WIDTH = DSA_HEADS * HEAD_DIM
NSA_WIDTH = NSA_HEADS * HEAD_DIM
ROPE_THETA = 500000.0
IDX_HEADS = 8
IDX_DIM = 32
IDX_TOPK = 256
Q_BLOCK = 128
NSA_KV_GROUPS = 2
NSA_GROUP_SIZE = NSA_HEADS // NSA_KV_GROUPS
KV_WIDTH = NSA_KV_GROUPS * HEAD_DIM
CMP_BLOCK = 32
CMP_STRIDE = 16
CMP_HIDDEN = 2 * HEAD_DIM
SLC_BLOCK = 64
SLC_COUNT = 8
WINDOW = 512
NSA_Q_BLOCK = 32
FORCE_SCORE = 1.0e4
FFN_HIDDEN = -(-8 * D_MODEL // (3 * 256)) * 256
ALPHA = (2.0 * DEPTH) ** 0.25
BETA = (8.0 * DEPTH) ** -0.25
LN_EPS = 1e-5
IN_SPLITS = (DSA_WIDTH, HEAD_DIM, HEAD_DIM, IDX_HEADS * IDX_DIM, IDX_HEADS, IDX_DIM,
             NSA_WIDTH, KV_WIDTH, KV_WIDTH, KV_WIDTH, KV_WIDTH, KV_WIDTH, KV_WIDTH, 3 * NSA_HEADS)
IN_IS_VALUE = (False, False, True, False, False, False,
               False, False, True, False, True, False, True, False)
IN_COLS = sum(IN_SPLITS)

kernel_name = "hymba_dsa_nsa_deepnorm_layer"


def split_columns(p):
    outs, start = [], 0
    for n in IN_SPLITS:
        outs.append(p[..., start:start + n])
        start += n
    return outs


def rope_partial(x, positions):
    rot = x.shape[-1] // 4
    half = rot // 2
    inv_freq = jnp.power(ROPE_THETA, -jnp.arange(half, dtype=jnp.float32) / half)
    ang = positions.astype(jnp.float32)[:, :, None, None] * inv_freq
    cos = jnp.cos(ang).astype(x.dtype)
    sin = jnp.sin(ang).astype(x.dtype)
    x1, x2 = x[..., :half], x[..., half:rot]
    return jnp.concatenate([x1 * cos - x2 * sin, x2 * cos + x1 * sin, x[..., rot:]], axis=-1)


def masked_softmax(s, mask):
    s = jnp.where(mask, s.astype(jnp.float32), -jnp.inf)
    m = jnp.max(s, axis=-1, keepdims=True)
    m = jnp.where(jnp.isfinite(m), m, 0.0)
    p = jnp.exp(s - m)
    return p / jnp.maximum(jnp.sum(p, axis=-1, keepdims=True), 1e-30)


def layer_norm(x, g, b):
    xf = x.astype(jnp.float32)
    mu = jnp.mean(xf, axis=-1, keepdims=True)
    var = jnp.mean(jnp.square(xf - mu), axis=-1, keepdims=True)
    return ((xf - mu) * lax.rsqrt(var + LN_EPS)).astype(x.dtype) * g + b


def group_rms(o):
    of = o.astype(jnp.float32)
    return (of * lax.rsqrt(jnp.mean(of * of, axis=-1, keepdims=True) + LN_EPS)).astype(o.dtype)


def dsa_mixer(q, k, v, iq, iw, ik):
    B, S, H, dh = q.shape
    topk = min(IDX_TOPK, S // 4)
    nblk = S // Q_BLOCK
    key_pos = jnp.arange(S)
    scale = HEAD_DIM ** -0.5
    idx_scale = (IDX_HEADS ** -0.5) * (IDX_DIM ** -0.5)

    def block(i):
        s0 = i * Q_BLOCK
        qb = lax.dynamic_slice_in_dim(q, s0, Q_BLOCK, axis=1)
        iqb = lax.dynamic_slice_in_dim(iq, s0, Q_BLOCK, axis=1)
        iwb = lax.dynamic_slice_in_dim(iw, s0, Q_BLOCK, axis=1)
        qpos = s0 + jnp.arange(Q_BLOCK)
        causal = key_pos[None, :] <= qpos[:, None]
        logits = jnp.einsum('bqhd,bsd->bqhs', iqb, ik)
        index = jnp.einsum('bqh,bqhs->bqs', iwb, jax.nn.relu(logits)) * idx_scale
        index = jnp.where(causal[None], index.astype(jnp.float32), -jnp.inf)
        _, sel = lax.top_k(index, topk)
        kg = jax.vmap(lambda kb, ib: kb[ib])(k, sel)
        vg = jax.vmap(lambda vb, ib: vb[ib])(v, sel)
        valid = (sel <= qpos[None, :, None])[:, :, None, :]
        s = jnp.einsum('bqhd,bqkd->bqhk', qb, kg) * scale
        p = masked_softmax(s, valid)
        return jnp.einsum('bqhk,bqkd->bqhd', p.astype(vg.dtype), vg)

    out = lax.map(block, jnp.arange(nblk))
    return out.transpose(1, 0, 2, 3, 4).reshape(B, S, H * dh)


def compress(kv, pos_emb, w1, w2):
    B, S, G, dh = kv.shape
    n_c = (S - CMP_BLOCK) // CMP_STRIDE + 1
    idx = jnp.arange(n_c)[:, None] * CMP_STRIDE + jnp.arange(CMP_BLOCK)[None, :]
    blocks = kv[:, idx] + pos_emb[None, None, :, None, :]
    flat = blocks.transpose(0, 1, 3, 2, 4).reshape(B, n_c, G, CMP_BLOCK * dh)
    return jax.nn.gelu(flat @ w1) @ w2


def nsa_mixer(q, k_cmp, v_cmp, k_slc, v_slc, k_win, v_win, gates, cmp_pos, cmp_w1, cmp_w2):
    B, S, H, dh = q.shape
    G, R = NSA_KV_GROUPS, NSA_GROUP_SIZE
    q = q.reshape(B, S, G, R, dh)
    scale = HEAD_DIM ** -0.5
    kc = compress(k_cmp, cmp_pos[0], cmp_w1[0], cmp_w2[0])
    vc = compress(v_cmp, cmp_pos[1], cmp_w1[1], cmp_w2[1])
    n_c = kc.shape[1]
    cmp_start = jnp.arange(n_c) * CMP_STRIDE
    cmp_end = cmp_start + CMP_BLOCK - 1
    n_s = S // SLC_BLOCK
    n_sel = min(SLC_COUNT, n_s)
    slc_start = jnp.arange(n_s) * SLC_BLOCK
    overlap = ((cmp_start[:, None] < slc_start[None, :] + SLC_BLOCK)
               & (cmp_end[:, None] >= slc_start[None, :])).astype(jnp.float32)
    ks_blocks = k_slc.reshape(B, n_s, SLC_BLOCK, G, dh).transpose(0, 3, 1, 2, 4)
    vs_blocks = v_slc.reshape(B, n_s, SLC_BLOCK, G, dh).transpose(0, 3, 1, 2, 4)
    pad = ((0, 0), (WINDOW, 0), (0, 0), (0, 0))
    kw_pad = jnp.pad(k_win, pad)
    vw_pad = jnp.pad(v_win, pad)
    nblk = S // NSA_Q_BLOCK
    QB = NSA_Q_BLOCK
    j = jnp.arange(n_s)

    def block(i):
        s0 = i * QB
        qb = lax.dynamic_slice_in_dim(q, s0, QB, axis=1)
        gb = lax.dynamic_slice_in_dim(gates, s0, QB, axis=1)
        qpos = s0 + jnp.arange(QB)
        s_c = jnp.einsum('bqgrd,bcgd->bgrqc', qb, kc) * scale
        p_c = masked_softmax(s_c, cmp_end[None, :] <= qpos[:, None])
        o_c = jnp.einsum('bgrqc,bcgd->bqgrd', p_c.astype(vc.dtype), vc)
        imp = jnp.einsum('bgrqc,cj->bgqj', p_c, overlap)
        cur = qpos // SLC_BLOCK
        forced = (j[None] == 0) | (j[None] == cur[:, None]) | (j[None] == cur[:, None] - 1)
        visible = slc_start[None, :] <= qpos[:, None]
        imp = jnp.where(forced[None, None], FORCE_SCORE, imp)
        imp = jnp.where(visible[None, None], imp, -1.0)
        _, sel = lax.top_k(imp, n_sel)
        gather = jax.vmap(jax.vmap(lambda kb, ib: kb[ib]))
        ksel = gather(ks_blocks, sel).reshape(B, G, QB, n_sel * SLC_BLOCK, dh)
        vsel = gather(vs_blocks, sel).reshape(B, G, QB, n_sel * SLC_BLOCK, dh)
        tok = (sel[..., None] * SLC_BLOCK + jnp.arange(SLC_BLOCK)).reshape(B, G, QB, n_sel * SLC_BLOCK)
        smask = (tok <= qpos[None, None, :, None])[:, :, None]
        s_s = jnp.einsum('bqgrd,bgqkd->bgrqk', qb, ksel) * scale
        p_s = masked_softmax(s_s, smask)
        o_s = jnp.einsum('bgrqk,bgqkd->bqgrd', p_s.astype(vsel.dtype), vsel)
        kw = lax.dynamic_slice_in_dim(kw_pad, s0, WINDOW + QB, axis=1)
        vw = lax.dynamic_slice_in_dim(vw_pad, s0, WINDOW + QB, axis=1)
        wpos = s0 - WINDOW + jnp.arange(WINDOW + QB)
        diff = qpos[:, None] - wpos[None, :]
        wmask = (diff >= 0) & (diff < WINDOW) & (wpos[None, :] >= 0)
        s_w = jnp.einsum('bqgrd,bkgd->bgrqk', qb, kw) * scale
        p_w = masked_softmax(s_w, wmask)
        o_w = jnp.einsum('bgrqk,bkgd->bqgrd', p_w.astype(vw.dtype), vw)
        return gb[..., 0:1] * o_c + gb[..., 1:2] * o_s + gb[..., 2:3] * o_w

    out = lax.map(block, jnp.arange(nblk))
    return out.transpose(1, 0, 2, 3, 4, 5).reshape(B, S, H * dh)


def hybrid_layer(x, positions, w_in, b_in, cmp_pos, cmp_w1, cmp_w2, mix_gain, w_out,
                 ln1_g, ln1_b, w_gate, w_up, w_down, ln2_g, ln2_b):
    B, S, _ = x.shape
    G = NSA_KV_GROUPS
    (dq, dk, dv, iq, iw, ik, nq, kcm, vcm, ksl, vsl, kwn, vwn, ng) = split_columns(x @ w_in + b_in)
    dq = rope_partial(dq.reshape(B, S, DSA_HEADS, HEAD_DIM), positions)
    dk = rope_partial(dk.reshape(B, S, 1, HEAD_DIM), positions)[:, :, 0]
    iq = rope_partial(iq.reshape(B, S, IDX_HEADS, IDX_DIM), positions)
    ik = rope_partial(ik.reshape(B, S, 1, IDX_DIM), positions)[:, :, 0]
    o_dsa = dsa_mixer(dq, dk, dv, iq, iw, ik)
    nq = rope_partial(nq.reshape(B, S, NSA_HEADS, HEAD_DIM), positions)
    heads = lambda t: t.reshape(B, S, G, HEAD_DIM)
    kcm = rope_partial(heads(kcm), positions)
    ksl = rope_partial(heads(ksl), positions)
    kwn = rope_partial(heads(kwn), positions)
    gates = jax.nn.sigmoid(ng).reshape(B, S, G, NSA_GROUP_SIZE, 3)
    o_nsa = nsa_mixer(nq, kcm, heads(vcm), ksl, heads(vsl), kwn, heads(vwn), gates,
                      cmp_pos, cmp_w1, cmp_w2)
    mixed = jnp.concatenate([group_rms(o_dsa), group_rms(o_nsa)], axis=-1) * mix_gain
    h = layer_norm(ALPHA * x + mixed @ w_out, ln1_g, ln1_b)
    ffn = (jax.nn.silu(h @ w_gate) * (h @ w_up)) @ w_down
    return layer_norm(ALPHA * h + ffn, ln2_g, ln2_b)


def setup_inputs(seed: int = 0) -> dict:
    key = jax.random.key(seed)
    ks = jax.random.split(key, 16)

    def nrm(k, shape, scale):
        return jax.random.normal(k, shape, jnp.float32) * scale

    x = nrm(ks[0], (BATCH, SEQ, D_MODEL), 1.0)
    offset = jax.random.randint(ks[1], (BATCH, 1), 0, 4096, dtype=jnp.int32)
    positions = offset + jnp.arange(SEQ, dtype=jnp.int32)[None, :]
    in_keys = jax.random.split(ks[2], len(IN_SPLITS))
    w_in = jnp.concatenate(
        [nrm(k, (DEPTH, D_MODEL, n), D_MODEL ** -0.5 * (BETA if is_v else 1.0))
         for k, n, is_v in zip(in_keys, IN_SPLITS, IN_IS_VALUE)], axis=-1)
    b_in = nrm(ks[3], (DEPTH, IN_COLS), 0.01)
    cmp_pos = nrm(ks[4], (DEPTH, 2, CMP_BLOCK, HEAD_DIM), 0.02)
    cmp_w1 = nrm(ks[5], (DEPTH, 2, CMP_BLOCK * HEAD_DIM, CMP_HIDDEN), (CMP_BLOCK * HEAD_DIM) ** -0.5)
    cmp_w2 = nrm(ks[6], (DEPTH, 2, CMP_HIDDEN, HEAD_DIM), CMP_HIDDEN ** -0.5)
    mix_gain = 1.0 + nrm(ks[7], (DEPTH, D_MODEL), 0.02)
    w_out = nrm(ks[8], (DEPTH, D_MODEL, D_MODEL), D_MODEL ** -0.5 * BETA)
    ln1_g = 1.0 + nrm(ks[9], (DEPTH, D_MODEL), 0.02)
    ln1_b = nrm(ks[10], (DEPTH, D_MODEL), 0.01)
    w_gate = nrm(ks[11], (DEPTH, D_MODEL, FFN_HIDDEN), D_MODEL ** -0.5)
    w_up = nrm(ks[12], (DEPTH, D_MODEL, FFN_HIDDEN), D_MODEL ** -0.5)
    w_down = nrm(ks[13], (DEPTH, FFN_HIDDEN, D_MODEL), FFN_HIDDEN ** -0.5 * BETA)
    ln2_g = 1.0 + nrm(ks[14], (DEPTH, D_MODEL), 0.02)
    ln2_b = nrm(ks[15], (DEPTH, D_MODEL), 0.01)
    return {"x": x, "positions": positions, "w_in": w_in, "b_in": b_in,
            "cmp_pos": cmp_pos, "cmp_w1": cmp_w1, "cmp_w2": cmp_w2, "mix_gain": mix_gain,
            "w_out": w_out, "ln1_g": ln1_g, "ln1_b": ln1_b, "w_gate": w_gate, "w_up": w_up,
            "w_down": w_down, "ln2_g": ln2_g, "ln2_b": ln2_b}


def reference(x, positions, w_in, b_in, cmp_pos, cmp_w1, cmp_w2, mix_gain, w_out,
              ln1_g, ln1_b, w_gate, w_up, w_down, ln2_g, ln2_b):
    for l in range(DEPTH):
        x = hybrid_layer(x, positions, w_in[l], b_in[l], cmp_pos[l], cmp_w1[l], cmp_w2[l],
                         mix_gain[l], w_out[l], ln1_g[l], ln1_b[l], w_gate[l], w_up[l],
                         w_down[l], ln2_g[l], ln2_b[l])
    return x
```

```cpp
#include <hip/hip_runtime.h>
#include <cstdio>
#include <cstdint>
#include <cmath>

typedef unsigned short bf16_t;

constexpr int D_MODEL = 1024, BATCH = 16, SEQ = 2048, T = BATCH * SEQ;
constexpr int HEAD_DIM = 64, DSA_HEADS = 8, NSA_HEADS = 8;
constexpr int IDX_HEADS = 8, IDX_DIM = 32, IDX_TOPK = 256;
constexpr int NSA_G = 2, NSA_R = 4;
constexpr int CMP_BLOCK = 32, CMP_STRIDE = 16, CMP_HIDDEN = 128, N_C = (SEQ - CMP_BLOCK) / CMP_STRIDE + 1;
constexpr int SLC_BLOCK = 64, SLC_COUNT = 8, N_S = SEQ / SLC_BLOCK, WINDOW = 512;
constexpr int FFN = 2816;
constexpr int IN_COLS = 2240, ACT_COLS = 2304;
constexpr float ALPHA = 1.189207115002721f;
constexpr float LN_EPS = 1e-5f;
constexpr float ATT_SCALE = 0.125f;
constexpr float IDX_SCALE = 0.0625f;

constexpr int C_DQ = 0, C_DK = 512, C_DV = 576, C_IQ = 640, C_NQ = 896, C_KCM = 1408, C_VCM = 1536, C_KSL = 1664, C_VSL = 1792,
              C_KWN = 1920, C_VWN = 2048, C_IK = 2176, C_IW = 2208, C_NG = 2216;

constexpr size_t MiB = 1u << 20;
constexpr size_t WS_ROPE = 1 * MiB;
constexpr size_t WS_KC = 30 * MiB;
constexpr size_t WS_ACT = 48 * MiB;
constexpr size_t WS_ACTF = 48 * MiB;
constexpr size_t WS_P = 232 * MiB;
constexpr size_t WS_MIXED = 256 * MiB;
constexpr size_t WS_HB = 320 * MiB;
constexpr size_t WS_NEED = 512 * MiB;

__device__ __forceinline__ float bf2f(bf16_t v) { return __uint_as_float(((unsigned)v) << 16); }
__device__ __forceinline__ bf16_t f2bf(float f) { unsigned u = __float_as_uint(f); return (bf16_t)((u + 0x7fffu + ((u >> 16) & 1u)) >> 16); }
__device__ __forceinline__ float bfr(float f) { return bf2f(f2bf(f)); }

__global__ void k_rope_table(const int* __restrict__ pos, float* __restrict__ tab) {
    int i = blockIdx.x * blockDim.x + threadIdx.x;
    if (i >= T * 8) return;
    int t = i >> 3, j = i & 7;
    double inv = pow(500000.0, -(double)j / 8.0);
    double ang = (double)pos[t] * inv;
    tab[2 * i] = (float)cos(ang); tab[2 * i + 1] = (float)sin(ang);
}

template <class LA, class LB, class EP>
__global__ void __launch_bounds__(256) k_gemm(int M, int N, int K, int pad0, LA la, LB lb, EP ep) {
    __shared__ float As[16][68], Bs[16][68];
    const int tid = threadIdx.x, tx = tid & 15, ty = tid >> 4;
    const int m0 = blockIdx.y * 64, n0 = blockIdx.x * 64;
    float acc[4][4];
#pragma unroll
    for (int i = 0; i < 4; ++i)
#pragma unroll
        for (int j = 0; j < 4; ++j) acc[i][j] = 0.f;
    for (int k0 = 0; k0 < K; k0 += 16) {
#pragma unroll
        for (int i = 0; i < 4; ++i) {
            int e = tid + i * 256;
            int am = e >> 4, ak = e & 15;
            As[ak][am] = (m0 + am < M) ? la(m0 + am, k0 + ak) : 0.f;
            int bk = e >> 6, bn = e & 63;
            Bs[bk][bn] = (n0 + bn < N) ? lb(k0 + bk, n0 + bn) : 0.f;
        }
        __syncthreads();
#pragma unroll
        for (int kk = 0; kk < 16; ++kk) {
            float a[4], b[4];
#pragma unroll
            for (int i = 0; i < 4; ++i) { a[i] = As[kk][ty * 4 + i]; b[i] = Bs[kk][tx * 4 + i]; }
#pragma unroll
            for (int i = 0; i < 4; ++i)
#pragma unroll
                for (int j = 0; j < 4; ++j) acc[i][j] = fmaf(a[i], b[j], acc[i][j]);
        }
        __syncthreads();
    }
#pragma unroll
    for (int i = 0; i < 4; ++i) {
        int m = m0 + ty * 4 + i; if (m >= M) continue;
        ep(m, n0 + tx * 4, acc[i], N);
    }
}

struct LoadF32R { const float* p; int ld; int pad; __device__ float operator()(int r, int c) const { return bfr(p[(size_t)r * ld + c]); } };
struct LoadBf16 { const bf16_t* p; int ld; int pad; __device__ float operator()(int r, int c) const { return bf2f(p[(size_t)r * ld + c]); } };
struct LoadGU { const float* wg; const float* wu; __device__ float operator()(int k, int n) const { return bfr((n & 1) ? wu[(size_t)k * FFN + (n >> 1)] : wg[(size_t)k * FFN + (n >> 1)]); } };

struct EpStoreF32 { float* o; int ld; int pad; __device__ void operator()(int m, int n, const float* acc, int N) const {
#pragma unroll
    for (int j = 0; j < 4; ++j) if (n + j < N) o[(size_t)m * ld + n + j] = acc[j]; } };
struct EpOutProj { const float* x; float* v1; __device__ void operator()(int m, int n, const float* acc, int N) const {
#pragma unroll
    for (int j = 0; j < 4; ++j) v1[(size_t)m * D_MODEL + n + j] = ALPHA * x[(size_t)m * D_MODEL + n + j] + acc[j]; } };
struct EpGU { bf16_t* act; __device__ void operator()(int m, int n, const float* acc, int N) const {
#pragma unroll
    for (int j = 0; j < 4; j += 2) { float g = acc[j], u = acc[j + 1]; float s = g / (1.f + expf(-g)); act[(size_t)m * FFN + ((n + j) >> 1)] = f2bf(s * u); } } };
struct EpDown { float* io; __device__ void operator()(int m, int n, const float* acc, int N) const {
#pragma unroll
    for (int j = 0; j < 4; ++j) { size_t i = (size_t)m * D_MODEL + n + j; io[i] = ALPHA * io[i] + acc[j]; } } };

__device__ __forceinline__ int orig_col(int pc) {
    if (pc < 896) return pc;
    if (pc < 1408) return 936 + (pc - 896);
    if (pc < 2176) return 1448 + (pc - 1408);
    if (pc < 2208) return 904 + (pc - 2176);
    if (pc < 2216) return 896 + (pc - 2208);
    return pc;
}
__global__ void k_post(const float* __restrict__ P, const float* __restrict__ b_in, const float* __restrict__ rope, bf16_t* __restrict__ act) {
    size_t i = (size_t)blockIdx.x * blockDim.x + threadIdx.x;
    if (i >= (size_t)T * ACT_COLS) return;
    int t = (int)(i / ACT_COLS), pc = (int)(i % ACT_COLS);
    float out = 0.f;
    if (pc < IN_COLS) {
        const float* Pr = P + (size_t)t * IN_COLS;
        int oc = orig_col(pc);
        float v = Pr[oc] + b_in[oc];
        bool r64 = (pc < 576) || (pc >= C_NQ && pc < C_KCM) || (pc >= C_KCM && pc < C_VCM) || (pc >= C_KSL && pc < C_VSL) || (pc >= C_KWN && pc < C_VWN);
        bool r32 = (pc >= C_IQ && pc < C_NQ) || (pc >= C_IK && pc < C_IW);
        if (r64) {
            int d = pc & 63;
            if (d < 16) {
                int j = d & 7; float c = rope[(t * 8 + j) * 2], s = rope[(t * 8 + j) * 2 + 1];
                if (d < 8) { int oc2 = orig_col(pc + 8); float v2 = Pr[oc2] + b_in[oc2]; v = v * c - v2 * s; }
                else { int oc2 = orig_col(pc - 8); float v1 = Pr[oc2] + b_in[oc2]; v = v * c + v1 * s; }
            }
        } else if (r32) {
            int d = pc & 31;
            if (d < 8) {
                int j = d & 3; float c = rope[(t * 8 + 2 * j) * 2], s = rope[(t * 8 + 2 * j) * 2 + 1];
                if (d < 4) { int oc2 = orig_col(pc + 4); float v2 = Pr[oc2] + b_in[oc2]; v = v * c - v2 * s; }
                else { int oc2 = orig_col(pc - 4); float v1 = Pr[oc2] + b_in[oc2]; v = v * c + v1 * s; }
            }
        } else if (pc >= C_NG) {
            v = 1.f / (1.f + expf(-v));
        }
        out = v;
    }
    act[i] = f2bf(out);
}

__device__ __forceinline__ float block_max(float v, float* red) {
    int tid = threadIdx.x; red[tid] = v; __syncthreads();
    for (int s = 128; s > 0; s >>= 1) { if (tid < s) red[tid] = fmaxf(red[tid], red[tid + s]); __syncthreads(); }
    float r = red[0]; __syncthreads(); return r;
}
__device__ __forceinline__ float block_sum(float v, float* red) {
    int tid = threadIdx.x; red[tid] = v; __syncthreads();
    for (int s = 128; s > 0; s >>= 1) { if (tid < s) red[tid] += red[tid + s]; __syncthreads(); }
    float r = red[0]; __syncthreads(); return r;
}
__device__ __forceinline__ int block_sum_i(int v, int* red) {
    int tid = threadIdx.x; red[tid] = v; __syncthreads();
    for (int s = 128; s > 0; s >>= 1) { if (tid < s) red[tid] += red[tid + s]; __syncthreads(); }
    int r = red[0]; __syncthreads(); return r;
}
__device__ __forceinline__ void block_softmax(float* sc, int n, float* red) {
    int tid = threadIdx.x;
    float m = -INFINITY;
    for (int i = tid; i < n; i += 256) m = fmaxf(m, sc[i]);
    m = block_max(m, red);
    if (!(m > -INFINITY)) m = 0.f;
    float s = 0.f;
    for (int i = tid; i < n; i += 256) { float p = expf(sc[i] - m); sc[i] = p; s += p; }
    s = block_sum(s, red);
    float inv = 1.f / fmaxf(s, 1e-30f);
    for (int i = tid; i < n; i += 256) sc[i] *= inv;
    __syncthreads();
}

__device__ __forceinline__ unsigned fkey(float f) { unsigned u = __float_as_uint(f); return (u & 0x80000000u) ? ~u : (u | 0x80000000u); }

__global__ void __launch_bounds__(256) k_dsa(const bf16_t* __restrict__ act, const float* __restrict__ mix_gain, bf16_t* __restrict__ mixed) {
    __shared__ float s_idx[SEQ];
    __shared__ unsigned char s_sel[SEQ];
    __shared__ int s_list[IDX_TOPK];
    __shared__ float s_sc[8][IDX_TOPK];
    __shared__ float s_q[8][64], s_iq[8][32], s_w[8];
    __shared__ float s_red[256]; __shared__ int s_redi[256];
    __shared__ float s_o[512];
    const int tid = threadIdx.x, row = blockIdx.x, b = row / SEQ, t = row % SEQ, n = t + 1;
    const bf16_t* ar = act + (size_t)row * ACT_COLS;
    for (int i = tid; i < 512; i += 256) s_q[i >> 6][i & 63] = bf2f(ar[C_DQ + i]);
    s_iq[tid >> 5][tid & 31] = bf2f(ar[C_IQ + tid]);
    if (tid < 8) s_w[tid] = bf2f(ar[C_IW + tid]);
    __syncthreads();
    const bf16_t* ab = act + (size_t)b * SEQ * ACT_COLS;
    for (int s = tid; s < n; s += 256) {
        const bf16_t* kr = ab + (size_t)s * ACT_COLS + C_IK;
        float kk[32];
#pragma unroll
        for (int d = 0; d < 32; ++d) kk[d] = bf2f(kr[d]);
        float a = 0.f;
        for (int h = 0; h < 8; ++h) { float L = 0.f;
#pragma unroll
            for (int d = 0; d < 32; ++d) L = fmaf(s_iq[h][d], kk[d], L);
            a = fmaf(s_w[h], fmaxf(L, 0.f), a); }
        s_idx[s] = a * IDX_SCALE;
    }
    __syncthreads();
    if (n <= IDX_TOPK) { for (int s = tid; s < n; s += 256) s_sel[s] = 1; }
    else {
        unsigned lo = 0u, hi = 0xFFFFFFFFu;
        while (lo < hi) {
            unsigned mid = lo + (unsigned)(((unsigned long long)hi - lo + 1ull) >> 1);
            int c = 0; for (int s = tid; s < n; s += 256) c += (fkey(s_idx[s]) >= mid) ? 1 : 0;
            c = block_sum_i(c, s_redi);
            if (c >= IDX_TOPK) lo = mid; else hi = mid - 1u;
        }
        const unsigned Tk = lo;
        int cg = 0; for (int s = tid; s < n; s += 256) cg += (fkey(s_idx[s]) > Tk) ? 1 : 0;
        cg = block_sum_i(cg, s_redi);
        const int need_eq = IDX_TOPK - cg;
        for (int s = tid; s < n; s += 256) {
            unsigned k = fkey(s_idx[s]); unsigned char f = 0;
            if (k > Tk) f = 1;
            else if (k == Tk) { int r = 0; for (int s2 = 0; s2 < s; ++s2) r += (fkey(s_idx[s2]) == Tk) ? 1 : 0; f = (r < need_eq) ? 1 : 0; }
            s_sel[s] = f;
        }
    }
    __syncthreads();
    {
        const int per = SEQ / 256; int c = 0;
        for (int i = 0; i < per; ++i) { int s = tid * per + i; c += (s < n && s_sel[s]) ? 1 : 0; }
        s_redi[tid] = c; __syncthreads();
        int off = 0; for (int i = 0; i < tid; ++i) off += s_redi[i];
        for (int i = 0; i < per; ++i) { int s = tid * per + i; if (s < n && s_sel[s]) s_list[off++] = s; }
        __syncthreads();
    }
    const int nsel = n < IDX_TOPK ? n : IDX_TOPK;
    {
        const int j = tid;
        if (j < nsel) {
            const bf16_t* kr = ab + (size_t)s_list[j] * ACT_COLS + C_DK;
            float kk[64];
#pragma unroll
            for (int d = 0; d < 64; ++d) kk[d] = bf2f(kr[d]);
            for (int h = 0; h < 8; ++h) { float a = 0.f;
#pragma unroll
                for (int d = 0; d < 64; ++d) a = fmaf(s_q[h][d], kk[d], a);
                s_sc[h][j] = a * ATT_SCALE; }
        } else { for (int h = 0; h < 8; ++h) s_sc[h][j] = -INFINITY; }
    }
    __syncthreads();
    for (int h = 0; h < 8; ++h) block_softmax(s_sc[h], IDX_TOPK, s_red);
    {
        const int h = tid >> 5, d0 = (tid & 31) * 2; float o0 = 0.f, o1 = 0.f;
        for (int j = 0; j < nsel; ++j) { const bf16_t* vr = ab + (size_t)s_list[j] * ACT_COLS + C_DV; float p = s_sc[h][j]; o0 = fmaf(p, bf2f(vr[d0]), o0); o1 = fmaf(p, bf2f(vr[d0 + 1]), o1); }
        s_o[h * 64 + d0] = o0; s_o[h * 64 + d0 + 1] = o1;
    }
    __syncthreads();
    float ss = s_o[tid] * s_o[tid] + s_o[tid + 256] * s_o[tid + 256];
    ss = block_sum(ss, s_red);
    const float rinv = rsqrtf(ss * (1.f / 512.f) + LN_EPS);
    for (int i = tid; i < 512; i += 256) mixed[(size_t)row * D_MODEL + i] = f2bf(s_o[i] * rinv * mix_gain[i]);
}

__global__ void __launch_bounds__(128) k_compress(const bf16_t* __restrict__ act, const float* __restrict__ cmp_pos, const float* __restrict__ w1, const float* __restrict__ w2, float* __restrict__ kcvc) {
    __shared__ float s_flat[CMP_BLOCK * 64]; __shared__ float s_h[CMP_HIDDEN];
    int id = blockIdx.x; const int kv = id & 1; id >>= 1; const int g = id & 1; id >>= 1; const int c = id % N_C, b = id / N_C;
    const int tid = threadIdx.x;
    const int colbase = (kv ? C_VCM : C_KCM) + g * 64;
    for (int i = tid; i < CMP_BLOCK * 64; i += 128) { int l = i >> 6, d = i & 63;
        s_flat[i] = bf2f(act[((size_t)b * SEQ + c * CMP_STRIDE + l) * ACT_COLS + colbase + d]) + cmp_pos[(kv * CMP_BLOCK + l) * 64 + d]; }
    __syncthreads();
    { const float* w = w1 + (size_t)kv * 2048 * CMP_HIDDEN; float a = 0.f;
      for (int k = 0; k < 2048; ++k) a = fmaf(bfr(s_flat[k]), bfr(w[(size_t)k * CMP_HIDDEN + tid]), a);
      float x = a; float u = 0.7978845608028654f * (x + 0.044715f * x * x * x); s_h[tid] = 0.5f * x * (1.f + tanhf(u)); }
    __syncthreads();
    if (tid < 64) { const float* w = w2 + (size_t)kv * CMP_HIDDEN * 64; float a = 0.f;
      for (int k = 0; k < CMP_HIDDEN; ++k) a = fmaf(bfr(s_h[k]), bfr(w[k * 64 + tid]), a);
      kcvc[(size_t)kv * BATCH * N_C * 128 + ((size_t)(b * N_C + c) * 2 + g) * 64 + tid] = bfr(a); }
}

__device__ __forceinline__ void pv_accum(const float* sc, int n, const bf16_t* vbase, const int* tokmap, int tok0, float gate, float* s_out, float* s_part) {
    const int tid = threadIdx.x, d = tid & 63, part = tid >> 6; float a = 0.f;
    for (int i = part; i < n; i += 4) { float p = sc[i]; if (p != 0.f) { int tok = tokmap ? tokmap[i] : tok0 + i; a = fmaf(p, bf2f(vbase[(size_t)tok * ACT_COLS + d]), a); } }
    s_part[tid] = a; __syncthreads();
    if (tid < 64) s_out[tid] += gate * (((s_part[tid] + s_part[tid + 64]) + s_part[tid + 128]) + s_part[tid + 192]);
    __syncthreads();
}
__global__ void __launch_bounds__(256) k_nsa(const bf16_t* __restrict__ act, const float* __restrict__ kcvc, const float* __restrict__ mix_gain, bf16_t* __restrict__ mixed) {
    __shared__ float s_q[8][64], s_gate[24];
    __shared__ float s_pc[4][128];
    __shared__ float s_sc[512]; __shared__ int s_tok[512];
    __shared__ float s_imp[32]; __shared__ int s_selb[8];
    __shared__ float s_red[256], s_part[256];
    __shared__ float s_out[8][64];
    const int tid = threadIdx.x, row = blockIdx.x, b = row / SEQ, t = row % SEQ;
    const bf16_t* ar = act + (size_t)row * ACT_COLS;
    const bf16_t* ab = act + (size_t)b * SEQ * ACT_COLS;
    const float* KC = kcvc + (size_t)b * N_C * 128; const float* VC = kcvc + (size_t)BATCH * N_C * 128 + (size_t)b * N_C * 128;
    for (int i = tid; i < 512; i += 256) { s_q[i >> 6][i & 63] = bf2f(ar[C_NQ + i]); s_out[i >> 6][i & 63] = 0.f; }
    if (tid < 24) s_gate[tid] = bf2f(ar[C_NG + tid]);
    __syncthreads();
    const int n_adm = (t >= 31) ? min((t - 31) / 16 + 1, N_C) : 0;
    const int cur = t / SLC_BLOCK;
    for (int g = 0; g < 2; ++g) {
        for (int r = 0; r < 4; ++r) {
            const int hh = g * 4 + r;
            if (tid < 128) { float s = -INFINITY;
                if (tid < n_adm) { const float* kr = KC + ((size_t)tid * 2 + g) * 64; float a = 0.f; for (int d = 0; d < 64; ++d) a = fmaf(s_q[hh][d], kr[d], a); s = a * ATT_SCALE; }
                s_sc[tid] = s; }
            __syncthreads();
            block_softmax(s_sc, 128, s_red);
            if (tid < 128) s_pc[r][tid] = s_sc[tid];
            if (tid < 64) { float a = 0.f; for (int c = 0; c < n_adm; ++c) a = fmaf(s_sc[c], VC[((size_t)c * 2 + g) * 64 + tid], a); s_out[hh][tid] += s_gate[hh * 3 + 0] * a; }
            __syncthreads();
        }
        if (tid < 32) { const int j = tid; float a = 0.f;
            for (int r = 0; r < 4; ++r) for (int c = 4 * j - 1; c <= 4 * j + 3; ++c) if (c >= 0 && c < N_C) a += s_pc[r][c];
            const bool forced = (j == 0) || (j == cur) || (j == cur - 1);
            if (forced) a = 1.0e4f;
            if (!(j * SLC_BLOCK <= t)) a = -1.0f;
            s_imp[j] = a; }
        __syncthreads();
        if (tid == 0) { unsigned used = 0u;
            for (int k = 0; k < SLC_COUNT; ++k) { int best = -1; float bv = 0.f;
                for (int j = 0; j < N_S; ++j) if (!((used >> j) & 1u)) { if (best < 0 || s_imp[j] > bv) { best = j; bv = s_imp[j]; } }
                used |= 1u << best; s_selb[k] = best; } }
        __syncthreads();
        for (int i = tid; i < 512; i += 256) s_tok[i] = s_selb[i >> 6] * SLC_BLOCK + (i & 63);
        __syncthreads();
        for (int r = 0; r < 4; ++r) {
            const int hh = g * 4 + r;
            for (int i = tid; i < 512; i += 256) { int tok = s_tok[i]; float s = -INFINITY;
                if (tok <= t) { const bf16_t* kr = ab + (size_t)tok * ACT_COLS + C_KSL + g * 64; float a = 0.f; for (int d = 0; d < 64; ++d) a = fmaf(s_q[hh][d], bf2f(kr[d]), a); s = a * ATT_SCALE; }
                s_sc[i] = s; }
            __syncthreads();
            block_softmax(s_sc, 512, s_red);
            pv_accum(s_sc, 512, ab + C_VSL + g * 64, s_tok, 0, s_gate[hh * 3 + 1], s_out[hh], s_part);
        }
        for (int r = 0; r < 4; ++r) {
            const int hh = g * 4 + r; const int tok0 = t - (WINDOW - 1);
            for (int i = tid; i < 512; i += 256) { int tok = tok0 + i; float s = -INFINITY;
                if (tok >= 0) { const bf16_t* kr = ab + (size_t)tok * ACT_COLS + C_KWN + g * 64; float a = 0.f; for (int d = 0; d < 64; ++d) a = fmaf(s_q[hh][d], bf2f(kr[d]), a); s = a * ATT_SCALE; }
                s_sc[i] = s; }
            __syncthreads();
            block_softmax(s_sc, 512, s_red);
            pv_accum(s_sc, 512, ab + C_VWN + g * 64, nullptr, tok0, s_gate[hh * 3 + 2], s_out[hh], s_part);
        }
    }
    const float* so = &s_out[0][0];
    float ss = so[tid] * so[tid] + so[tid + 256] * so[tid + 256];
    ss = block_sum(ss, s_red);
    const float rinv = rsqrtf(ss * (1.f / 512.f) + LN_EPS);
    for (int i = tid; i < 512; i += 256) mixed[(size_t)row * D_MODEL + 512 + i] = f2bf(so[i] * rinv * mix_gain[512 + i]);
}

__global__ void __launch_bounds__(256) k_ln(float* __restrict__ io, const float* __restrict__ g, const float* __restrict__ bta, bf16_t* __restrict__ ob) {
    __shared__ float s_red[256];
    const int tid = threadIdx.x; float* r = io + (size_t)blockIdx.x * D_MODEL;
    float v[4]; float s = 0.f;
    for (int i = 0; i < 4; ++i) { v[i] = r[tid + 256 * i]; s += v[i]; }
    const float mean = block_sum(s, s_red) * (1.f / D_MODEL);
    float q = 0.f; for (int i = 0; i < 4; ++i) { v[i] -= mean; q += v[i] * v[i]; }
    const float rstd = rsqrtf(block_sum(q, s_red) * (1.f / D_MODEL) + LN_EPS);
    for (int i = 0; i < 4; ++i) { int c = tid + 256 * i; float o = v[i] * rstd * g[c] + bta[c]; r[c] = o; if (ob) ob[(size_t)blockIdx.x * D_MODEL + c] = f2bf(o); }
}

extern "C" void kernel_launch(void* const* d_in, const int* in_sizes, int n_in, void* d_out, int out_size, void* d_ws, size_t ws_size, hipStream_t stream) {
    if (n_in != 16 || in_sizes[0] != T * D_MODEL || out_size != T * D_MODEL || ws_size < WS_NEED) { fprintf(stderr, "kernel_launch: unexpected shapes / workspace (%d inputs, ws %zu)\n", n_in, ws_size); return; }
    const float* x = (const float*)d_in[0]; const int* pos = (const int*)d_in[1];
    const float* w_in = (const float*)d_in[2]; const float* b_in = (const float*)d_in[3];
    const float* cmp_pos = (const float*)d_in[4]; const float* cmp_w1 = (const float*)d_in[5]; const float* cmp_w2 = (const float*)d_in[6];
    const float* mix_gain = (const float*)d_in[7]; const float* w_out = (const float*)d_in[8];
    const float* ln1_g = (const float*)d_in[9]; const float* ln1_b = (const float*)d_in[10];
    const float* w_gate = (const float*)d_in[11]; const float* w_up = (const float*)d_in[12]; const float* w_down = (const float*)d_in[13];
    const float* ln2_g = (const float*)d_in[14]; const float* ln2_b = (const float*)d_in[15];
    unsigned char* ws = (unsigned char*)d_ws; float* out = (float*)d_out;
    float* rope = (float*)(ws + WS_ROPE); float* kcvc = (float*)(ws + WS_KC);
    bf16_t* act = (bf16_t*)(ws + WS_ACT); bf16_t* actf = (bf16_t*)(ws + WS_ACTF); float* P = (float*)(ws + WS_P);
    bf16_t* mixed = (bf16_t*)(ws + WS_MIXED); bf16_t* hb = (bf16_t*)(ws + WS_HB);

    k_rope_table<<<(T * 8 + 255) / 256, 256, 0, stream>>>(pos, rope);
    k_gemm<<<dim3((IN_COLS + 63) / 64, T / 64), 256, 0, stream>>>(T, IN_COLS, D_MODEL, 0, LoadF32R{x, D_MODEL, 0}, LoadF32R{w_in, IN_COLS, 0}, EpStoreF32{P, IN_COLS, 0});
    k_post<<<(unsigned)(((size_t)T * ACT_COLS + 255) / 256), 256, 0, stream>>>(P, b_in, rope, act);
    k_compress<<<BATCH * N_C * 2 * 2, 128, 0, stream>>>(act, cmp_pos, cmp_w1, cmp_w2, kcvc);
    k_dsa<<<T, 256, 0, stream>>>(act, mix_gain, mixed);
    k_nsa<<<T, 256, 0, stream>>>(act, kcvc, mix_gain, mixed);
    k_gemm<<<dim3(D_MODEL / 64, T / 64), 256, 0, stream>>>(T, D_MODEL, D_MODEL, 0, LoadBf16{mixed, D_MODEL, 0}, LoadF32R{w_out, D_MODEL, 0}, EpOutProj{x, out});
    k_ln<<<T, 256, 0, stream>>>(out, ln1_g, ln1_b, hb);
    k_gemm<<<dim3(2 * FFN / 64, T / 64), 256, 0, stream>>>(T, 2 * FFN, D_MODEL, 0, LoadBf16{hb, D_MODEL, 0}, LoadGU{w_gate, w_up}, EpGU{actf});
    k_gemm<<<dim3(D_MODEL / 64, T / 64), 256, 0, stream>>>(T, D_MODEL, FFN, 0, LoadBf16{actf, FFN, 0}, LoadF32R{w_down, D_MODEL, 0}, EpDown{out});
    k_ln<<<T, 256, 0, stream>>>(out, ln2_g, ln2_b, nullptr);
}
```

```cpp
#include <hip/hip_runtime.h>
#include <cstdio>
#include <cstdint>
#include <cmath>

#ifndef PROBE_DUP
#define PROBE_DUP -1
#endif
#ifndef PROBE_T
#define PROBE_T -1
#endif
#if PROBE_T >= 0
__device__ unsigned long long t_tic, t_acc;
#define TIC(k) do { if (PROBE_T == (k) && blockIdx.x == 0 && threadIdx.x == 0) { t_tic = __builtin_amdgcn_s_memrealtime(); } } while (0)
#define TOC(k) do { if (PROBE_T == (k) && blockIdx.x == 0 && threadIdx.x == 0) { t_acc += __builtin_amdgcn_s_memrealtime() - t_tic; } } while (0)
#else
#define TIC(k) do { } while (0)
#define TOC(k) do { } while (0)
#endif
#ifndef MIXED_F8
#define MIXED_F8 1
#endif
#ifndef MK_N_LAUNCHES
#define MK_N_LAUNCHES 1
#endif

constexpr int D_MODEL = 1024, BATCH = 16, SEQ = 2048, T = BATCH * SEQ;
constexpr int IDX_TOPK = 256;
constexpr int CMP_BLOCK = 32, CMP_STRIDE = 16, CMP_HIDDEN = 128, N_C = (SEQ - CMP_BLOCK) / CMP_STRIDE + 1;
constexpr int SLC_BLOCK = 64, SLC_COUNT = 8, N_S = SEQ / SLC_BLOCK, WINDOW = 512;
constexpr int FFN = 2816;
constexpr int IN_COLS = 2240, ACT_COLS = 2304;
constexpr float ALPHA = 1.189207115002721f;
constexpr float LN_EPS = 1e-5f;
constexpr float ATT_SCALE = 0.125f;
constexpr float IDX_SCALE = 0.0625f;
constexpr int C_DQ = 0, C_DK = 512, C_DV = 576, C_IQ = 640, C_NQ = 896, C_KCM = 1408, C_VCM = 1536, C_KSL = 1664, C_VSL = 1792,
              C_KWN = 1920, C_VWN = 2048, C_IK = 2176, C_IW = 2208, C_NG = 2216;
__host__ __device__ __forceinline__ int orig_col(int pc) {
    if (pc < 896) return pc;
    if (pc < 1408) return 936 + (pc - 896);
    if (pc < 2176) return 1448 + (pc - 1408);
    if (pc < 2208) return 904 + (pc - 2176);
    if (pc < 2216) return 896 + (pc - 2208);
    if (pc < IN_COLS) return pc;
    return -1;
}
constexpr size_t MiB = 1u << 20;
constexpr size_t WS_CTL = 0, CTL_ZERO_BYTES = 1 * MiB;
constexpr size_t CTL_STATS1 = 256 * 1024;
constexpr size_t CTL_CS = 512 * 1024;
constexpr size_t CTL_CB1 = 600 * 1024;
constexpr size_t WS_ROPE = 1 * MiB;
constexpr size_t WS_BIASP = 3 * MiB;
constexpr size_t WS_WIN = 4 * MiB;
constexpr size_t WS_WOUT = 9 * MiB;
constexpr size_t WS_WGU = 11 * MiB;
constexpr size_t WS_WDN = 22 * MiB;
constexpr size_t WS_W1T = 28 * MiB;
constexpr size_t WS_W2T = 29 * MiB;
constexpr size_t WS_CB1 = 29 * MiB + 512 * 1024;
constexpr size_t WS_KCB = 30 * MiB;
constexpr size_t WS_XCH = 36 * MiB;
constexpr size_t WS_KC = 32 * MiB;
constexpr size_t WS_ACT = 48 * MiB;
constexpr size_t WS_ACTF = 48 * MiB;
constexpr size_t WS_XB = 192 * MiB;
constexpr size_t WS_MIXED = 256 * MiB;
constexpr size_t WS_V1B = 320 * MiB;
constexpr size_t WS_GCAND = 384 * MiB;
constexpr size_t WS_NEED = 512 * MiB;

namespace pg8 {
#define PG8_LAS __attribute__((address_space(3)))
typedef unsigned short bf16_t;
typedef short bf16x8 __attribute__((ext_vector_type(8)));
typedef float f32x4 __attribute__((ext_vector_type(4)));
typedef unsigned u32x4 __attribute__((ext_vector_type(4)));
constexpr int BM = 256, BK = 64, HALF = 128, HTB = HALF * BK * 2  , STAGE_BYTES = 8 * HTB, NXCD = 8, WGM = 8;

__host__ __device__ __forceinline__ int lds_byte(int r, int c) { const int st = (r >> 4) * 2 + (c >> 5), rr = r & 15, cc = c & 31, ob = rr * 64 + cc * 2; return st * 1024 + (ob ^ (((ob >> 9) & 1) << 5)); }
__host__ __device__ __forceinline__ void stage_rc(int b, int& R, int& C) { const int st = b / 1024, sb = b % 1024, swz = sb ^ (((sb >> 9) & 1) << 5); R = (st >> 1) * 16 + swz / 64; C = (st & 1) * 32 + (swz % 64) / 2; }
__host__ __device__ __forceinline__ int perm32(int rho) { const int n = rho >> 4, i = rho & 15; return 8 * (i >> 2) + 4 * n + (i & 3); }

struct Unit { int pm, pn; };
struct Gemm { const bf16_t* A; const bf16_t* Bt; int M, N, K; };

struct StaticOrder {
    int nM, nN, nwg, G, c;
    __host__ __device__ void init(int M, int N, int G_, int c_) { nM = M / BM; nN = N / BM; nwg = nM * nN; G = G_; c = c_; }
    __host__ __device__ bool next(int i, Unit& u) const {
        const long L = (long)i * G + c; if (L >= nwg) return false;
        int wgid = (int)L; { const int q = nwg / NXCD, r = nwg % NXCD, xcd = wgid % NXCD, off = wgid / NXCD; wgid = (xcd < r ? xcd * (q + 1) : r * (q + 1) + (xcd - r) * q) + off; }
        const int nig = WGM * nN, gid = wgid / nig, fm = gid * WGM, gsz = (nM - fm) < WGM ? (nM - fm) : WGM;
        u.pm = fm + ((wgid % nig) % gsz); u.pn = (wgid % nig) / gsz; return true;
    }
    __device__ __forceinline__ void a_ready(const Unit&) const {}
    __device__ __forceinline__ void done(const Unit&) const {}
};
__device__ __forceinline__ unsigned cvt_pk_bf16(float lo, float hi) { unsigned r; asm volatile("v_cvt_pk_bf16_f32 %0, %1, %2" : "=v"(r) : "v"(lo), "v"(hi)); return r; }
typedef float f32x2 __attribute__((ext_vector_type(2)));
__device__ __forceinline__ f32x4 shflx16(f32x4 v) { f32x4 r; r[0] = __shfl_xor(v[0], 16); r[1] = __shfl_xor(v[1], 16); r[2] = __shfl_xor(v[2], 16); r[3] = __shfl_xor(v[3], 16); return r; }
typedef unsigned u32x2 __attribute__((ext_vector_type(2)));
__device__ __forceinline__ u32x2 pack8_f8(f32x4 a, f32x4 b) {
    int p0 = __builtin_amdgcn_cvt_pk_fp8_f32(a[0], a[1], 0, false); p0 = __builtin_amdgcn_cvt_pk_fp8_f32(a[2], a[3], p0, true);
    int p1 = __builtin_amdgcn_cvt_pk_fp8_f32(b[0], b[1], 0, false); p1 = __builtin_amdgcn_cvt_pk_fp8_f32(b[2], b[3], p1, true);
    return u32x2{(unsigned)p0, (unsigned)p1}; }
__device__ __forceinline__ u32x4 pack8(f32x4 a, f32x4 b) { u32x4 w; w.x = cvt_pk_bf16(a[0], a[1]); w.y = cvt_pk_bf16(a[2], a[3]); w.z = cvt_pk_bf16(b[0], b[1]); w.w = cvt_pk_bf16(b[2], b[3]); return w; }
struct EpiNull {
    static constexpr bool PERM = true, AFTER_DRAIN = false;
    float* o;
    __device__ __forceinline__ void operator()(const f32x4 (&acc)[2][2][4][2], const Unit& u, int wr, int wc, int fr, int fq) const {
        f32x4 s = acc[0][0][0][0];
#pragma unroll
        for (int ai = 0; ai < 2; ++ai)
#pragma unroll
            for (int bj = 0; bj < 2; ++bj)
#pragma unroll
                for (int m = 0; m < 4; ++m)
#pragma unroll
                    for (int n = 0; n < 2; ++n) s += acc[ai][bj][m][n];
        *(f32x4*)(o + ((size_t)(u.pm * 8 + u.pn % 8) * 512 + threadIdx.x) * 4) = s;
    }
};
struct EpiInProj {
    static constexpr bool PERM = true, AFTER_DRAIN = false;
    bf16_t* act; const float* biasP; const float* rope; float qscale;
    __device__ __forceinline__ void operator()(const f32x4 (&acc)[2][2][4][2], const Unit& u, int wr, int wc, int fr, int fq) const {
        const int row0 = u.pm * BM + wr * 64 + fr; const bool lo = (wc & 1) == 0;
#pragma unroll
        for (int bj = 0; bj < 2; ++bj) {
            const int cgb = u.pn * BM + bj * HALF + wc * 32, H = cgb >> 6, col0 = cgb + 8 * fq;
            const f32x4 b0 = *(const f32x4*)(biasP + col0), b1 = *(const f32x4*)(biasP + col0 + 4);
            const bool k64 = lo && ((0xCCFFC1FFull >> H) & 1ull), k32 = (H >= 10 && H <= 13) || (H == 34 && lo), ksig = (H == 34 && !lo);
            const float qs = (H < 8 || (H >= 14 && H < 22)) ? qscale : 1.f;
#pragma unroll
            for (int ai = 0; ai < 2; ++ai)
#pragma unroll
                for (int m = 0; m < 4; ++m) {
                    const int row = row0 + ai * HALF + m * 16;
                    f32x4 v0 = acc[ai][bj][m][0] + b0, v1 = acc[ai][bj][m][1] + b1;
                    if (k64) {
                        const f32x4 p0 = shflx16(v0), p1 = shflx16(v1);
                        if (fq < 2) {
                            const f32x4* rp = (const f32x4*)(rope + (size_t)row * 16); const f32x4 t0 = rp[0], t1 = rp[1], t2 = rp[2], t3 = rp[3];
                            const float sg = fq == 0 ? -1.f : 1.f;
                            v0[0] = v0[0] * t0[0] + sg * p0[0] * t0[1]; v0[1] = v0[1] * t0[2] + sg * p0[1] * t0[3];
                            v0[2] = v0[2] * t1[0] + sg * p0[2] * t1[1]; v0[3] = v0[3] * t1[2] + sg * p0[3] * t1[3];
                            v1[0] = v1[0] * t2[0] + sg * p1[0] * t2[1]; v1[1] = v1[1] * t2[2] + sg * p1[1] * t2[3];
                            v1[2] = v1[2] * t3[0] + sg * p1[2] * t3[1]; v1[3] = v1[3] * t3[2] + sg * p1[3] * t3[3];
                        }
                    } else if (k32) {
                        if (fq == 0) {
                            const f32x4* rp = (const f32x4*)(rope + (size_t)row * 16); const f32x4 t0 = rp[0], t1 = rp[1], t2 = rp[2], t3 = rp[3];
                            const f32x4 x1 = v0, x2 = v1;
                            v0[0] = x1[0] * t0[0] - x2[0] * t0[1]; v1[0] = x2[0] * t0[0] + x1[0] * t0[1];
                            v0[1] = x1[1] * t1[0] - x2[1] * t1[1]; v1[1] = x2[1] * t1[0] + x1[1] * t1[1];
                            v0[2] = x1[2] * t2[0] - x2[2] * t2[1]; v1[2] = x2[2] * t2[0] + x1[2] * t2[1];
                            v0[3] = x1[3] * t3[0] - x2[3] * t3[1]; v1[3] = x2[3] * t3[0] + x1[3] * t3[1];
                        }
                    } else if (ksig) {
                        if (fq >= 1) {
#pragma unroll
                            for (int e = 0; e < 4; ++e) { v0[e] = 1.f / (1.f + __expf(-v0[e])); v1[e] = 1.f / (1.f + __expf(-v1[e])); }
                        }
                    }
                    *(u32x4*)(act + (size_t)row * 2304 + col0) = pack8(v0 * qs, v1 * qs);
                }
        }
    }
};
struct EpiOutProj {
    static constexpr bool PERM = true, AFTER_DRAIN = false;
    const bf16_t* xb; bf16_t* v1b; unsigned char* v1q; float* stats; float alpha, inv_s;
    __device__ __forceinline__ void operator()(const f32x4 (&acc)[2][2][4][2], const Unit& u, int wr, int wc, int fr, int fq) const {
        const int row0 = u.pm * BM + wr * 64 + fr;
#pragma unroll
        for (int ai = 0; ai < 2; ++ai)
#pragma unroll
            for (int m = 0; m < 4; ++m) {
                const int row = row0 + ai * HALF + m * 16; float s = 0.f, q = 0.f;
#pragma unroll
                for (int bj = 0; bj < 2; ++bj) {
                    const size_t off = (size_t)row * 1024 + u.pn * BM + bj * HALF + wc * 32 + 8 * fq;
                    const u32x4 xv = *(const u32x4*)(xb + off);
                    const f32x4 xa = {__uint_as_float(xv[0] << 16), __uint_as_float(xv[0] & 0xffff0000u), __uint_as_float(xv[1] << 16), __uint_as_float(xv[1] & 0xffff0000u)};
                    const f32x4 xc = {__uint_as_float(xv[2] << 16), __uint_as_float(xv[2] & 0xffff0000u), __uint_as_float(xv[3] << 16), __uint_as_float(xv[3] & 0xffff0000u)};
                    const f32x4 a = xa * alpha + acc[ai][bj][m][0] * inv_s, b = xc * alpha + acc[ai][bj][m][1] * inv_s;
                    *(u32x4*)(v1b + off) = pack8(a, b); if (v1q) *(u32x2*)(v1q + off) = pack8_f8(a, b);
                    s += ((a[0] + a[1]) + (a[2] + a[3])) + ((b[0] + b[1]) + (b[2] + b[3]));
                    q += ((a[0] * a[0] + a[1] * a[1]) + (a[2] * a[2] + a[3] * a[3])) + ((b[0] * b[0] + b[1] * b[1]) + (b[2] * b[2] + b[3] * b[3]));
                }
                s += __shfl_xor(s, 16); s += __shfl_xor(s, 32); q += __shfl_xor(q, 16); q += __shfl_xor(q, 32);
                if (fq == 0 && stats) { atomicAdd(stats + 2 * row, s); atomicAdd(stats + 2 * row + 1, q); }
            }
    }
};
struct EpiGateUp {
    static constexpr bool PERM = true, AFTER_DRAIN = false;
    bf16_t* actf; unsigned char* actq; const float* stats; const float* cs; const float* bs; float inv_s;
    __device__ __forceinline__ void operator()(const f32x4 (&acc)[2][2][4][2], const Unit& u, int wr, int wc, int fr, int fq) const {
        const int row0 = u.pm * BM + wr * 64 + fr; const int ng = u.pn * BM + wc * 32 + 8 * fq, nu = ng + HALF, jc = u.pn * HALF + wc * 32 + 8 * fq;
        f32x4 csg[2], bsg[2], csu[2], bsu[2];
#pragma unroll
        for (int n = 0; n < 2; ++n) { csg[n] = *(const f32x4*)(cs + ng + 4 * n); bsg[n] = *(const f32x4*)(bs + ng + 4 * n); csu[n] = *(const f32x4*)(cs + nu + 4 * n); bsu[n] = *(const f32x4*)(bs + nu + 4 * n); }
#pragma unroll
        for (int ai = 0; ai < 2; ++ai)
#pragma unroll
            for (int m = 0; m < 4; ++m) {
                const int row = row0 + ai * HALF + m * 16;
                typedef float f2_t __attribute__((ext_vector_type(2)));
                const f2_t st = *(const f2_t*)(stats + 2 * row);
                const float mean = st[0] * (1.f / 1024.f), var = st[1] * (1.f / 1024.f) - mean * mean, rstd = __builtin_amdgcn_rsqf(fmaxf(var, 0.f) + 1e-5f);
                const float a1 = inv_s * rstd, a0 = -mean * rstd;
                f32x4 o[2];
#pragma unroll
                for (int n = 0; n < 2; ++n) {
                    const f32x4 g = acc[ai][0][m][n] * a1 + (csg[n] * a0 + bsg[n]), up = acc[ai][1][m][n] * a1 + (csu[n] * a0 + bsu[n]);
#pragma unroll
                    for (int e = 0; e < 4; ++e) o[n][e] = g[e] * __builtin_amdgcn_rcpf(1.f + __builtin_amdgcn_exp2f(g[e] * -1.4426950408889634f)) * up[e];
                }
                if (actq) *(u32x2*)(actq + (size_t)row * 2816 + jc) = pack8_f8(o[0], o[1]); else *(u32x4*)(actf + (size_t)row * 2816 + jc) = pack8(o[0], o[1]);
            }
    }
};
struct RowStatsX {
    unsigned long long* xbuf;
    unsigned* cnt;
    PG8_LAS unsigned char* tab;
    float eps;
    __device__ __forceinline__ void run(const f32x4 (&v)[2][2][4][2], const Unit& u, int wr, int wc, int fr, int fq, int wid, int lane) const {
        typedef float f32x2v __attribute__((ext_vector_type(2)));
        PG8_LAS f32x2v* P = (PG8_LAS f32x2v*)tab; PG8_LAS f32x2v* S = (PG8_LAS f32x2v*)(tab + 8192);
#pragma unroll
        for (int ai = 0; ai < 2; ++ai)
#pragma unroll
            for (int m = 0; m < 4; ++m) {
                float s = 0.f;
#pragma unroll
                for (int bj = 0; bj < 2; ++bj)
#pragma unroll
                    for (int n = 0; n < 2; ++n) { const f32x4 x = v[ai][bj][m][n]; s += (x[0] + x[1]) + (x[2] + x[3]); }
                s += __shfl_xor(s, 16); s += __shfl_xor(s, 32);
                const float mw = s * (1.0f / 64.0f); float q = 0.f;
#pragma unroll
                for (int bj = 0; bj < 2; ++bj)
#pragma unroll
                    for (int n = 0; n < 2; ++n) { const f32x4 d = v[ai][bj][m][n] - mw; q += (d[0] * d[0] + d[1] * d[1]) + (d[2] * d[2] + d[3] * d[3]); }
                q += __shfl_xor(q, 16); q += __shfl_xor(q, 32);
                if (fq == 0) P[(ai * HALF + wr * 64 + m * 16 + fr) * 4 + wc] = (f32x2v){mw, q};
            }
        asm volatile("s_waitcnt lgkmcnt(0)" ::: "memory"); __builtin_amdgcn_s_barrier(); asm volatile("" ::: "memory");
        const int row = wid * 32 + (lane & 31);
        if (lane < 32) {
            const f32x2v a = P[row * 4 + 0], b = P[row * 4 + 1], c = P[row * 4 + 2], d = P[row * 4 + 3];
            const float mt = (a.x + b.x + c.x + d.x) * 0.25f;
            const float da = a.x - mt, db = b.x - mt, dc = c.x - mt, dd = d.x - mt;
            const float m2 = (a.y + b.y) + (c.y + d.y) + 64.0f * ((da * da + db * db) + (dc * dc + dd * dd));
            __hip_atomic_store(xbuf + ((size_t)(u.pm * BM + row) * 4 + u.pn), ((unsigned long long)__float_as_uint(m2) << 32) | __float_as_uint(mt), __ATOMIC_RELAXED, __HIP_MEMORY_SCOPE_AGENT);
        }
        asm volatile("s_waitcnt vmcnt(0)" ::: "memory");
        if (lane == 0) __hip_atomic_fetch_add(cnt + 64 * u.pm, 1u, __ATOMIC_RELAXED, __HIP_MEMORY_SCOPE_AGENT);
        if (wid == 0) {
            unsigned sp = 0;
            while ((unsigned)__builtin_amdgcn_readfirstlane((int)__hip_atomic_load(cnt + 64 * u.pm, __ATOMIC_RELAXED, __HIP_MEMORY_SCOPE_AGENT)) < 32u) { __builtin_amdgcn_s_sleep(2); if (++sp > (1u << 22)) break; }
            __builtin_amdgcn_fence(__ATOMIC_ACQUIRE, "agent");
        }
        asm volatile("s_waitcnt vmcnt(0) lgkmcnt(0)" ::: "memory"); __builtin_amdgcn_s_barrier(); asm volatile("" ::: "memory");
        if (lane < 32) {
            const unsigned long long* slot = xbuf + (size_t)(u.pm * BM + row) * 4; float mt[4], m2[4]; float ms = 0.f;
#pragma unroll
            for (int t = 0; t < 4; ++t) { const unsigned long long w = __hip_atomic_load(slot + t, __ATOMIC_RELAXED, __HIP_MEMORY_SCOPE_AGENT); mt[t] = __uint_as_float((unsigned)w); m2[t] = __uint_as_float((unsigned)(w >> 32)); ms += mt[t]; }
            const float mean = ms * 0.25f; float q = 0.f;
#pragma unroll
            for (int t = 0; t < 4; ++t) { const float dm = mt[t] - mean; q += m2[t] + 256.0f * dm * dm; }
            S[row] = (f32x2v){mean, __builtin_amdgcn_rsqf(q * (1.0f / 1024.0f) + eps)};
        }
        asm volatile("s_waitcnt lgkmcnt(0)" ::: "memory"); __builtin_amdgcn_s_barrier(); asm volatile("" ::: "memory");
    }
};
struct EpiDownLn {
    static constexpr bool PERM = true, AFTER_DRAIN = false;
    const bf16_t* v1b; float* out; const float* stats; const float* g1; const float* b1; const float* g2; const float* b2; float alpha, inv_s; RowStatsX rx;
    __device__ __forceinline__ void operator()(const f32x4 (&acc_)[2][2][4][2], const Unit& u, int wr, int wc, int fr, int fq) const {
        typedef float f32x2v __attribute__((ext_vector_type(2)));
        f32x4 (&acc)[2][2][4][2] = const_cast<f32x4 (&)[2][2][4][2]>(acc_);
        const int row0 = u.pm * BM + wr * 64 + fr; const int wid = wr * 4 + wc, lane = fq * 16 + fr;
#pragma unroll
        for (int bj = 0; bj < 2; ++bj) {
            const int col0 = u.pn * BM + bj * HALF + wc * 32 + 8 * fq;
            const f32x4 ga = *(const f32x4*)(g1 + col0), gb = *(const f32x4*)(g1 + col0 + 4), ba = *(const f32x4*)(b1 + col0), bb = *(const f32x4*)(b1 + col0 + 4);
#pragma unroll
            for (int ai = 0; ai < 2; ++ai)
#pragma unroll
                for (int m = 0; m < 4; ++m) {
                    const int row = row0 + ai * HALF + m * 16;
                    const f32x2v st = *(const f32x2v*)(stats + 2 * row);
                    const float mean = st[0] * (1.f / 1024.f), var = st[1] * (1.f / 1024.f) - mean * mean, rstd = __builtin_amdgcn_rsqf(fmaxf(var, 0.f) + 1e-5f);
                    const u32x4 vv = *(const u32x4*)(v1b + (size_t)row * 1024 + col0);
                    const f32x4 va = {__uint_as_float(vv[0] << 16), __uint_as_float(vv[0] & 0xffff0000u), __uint_as_float(vv[1] << 16), __uint_as_float(vv[1] & 0xffff0000u)};
                    const f32x4 vb = {__uint_as_float(vv[2] << 16), __uint_as_float(vv[2] & 0xffff0000u), __uint_as_float(vv[3] << 16), __uint_as_float(vv[3] & 0xffff0000u)};
                    acc[ai][bj][m][0] = ((va - mean) * rstd * ga + ba) * alpha + acc[ai][bj][m][0] * inv_s;
                    acc[ai][bj][m][1] = ((vb - mean) * rstd * gb + bb) * alpha + acc[ai][bj][m][1] * inv_s;
                    asm volatile("" : "+v"(acc[ai][bj][m][0]), "+v"(acc[ai][bj][m][1]));
                    if (m & 1) asm volatile("" ::: "memory");
                }
        }
        rx.run(acc, u, wr, wc, fr, fq, wid, lane);
        const PG8_LAS f32x2v* S = (const PG8_LAS f32x2v*)(rx.tab + 8192);
#pragma unroll
        for (int bj = 0; bj < 2; ++bj) {
            const int col0 = u.pn * BM + bj * HALF + wc * 32 + 8 * fq;
            const f32x4 ga = *(const f32x4*)(g2 + col0), gb = *(const f32x4*)(g2 + col0 + 4), ba = *(const f32x4*)(b2 + col0), bb = *(const f32x4*)(b2 + col0 + 4);
#pragma unroll
            for (int ai = 0; ai < 2; ++ai)
#pragma unroll
                for (int m = 0; m < 4; ++m) {
                    const int r = ai * HALF + wr * 64 + m * 16 + fr; const f32x2v sr = S[r]; float* po = out + (size_t)(u.pm * BM + r) * 1024 + col0;
                    *(f32x4*)po = (acc[ai][bj][m][0] - sr.x) * sr.y * ga + ba; *(f32x4*)(po + 4) = (acc[ai][bj][m][1] - sr.x) * sr.y * gb + bb;
                    if (m & 1) asm volatile("" ::: "memory");
                }
        }
        asm volatile("s_waitcnt lgkmcnt(0)" ::: "memory"); __builtin_amdgcn_s_barrier(); asm volatile("" ::: "memory");
    }
};
struct EpiDown {
    static constexpr bool PERM = true, AFTER_DRAIN = false;
    const bf16_t* v1b; bf16_t* v2b; const float* stats; const float* g1; const float* b1; float alpha, inv_s;
    __device__ __forceinline__ void operator()(const f32x4 (&acc)[2][2][4][2], const Unit& u, int wr, int wc, int fr, int fq) const {
        const int row0 = u.pm * BM + wr * 64 + fr;
#pragma unroll
        for (int bj = 0; bj < 2; ++bj) {
            const int col0 = u.pn * BM + bj * HALF + wc * 32 + 8 * fq;
            const f32x4 ga = *(const f32x4*)(g1 + col0), gb = *(const f32x4*)(g1 + col0 + 4), ba = *(const f32x4*)(b1 + col0), bb = *(const f32x4*)(b1 + col0 + 4);
#pragma unroll
            for (int ai = 0; ai < 2; ++ai)
#pragma unroll
                for (int m = 0; m < 4; ++m) {
                    const int row = row0 + ai * HALF + m * 16;
                    const float sm = stats[2 * row], sq = stats[2 * row + 1];
                    const float mean = sm * (1.f / 1024.f), var = sq * (1.f / 1024.f) - mean * mean, rstd = rsqrtf(fmaxf(var, 0.f) + 1e-5f);
                    const u32x4 vv = *(const u32x4*)(v1b + (size_t)row * 1024 + col0);
                    const f32x4 va = {__uint_as_float(vv[0] << 16), __uint_as_float(vv[0] & 0xffff0000u), __uint_as_float(vv[1] << 16), __uint_as_float(vv[1] & 0xffff0000u)};
                    const f32x4 vb = {__uint_as_float(vv[2] << 16), __uint_as_float(vv[2] & 0xffff0000u), __uint_as_float(vv[3] << 16), __uint_as_float(vv[3] & 0xffff0000u)};
                    const f32x4 ha = (va - mean) * rstd * ga + ba, hb = (vb - mean) * rstd * gb + bb;
                    *(u32x4*)(v2b + (size_t)row * 1024 + col0) = pack8(ha * alpha + acc[ai][bj][m][0] * inv_s, hb * alpha + acc[ai][bj][m][1] * inv_s);
                }
        }
    }
};

typedef int i32x8 __attribute__((ext_vector_type(8))); typedef int i32x4 __attribute__((ext_vector_type(4)));
__device__ __forceinline__ i32x8 cat8(bf16x8 a, bf16x8 b) { return __builtin_shufflevector(__builtin_bit_cast(i32x4, a), __builtin_bit_cast(i32x4, b), 0, 1, 2, 3, 4, 5, 6, 7); }
template <class Epi, class Sched, bool ALIGN_EPI = false, bool SP2 = false, bool F8 = false>
__device__ __forceinline__ void gemm_phase(PG8_LAS unsigned char* lds, const Gemm g, const Sched& S, const Epi& E) {
    int tid_ = threadIdx.x; asm volatile("" : "+v"(tid_));
    const int tid = tid_, wid = __builtin_amdgcn_readfirstlane(tid >> 6), lane = tid & 63, wr = wid >> 2, wc = wid & 3, fr = lane & 15, fq = lane >> 4;
    const int RB = F8 ? g.K : 2 * g.K  , nt = RB / 128;
    int sc7f = 0x7F7F7F7F; asm volatile("" : "+v"(sc7f));
    unsigned voffA[2], voffB[2];
#pragma unroll
    for (int i = 0; i < 2; ++i) { int R, C; stage_rc(tid * 16 + i * 8192, R, C); const int Rb = Epi::PERM ? ((R & ~31) + perm32(R & 31)) : R;
        voffA[i] = (unsigned)(R * RB + C * 2); voffB[i] = (unsigned)(Rb * RB + C * 2); }
    const size_t kstep = (size_t)(BK * 2);
    const size_t hstep = (size_t)HALF * RB;
    const size_t tstep = 2 * hstep;
    const unsigned ldsw = (unsigned)wid * 1024u;
    const int aoff = lds_byte(wr * 64 + fr, fq * 8), boff = lds_byte(wc * 32 + fr, fq * 8);
#define PG8_SA(b, h) (((b) * 2 + (h)) * HTB)
#define PG8_SB(b, h) ((4 + (b) * 2 + (h)) * HTB)
#define PG8_STAGE(bufoff, gbase, voff) do { _Pragma("unroll") for (int _i = 0; _i < 2; ++_i) \
        __builtin_amdgcn_global_load_lds((const unsigned*)((const char*)(gbase) + (voff)[_i]), (PG8_LAS unsigned*)(lds + (bufoff) + ldsw + _i * 8192), 16, 0, 0); } while (0)
#define PG8_LDA(dst, b, h) do { _Pragma("unroll") for (int m = 0; m < 4; ++m) _Pragma("unroll") for (int k = 0; k < 2; ++k) dst[m][k] = *(const PG8_LAS bf16x8*)(lds + PG8_SA(b, h) + aoff + m * 2048 + k * 1024); } while (0)
#define PG8_LDB(dst, b, h) do { _Pragma("unroll") for (int n = 0; n < 2; ++n) _Pragma("unroll") for (int k = 0; k < 2; ++k) dst[n][k] = *(const PG8_LAS bf16x8*)(lds + PG8_SB(b, h) + boff + n * 2048 + k * 1024); } while (0)
#define PG8_MMA(ai, bj, At, Bt) do { if constexpr (F8) __builtin_amdgcn_sched_barrier(0); __builtin_amdgcn_s_setprio(1); \
        if constexpr (F8) { _Pragma("unroll") for (int m = 0; m < 4; ++m) _Pragma("unroll") for (int n = 0; n < 2; ++n) \
            asm volatile("v_mfma_scale_f32_16x16x128_f8f6f4 %0, %1, %2, %0, %3, %3 op_sel_hi:[0,0,0]" : "+v"(acc[ai][bj][m][n]) : "v"(cat8(Bt[n][0], Bt[n][1])), "v"(cat8(At[m][0], At[m][1])), "v"(sc7f)); } \
        else { _Pragma("unroll") for (int m = 0; m < 4; ++m) _Pragma("unroll") for (int n = 0; n < 2; ++n) _Pragma("unroll") for (int k = 0; k < 2; ++k) \
            acc[ai][bj][m][n] = __builtin_amdgcn_mfma_f32_16x16x32_bf16(Bt[n][k], At[m][k], acc[ai][bj][m][n], 0, 0, 0); } \
        __builtin_amdgcn_s_setprio(0); if constexpr (F8) __builtin_amdgcn_sched_barrier(0); } while (0)
#define PG8_WAIT_V(n) asm volatile("s_waitcnt vmcnt(" #n ")" ::: "memory")
#define PG8_WAIT_L(n) asm volatile("s_waitcnt lgkmcnt(" #n ")" ::: "memory")
#define PG8_BAR __builtin_amdgcn_s_barrier()
#define PG8_SCHED __builtin_amdgcn_sched_barrier(0)
    Unit cur, nxt; int ui = 0;
    if (!S.next(0, cur)) return;
    f32x4 acc[2][2][4][2];
#pragma unroll
    for (int a = 0; a < 2; ++a)
#pragma unroll
        for (int b = 0; b < 2; ++b)
#pragma unroll
            for (int m = 0; m < 4; ++m)
#pragma unroll
                for (int n = 0; n < 2; ++n) acc[a][b][m][n] = (f32x4){0.f, 0.f, 0.f, 0.f};
    bf16x8 At[4][2], B0[2][2], B1[2][2];
    const char* cA = (const char*)g.A + (size_t)cur.pm * tstep; const char* cB = (const char*)g.Bt + (size_t)cur.pn * tstep;
    S.a_ready(cur);
    if constexpr (SP2) {
        PG8_STAGE(PG8_SB(0, 0), cB, voffB); PG8_STAGE(PG8_SB(0, 1), cB + hstep, voffB); PG8_STAGE(PG8_SA(0, 0), cA, voffA); PG8_STAGE(PG8_SA(0, 1), cA + hstep, voffA);
        if (wr == 1) PG8_BAR;
        PG8_WAIT_V(2); PG8_BAR;
        PG8_STAGE(PG8_SB(1, 0), cB + kstep, voffB); PG8_STAGE(PG8_SA(1, 0), cA + kstep, voffA); PG8_STAGE(PG8_SB(1, 1), cB + hstep + kstep, voffB);
        PG8_WAIT_V(6); PG8_BAR;
    } else {
        PG8_STAGE(PG8_SB(0, 0), cB, voffB); PG8_STAGE(PG8_SA(0, 0), cA, voffA); PG8_STAGE(PG8_SB(0, 1), cB + hstep, voffB); PG8_STAGE(PG8_SA(0, 1), cA + hstep, voffA);
        if (wr == 1) PG8_BAR;
        PG8_WAIT_V(4); PG8_BAR;
        PG8_STAGE(PG8_SB(1, 0), cB + kstep, voffB); PG8_STAGE(PG8_SA(1, 0), cA + kstep, voffA); PG8_STAGE(PG8_SB(1, 1), cB + hstep + kstep, voffB);
        PG8_WAIT_V(6); PG8_BAR;
    }
    for (;;) {
        const bool has_next = S.next(ui + 1, nxt);
        const char* nA = has_next ? (const char*)g.A + (size_t)nxt.pm * tstep : cA; const char* nB = has_next ? (const char*)g.Bt + (size_t)nxt.pn * tstep : cB;
        for (int t = 0; t < nt; t += 2) {
            const bool last = (t == nt - 2);
            const char* a1 = cA + (size_t)(t + 1) * kstep;
            const char* a2 = last ? nA : cA + (size_t)(t + 2) * kstep; const char* b2 = last ? nB : cB + (size_t)(t + 2) * kstep;
            const char* a3 = a2 + kstep; const char* b3 = b2 + kstep;
            if (last && has_next) S.a_ready(nxt);
            if constexpr (SP2) {
            PG8_LDB(B0, 0, 0); PG8_LDB(B1, 0, 1); PG8_SCHED; PG8_LDA(At, 0, 0); PG8_STAGE(PG8_SA(1, 1), a1 + hstep, voffA);
            PG8_WAIT_V(8); PG8_WAIT_L(0); PG8_BAR; PG8_MMA(0, 0, At, B0); PG8_MMA(0, 1, At, B1); PG8_BAR; PG8_SCHED;
            PG8_LDA(At, 0, 1); PG8_STAGE(PG8_SB(0, 0), b2, voffB); PG8_STAGE(PG8_SB(0, 1), b2 + hstep, voffB); PG8_STAGE(PG8_SA(0, 0), a2, voffA);
            PG8_WAIT_V(8); PG8_WAIT_L(0); PG8_BAR; PG8_MMA(1, 0, At, B0); PG8_MMA(1, 1, At, B1); PG8_BAR; PG8_SCHED;
            PG8_LDB(B0, 1, 0); PG8_LDB(B1, 1, 1); PG8_SCHED; PG8_LDA(At, 1, 0); PG8_STAGE(PG8_SA(0, 1), a2 + hstep, voffA);
            PG8_WAIT_V(8); PG8_WAIT_L(0); PG8_BAR; PG8_MMA(0, 0, At, B0); PG8_MMA(0, 1, At, B1); PG8_BAR; PG8_SCHED;
            PG8_LDA(At, 1, 1); PG8_STAGE(PG8_SB(1, 0), b3, voffB); PG8_STAGE(PG8_SB(1, 1), b3 + hstep, voffB); PG8_STAGE(PG8_SA(1, 0), a3, voffA);
            PG8_WAIT_V(8); PG8_WAIT_L(0); PG8_BAR; PG8_MMA(1, 0, At, B0); PG8_MMA(1, 1, At, B1); PG8_BAR; PG8_SCHED;
            } else {
            PG8_LDB(B0, 0, 0); PG8_SCHED; PG8_LDA(At, 0, 0); PG8_STAGE(PG8_SA(1, 1), a1 + hstep, voffA);
            PG8_WAIT_L(8); PG8_BAR; PG8_WAIT_L(0); PG8_MMA(0, 0, At, B0); PG8_BAR; PG8_SCHED;
            PG8_LDB(B1, 0, 1); PG8_STAGE(PG8_SB(0, 0), b2, voffB);
            PG8_BAR; PG8_WAIT_L(0); PG8_MMA(0, 1, At, B1); PG8_BAR;
            PG8_LDA(At, 0, 1); PG8_STAGE(PG8_SA(0, 0), a2, voffA);
            PG8_BAR; PG8_WAIT_L(0); PG8_MMA(1, 0, At, B0); PG8_BAR; PG8_SCHED;
            PG8_STAGE(PG8_SB(0, 1), b2 + hstep, voffB);
            PG8_WAIT_V(6); PG8_BAR; PG8_MMA(1, 1, At, B1); PG8_BAR;
            PG8_LDB(B0, 1, 0); PG8_SCHED; PG8_LDA(At, 1, 0); PG8_STAGE(PG8_SA(0, 1), a2 + hstep, voffA);
            PG8_WAIT_L(8); PG8_BAR; PG8_WAIT_L(0); PG8_MMA(0, 0, At, B0); PG8_BAR; PG8_SCHED;
            PG8_LDB(B1, 1, 1); PG8_STAGE(PG8_SB(1, 0), b3, voffB);
            PG8_BAR; PG8_WAIT_L(0); PG8_MMA(0, 1, At, B1); PG8_BAR;
            PG8_LDA(At, 1, 1); PG8_STAGE(PG8_SA(1, 0), a3, voffA);
            PG8_BAR; PG8_WAIT_L(0); PG8_MMA(1, 0, At, B0); PG8_BAR; PG8_SCHED;
            PG8_STAGE(PG8_SB(1, 1), b3 + hstep, voffB);
            PG8_WAIT_V(6); PG8_BAR; PG8_MMA(1, 1, At, B1); PG8_BAR;
            }
        }
        if constexpr (ALIGN_EPI) { if (wr == 0) PG8_BAR; }
        if constexpr (F8) asm volatile("s_nop 15\n\ts_nop 7" ::: "memory");
        if constexpr (!Epi::AFTER_DRAIN) { E(acc, cur, wr, wc, fr, fq); S.done(cur); }
        if (!has_next) break;
#pragma unroll
        for (int a = 0; a < 2; ++a)
#pragma unroll
            for (int b = 0; b < 2; ++b)
#pragma unroll
                for (int m = 0; m < 4; ++m)
#pragma unroll
                    for (int n = 0; n < 2; ++n) acc[a][b][m][n] = (f32x4){0.f, 0.f, 0.f, 0.f};
        cur = nxt; cA = nA; cB = nB; ++ui;
        if constexpr (ALIGN_EPI) { if (wr == 1) PG8_BAR; }
    }
    PG8_WAIT_V(0);
    if constexpr (!ALIGN_EPI) { if (wr == 0) PG8_BAR; }
    PG8_BAR;
    if constexpr (Epi::AFTER_DRAIN) { E.fused(acc, cur, wr, wc, fr, fq, lds, wid, lane); S.done(cur); }
#undef PG8_SA
#undef PG8_SB
#undef PG8_STAGE
#undef PG8_LDA
#undef PG8_LDB
#undef PG8_MMA
#undef PG8_WAIT_V
#undef PG8_WAIT_L
#undef PG8_BAR
#undef PG8_SCHED
}
}
#define GAS __attribute__((address_space(1)))
#define LAS __attribute__((address_space(3)))
typedef unsigned short bf16;
typedef unsigned v4u __attribute__((ext_vector_type(4)));
typedef float f32x4 __attribute__((ext_vector_type(4)));
typedef short bf16x8 __attribute__((ext_vector_type(8)));
typedef GAS unsigned gu32;
typedef GAS unsigned long long gu64;
#define RLX_AGENT __ATOMIC_RELAXED, __HIP_MEMORY_SCOPE_AGENT
#define LDS_WAIT() asm volatile("s_waitcnt lgkmcnt(0)" ::: "memory")
#define VM_WAIT() asm volatile("s_waitcnt vmcnt(0)" ::: "memory")
__device__ __forceinline__ unsigned long long rt() { return __builtin_amdgcn_s_memrealtime(); }
__device__ __forceinline__ unsigned f2bf(float f) { unsigned u = __builtin_bit_cast(unsigned, f); return (u + 0x7fffu + ((u >> 16) & 1u)) >> 16; }
__device__ __forceinline__ unsigned pk2(float lo, float hi) { return f2bf(lo) | (f2bf(hi) << 16); }

#define XB_TMO      128
#define XB_XCNT(j)  (256  + 64 * (j))
#define XB_XSUB(j)  (1280 + 64 * (j))
#define XB_XGEN(j)  (2304 + 64 * (j))
#define XB_TOP      3328
#define XB_TOPGEN   3392
#define XCD_BAR_WORDS 3456
#define XB_SPIN_CAP (1u << 18)

__device__ __forceinline__ unsigned xb_ld(unsigned* p)              { return __hip_atomic_load(p, __ATOMIC_RELAXED, __HIP_MEMORY_SCOPE_AGENT); }
__device__ __forceinline__ unsigned xb_add(unsigned* p, unsigned v) { return __hip_atomic_fetch_add(p, v, __ATOMIC_RELAXED, __HIP_MEMORY_SCOPE_AGENT); }
__device__ __forceinline__ unsigned xb_xcc_id() { return (unsigned)__builtin_amdgcn_s_getreg((3 << 11) | 20) & 0xFu; }
#define XB_SPIN(cond, bar) do { unsigned _sp = 0; while (cond) { __builtin_amdgcn_s_sleep(1); \
    if ((++_sp & 255u) == 0u) { if (xb_ld(&(bar)[XB_TMO])) break; if (_sp > XB_SPIN_CAP) { atomicAdd(&(bar)[XB_TMO], 1u); break; } } } } while (0)

struct XcdBarrier {
    unsigned* bar; unsigned x;
    volatile LAS unsigned* st;
};

__device__ __forceinline__ XcdBarrier xcd_barrier_post(unsigned* bar, volatile LAS unsigned* st) {
    XcdBarrier b; b.bar = bar; b.x = xb_xcc_id(); b.st = st;
    if (threadIdx.x == 0) (void)xb_add(&bar[XB_XCNT(b.x)], 1u);
    return b;
}
__device__ __forceinline__ void xcd_barrier_complete(unsigned* bar, unsigned x, unsigned& nloc, unsigned& nx) {
    const unsigned G = gridDim.x * gridDim.y * gridDim.z;
    unsigned sum, cnt, mine, sp = 0u;
    for (;;) {
        sum = 0u; cnt = 0u; mine = 0u;
#pragma unroll
        for (unsigned j = 0; j < 16; ++j) { const unsigned c = xb_ld(&bar[XB_XCNT(j)]); sum += c; cnt += (c > 0u) ? 1u : 0u; mine = (j == x) ? c : mine; }
        if (sum == G) break;
        __builtin_amdgcn_s_sleep(1);
        if ((++sp & 255u) == 0u) { if (xb_ld(&bar[XB_TMO])) break; if (sp > XB_SPIN_CAP) { atomicAdd(&bar[XB_TMO], 1u); break; } }
    }
    nloc = mine > 0u ? mine : 1u; nx = cnt > 0u ? cnt : 1u;
}

__device__ __forceinline__ void xcd_barrier(const XcdBarrier& b) {
    asm volatile("s_waitcnt vmcnt(0)" ::: "memory");
    __syncthreads();
    if (threadIdx.x == 0) {
        unsigned* bar = b.bar;
        __builtin_amdgcn_s_waitcnt(0);
        unsigned nloc = b.st[0], nx = b.st[1];
        if (nloc == 0u) { xcd_barrier_complete(bar, b.x, nloc, nx); b.st[0] = nloc; b.st[1] = nx; }
        const unsigned old = xb_add(&bar[XB_XSUB(b.x)], 1u);
        const unsigned gen = old / nloc;
        if (old + 1u == (gen + 1u) * nloc) {
            __builtin_amdgcn_fence(__ATOMIC_RELEASE, "agent");
            asm volatile("s_waitcnt vmcnt(0)" ::: "memory");
            const unsigned og = xb_add(&bar[XB_TOP], 1u);
            const unsigned tg = og / nx;
            if (og + 1u == (tg + 1u) * nx) xb_add(&bar[XB_TOPGEN], 1u);
            else XB_SPIN(xb_ld(&bar[XB_TOPGEN]) == tg, bar);
            __builtin_amdgcn_fence(__ATOMIC_ACQUIRE, "agent");
            xb_add(&bar[XB_XGEN(b.x)], 1u);
            asm volatile("s_waitcnt vmcnt(0)" ::: "memory");
        } else {
            XB_SPIN(xb_ld(&bar[XB_XGEN(b.x)]) == gen, bar);
            __builtin_amdgcn_fence(__ATOMIC_ACQUIRE, "agent");
            asm volatile("s_waitcnt vmcnt(0)" ::: "memory");
        }
    }
    __syncthreads();
}
constexpr int NWAVES = 8, NT = 512;
constexpr float S_GU = 32.f, S_DN = 64.f, S_OUT = 32.f;
constexpr int RING_BYTES = 131072, LDSCTL_OFF = RING_BYTES, MISC_OFF = LDSCTL_OFF + 320, LDS_BYTES = 147456;
constexpr int CW_TMO = 0, CW_BAR = 4096;
__device__ __forceinline__ float bf2f(bf16 v) { return __uint_as_float(((unsigned)v) << 16); }
__device__ __forceinline__ float bfr(float f) { return __uint_as_float(f2bf(f) << 16); }
__device__ __forceinline__ float wave_sum(float v) {
#pragma unroll
    for (int o = 1; o < 64; o <<= 1) v += __shfl_xor(v, o);
    return v;
}
template <bool F8>
__device__ __forceinline__ void tr64(const float* __restrict__ W, int Nsrc, int K, void* WT, int n0, int k0, int srccol, const float* __restrict__ kscale, float S, const float* __restrict__ kbias, float* csum, float* bsum, int lane) {
    const float* wp = W + (size_t)k0 * Nsrc + (srccol >= 0 ? srccol : 0); float cs = 0.f, bs = 0.f; const float rS = 1.f / S;
#pragma unroll 1
    for (int ch = 0; ch < 4; ++ch) {
        float v[16];
#pragma unroll
        for (int i = 0; i < 16; ++i) v[i] = srccol >= 0 ? wp[(size_t)(ch * 16 + i) * Nsrc] : 0.f;
        if (bsum) {
#pragma unroll
            for (int i = 0; i < 16; ++i) bs = fmaf(kbias[k0 + ch * 16 + i], v[i], bs); }
        if (kscale) {
#pragma unroll
            for (int i = 0; i < 16; ++i) v[i] *= kscale[k0 + ch * 16 + i]; }
        if constexpr (F8) {
            v4u o;
#pragma unroll
            for (int d = 0; d < 4; ++d) { int p = __builtin_amdgcn_cvt_pk_fp8_f32(v[4 * d] * S, v[4 * d + 1] * S, 0, false); p = __builtin_amdgcn_cvt_pk_fp8_f32(v[4 * d + 2] * S, v[4 * d + 3] * S, p, true); o[d] = (unsigned)p;
                if (csum) cs += ((__builtin_amdgcn_cvt_f32_fp8(p, 0) + __builtin_amdgcn_cvt_f32_fp8(p, 1)) + (__builtin_amdgcn_cvt_f32_fp8(p, 2) + __builtin_amdgcn_cvt_f32_fp8(p, 3))) * rS; }
            *(GAS v4u*)((unsigned char*)WT + (size_t)(n0 + lane) * K + k0 + ch * 16) = o;
        } else {
            v4u o0, o1;
#pragma unroll
            for (int d = 0; d < 4; ++d) { o0[d] = pk2(v[2 * d], v[2 * d + 1]); o1[d] = pk2(v[8 + 2 * d], v[8 + 2 * d + 1]); }
            GAS v4u* dst = (GAS v4u*)((bf16*)WT + (size_t)(n0 + lane) * K + k0 + ch * 16); dst[0] = o0; dst[1] = o1;
        }
    }
    if (csum) atomicAdd(csum + n0 + lane, cs);
    if (bsum) atomicAdd(bsum + n0 + lane, bs);
}


namespace att {
typedef short bf16x8 __attribute__((ext_vector_type(8)));
typedef short s16x4 __attribute__((ext_vector_type(4)));
typedef short v4i16_t __attribute__((ext_vector_type(4)));
typedef float f32x16 __attribute__((ext_vector_type(16)));
typedef unsigned u32x4 __attribute__((ext_vector_type(4)));
typedef unsigned u32x2 __attribute__((ext_vector_type(2)));
constexpr float C2 = 0.125f * 1.4426950408889634f;
constexpr float NEG_INF = -INFINITY;
__device__ __forceinline__ int crow(int r, int hi) { return (r & 3) + 8 * (r >> 2) + 4 * hi; }
__device__ __forceinline__ s16x4 vtr(const LAS unsigned char* p) { return __builtin_bit_cast(s16x4, __builtin_amdgcn_ds_read_tr16_b64_v4i16((LAS v4i16_t*)p)); }
__device__ __forceinline__ unsigned cvtpk(float lo, float hi) { typedef float f2_t __attribute__((ext_vector_type(2))); typedef __bf16 b2_t __attribute__((ext_vector_type(2))); f2_t v = {lo, hi}; b2_t b = __builtin_convertvector(v, b2_t); return __builtin_bit_cast(unsigned, b); }
__device__ __forceinline__ float ex2(float x) { return __builtin_amdgcn_exp2f(x); }

__device__ __forceinline__ void qkt(f32x16& p0, f32x16& p1, const LAS unsigned char* Ks, const bf16x8* qf, int r32, int hi) {
    const LAS unsigned char* kb = Ks + hi * 1024 + r32 * 16;
#pragma unroll
    for (int dh = 0; dh < 2; ++dh) {
        const bf16x8 b0 = *(const LAS bf16x8*)(kb + (2 * dh) * 2048), b1 = *(const LAS bf16x8*)(kb + (2 * dh) * 2048 + 512);
        const bf16x8 b2 = *(const LAS bf16x8*)(kb + (2 * dh + 1) * 2048), b3 = *(const LAS bf16x8*)(kb + (2 * dh + 1) * 2048 + 512);
        __builtin_amdgcn_s_setprio(1);
        p0 = __builtin_amdgcn_mfma_f32_32x32x16_bf16(b0, qf[2 * dh], p0, 0, 0, 0); p1 = __builtin_amdgcn_mfma_f32_32x32x16_bf16(b1, qf[2 * dh], p1, 0, 0, 0);
        p0 = __builtin_amdgcn_mfma_f32_32x32x16_bf16(b2, qf[2 * dh + 1], p0, 0, 0, 0); p1 = __builtin_amdgcn_mfma_f32_32x32x16_bf16(b3, qf[2 * dh + 1], p1, 0, 0, 0);
        __builtin_amdgcn_s_setprio(0);
        if (dh == 0) __builtin_amdgcn_sched_barrier(0);
    }
}
__device__ __forceinline__ float max3f(float a, float b, float c) { float r; asm("v_max3_f32 %0, %1, %2, %3" : "=v"(r) : "v"(a), "v"(b), "v"(c)); return r; }
__device__ __forceinline__ void cinit_bits(f32x16& c, unsigned w, int hi, float negm) {
    const unsigned w2 = w >> (4 * hi), nb = __float_as_uint(negm);
#pragma unroll
    for (int r = 0; r < 16; ++r) { const unsigned mm = (unsigned)__builtin_amdgcn_sbfe((int)w2, crow(r, 0), 1); c[r] = __uint_as_float((nb & mm) | (0xFF800000u & ~mm)); }
}
__device__ __forceinline__ void cinit_splat(f32x16& c, float v) {
#pragma unroll
    for (int r = 0; r < 16; ++r) c[r] = v;
}
__device__ __forceinline__ void pv(f32x16* o, const LAS unsigned char* Vs, int lane, int hi, const u32x4 (&pw)[4]) {
    const LAS unsigned char* vb = Vs + ((lane >> 4) & 1) * 32 + (lane & 3) * 8 + (4 * hi + ((lane & 15) >> 2)) * 64;
#pragma unroll
    for (int d0 = 0; d0 < 2; ++d0) {
        s16x4 lo[4], hh[4];
#pragma unroll
        for (int ks = 0; ks < 4; ++ks) { lo[ks] = vtr(vb + d0 * 4096 + ks * 1024); hh[ks] = vtr(vb + d0 * 4096 + ks * 1024 + 512); }
        asm volatile("s_waitcnt lgkmcnt(0)" ::: "memory"); __builtin_amdgcn_sched_barrier(0);
        __builtin_amdgcn_s_setprio(1);
#pragma unroll
        for (int ks = 0; ks < 4; ++ks) { const bf16x8 vf = {lo[ks][0], lo[ks][1], lo[ks][2], lo[ks][3], hh[ks][0], hh[ks][1], hh[ks][2], hh[ks][3]};
            o[d0] = __builtin_amdgcn_mfma_f32_32x32x16_bf16(__builtin_bit_cast(bf16x8, pw[ks]), vf, o[d0], 0, 0, 0); }
        __builtin_amdgcn_s_setprio(0);
    }
}
__device__ __forceinline__ void softmax_step(f32x16& p0, f32x16& p1, float& m, float& l, f32x16* o, LAS float* wsf, int r32, int hi, u32x4 (&pw)[4]) {
    float rm = fmaxf(p0[0], p1[0]);
#pragma unroll
    for (int r = 1; r < 16; ++r) rm = fmaxf(rm, fmaxf(p0[r], p1[r]));
    rm = fmaxf(rm, __shfl_xor(rm, 32));
    if (__any(rm > m)) {
        const float mn = fmaxf(m, rm), f = ex2(m - mn);
        l *= f; m = mn;
        if (hi == 0) wsf[r32] = f;
#pragma unroll
        for (int r = 0; r < 16; ++r) { const float fr = wsf[crow(r, hi)]; o[0][r] *= fr; o[1][r] *= fr; }
    }
    float s = 0.f;
#pragma unroll
    for (int r = 0; r < 16; ++r) { p0[r] = ex2(p0[r] - m); p1[r] = ex2(p1[r] - m); s += p0[r] + p1[r]; }
    l += s;
    pw[0] = u32x4{cvtpk(p0[0], p0[1]), cvtpk(p0[2], p0[3]), cvtpk(p0[4], p0[5]), cvtpk(p0[6], p0[7])};
    pw[1] = u32x4{cvtpk(p0[8], p0[9]), cvtpk(p0[10], p0[11]), cvtpk(p0[12], p0[13]), cvtpk(p0[14], p0[15])};
    pw[2] = u32x4{cvtpk(p1[0], p1[1]), cvtpk(p1[2], p1[3]), cvtpk(p1[4], p1[5]), cvtpk(p1[6], p1[7])};
    pw[3] = u32x4{cvtpk(p1[8], p1[9]), cvtpk(p1[10], p1[11]), cvtpk(p1[12], p1[13]), cvtpk(p1[14], p1[15])};
}
__device__ __forceinline__ void mask_bits(f32x16& p, unsigned w, int hi) {
    const unsigned w2 = w >> (4 * hi);
#pragma unroll
    for (int r = 0; r < 16; ++r) p[r] = ((w2 >> crow(r, 0)) & 1u) ? p[r] : NEG_INF;
}
constexpr float THRL = 8.f;
__device__ __forceinline__ void partialSM(f32x16& p0, f32x16& p1, float& m_reg, float& alpha, bool& seen) {
    float a = max3f(p0[0], p0[1], p1[0]), b = max3f(p0[2], p0[3], p1[1]); a = max3f(a, p1[2], p1[3]);
#pragma unroll
    for (int r = 4; r < 16; r += 4) { a = max3f(a, p0[r], p0[r + 1]); b = max3f(b, p0[r + 2], p0[r + 3]); a = max3f(a, p1[r], p1[r + 1]); b = max3f(b, p1[r + 2], p1[r + 3]); }
    float pmax = max3f(a, b, b);
    { auto rr = __builtin_amdgcn_permlane32_swap(__float_as_uint(pmax), __float_as_uint(pmax), false, false); pmax = max3f(__uint_as_float(rr[0]), __uint_as_float(rr[1]), __uint_as_float(rr[1])); }
    const bool fin = pmax > NEG_INF, init = fin && !seen, up = seen && pmax > THRL;
    alpha = 1.f;
    if (__builtin_expect(__any(init || up), 0)) { const float dl = (init || up) ? pmax : 0.f; alpha = up ? ex2(-dl) : 1.f; m_reg += dl;
#pragma unroll
        for (int r = 0; r < 16; ++r) { p0[r] -= dl; p1[r] -= dl; } }
    seen = seen || fin;
#pragma unroll
    for (int r = 0; r < 16; ++r) p0[r] = ex2(p0[r]);
}
__device__ __forceinline__ void finishSM(f32x16& p0, f32x16& p1, float alpha, float& l_reg, u32x4 (&pw)[4]) {
#pragma unroll
    for (int r = 0; r < 16; ++r) p1[r] = ex2(p1[r]);
    float ps = 0.f;
#pragma unroll
    for (int r = 0; r < 16; ++r) ps += p0[r] + p1[r];
    l_reg = l_reg * alpha + ps;
    pw[0] = u32x4{cvtpk(p0[0], p0[1]), cvtpk(p0[2], p0[3]), cvtpk(p0[4], p0[5]), cvtpk(p0[6], p0[7])};
    pw[1] = u32x4{cvtpk(p0[8], p0[9]), cvtpk(p0[10], p0[11]), cvtpk(p0[12], p0[13]), cvtpk(p0[14], p0[15])};
    pw[2] = u32x4{cvtpk(p1[0], p1[1]), cvtpk(p1[2], p1[3]), cvtpk(p1[4], p1[5]), cvtpk(p1[6], p1[7])};
    pw[3] = u32x4{cvtpk(p1[8], p1[9]), cvtpk(p1[10], p1[11]), cvtpk(p1[12], p1[13]), cvtpk(p1[14], p1[15])};
}
__device__ __forceinline__ void rescale_o(f32x16* o, float alpha, LAS float* wsf, int r32, int hi) {
    if (__any(alpha < 1.f)) { if (hi == 0) wsf[r32] = alpha;
#pragma unroll
        for (int r = 0; r < 16; ++r) { const float fr = wsf[crow(r, hi)]; o[0][r] *= fr; o[1][r] *= fr; } }
}
#define SBAR_() __builtin_amdgcn_sched_barrier(0)
template <class Stg, class MaskF>
__device__ __forceinline__ void flash_loop(int t0, int nt, Stg& sg, const MaskF& mk, const bf16x8* qf, LAS unsigned char* kb, LAS unsigned char* vb, int bstride,
                                           float& m_reg, float& l_reg, f32x16* o, LAS float* wsf, int lane, int r32, int hi, bool preloaded = false) {
    f32x16 pA0, pA1, pB0, pB1; float alA = 1.f, alB = 1.f; u32x4 pw[4]; bool seen = false;
    if (!preloaded) sg.load(t0);
    sg.store(0); __syncthreads();
    if (nt > 1) sg.load(t0 + 1); else sg.load_after();
    mk(pA0, pA1, t0, -m_reg); qkt(pA0, pA1, kb, qf, r32, hi); mk.post(pA0, pA1, t0); partialSM(pA0, pA1, m_reg, alA, seen);
    if (nt > 1) sg.store(1);
    __syncthreads();
#define FL_STEP(C0, C1, ALC, P0, P1, ALP, J) do { const int cb_ = ((J) & 1) * bstride, pb_ = (((J) - 1) & 1) * bstride; \
        if ((J) + 1 < nt) sg.load(t0 + (J) + 1); else sg.load_after(); \
        mk(C0, C1, t0 + (J), -m_reg); SBAR_(); qkt(C0, C1, kb + cb_, qf, r32, hi); \
        finishSM(P0, P1, ALP, l_reg, pw); SBAR_(); \
        pv(o, vb + pb_, lane, hi, pw); mk.post(C0, C1, t0 + (J)); partialSM(C0, C1, m_reg, ALC, seen); \
        __syncthreads(); \
        if ((J) + 1 < nt) sg.store(((J) + 1) & 1); \
        rescale_o(o, ALC, wsf, r32, hi); \
        __syncthreads(); } while (0)
    int j = 1;
    for (; j + 1 < nt; j += 2) { FL_STEP(pB0, pB1, alB, pA0, pA1, alA, j); FL_STEP(pA0, pA1, alA, pB0, pB1, alB, j + 1); }
    if (j < nt) { FL_STEP(pB0, pB1, alB, pA0, pA1, alA, j); ++j; }
    if (nt & 1) { finishSM(pA0, pA1, alA, l_reg, pw); SBAR_(); pv(o, vb, lane, hi, pw); }
    else { finishSM(pB0, pB1, alB, l_reg, pw); SBAR_(); pv(o, vb + bstride, lane, hi, pw); }
#undef FL_STEP
    __syncthreads();
}
template <class Stg, class MaskF>
__device__ __forceinline__ void flash_loop_r(int t0, int nt, Stg& sg, const MaskF& mk, const bf16x8* qf, LAS unsigned char* kb, int kstride, LAS unsigned char* vb, int vstride,
                                             float& m_reg, float& l_reg, f32x16* o, LAS float* wsf, int lane, int r32, int hi, bool preloaded = false) {
    f32x16 pA0, pA1, pB0, pB1; float alA = 1.f, alB = 1.f; u32x4 pw[4]; bool seen = false;
    if (!preloaded) sg.load(t0);
    sg.store(0, 0); __syncthreads();
    if (nt > 1) sg.load(t0 + 1); else sg.load_after();
    mk(pA0, pA1, t0, -m_reg); qkt(pA0, pA1, kb, qf, r32, hi); mk.post(pA0, pA1, t0); partialSM(pA0, pA1, m_reg, alA, seen);
    if (nt > 1) sg.store(1, 1);
    __syncthreads();
    int vprev = 0, vcur = 1, vnext = 2;
#define FR_STEP(C0, C1, ALC, P0, P1, ALP, J) do { \
        if ((J) + 1 < nt) sg.load(t0 + (J) + 1); else sg.load_after(); \
        mk(C0, C1, t0 + (J), -m_reg); SBAR_(); qkt(C0, C1, kb + ((J) & 1) * kstride, qf, r32, hi); \
        finishSM(P0, P1, ALP, l_reg, pw); SBAR_(); \
        pv(o, vb + vprev * vstride, lane, hi, pw); mk.post(C0, C1, t0 + (J)); partialSM(C0, C1, m_reg, ALC, seen); \
        rescale_o(o, ALC, wsf, r32, hi); \
        if ((J) + 1 < nt) sg.store(((J) + 1) & 1, vnext); \
        __syncthreads(); \
        { const int t_ = vprev; vprev = vcur; vcur = vnext; vnext = t_; } } while (0)
    int j = 1;
    for (; j + 1 < nt; j += 2) { FR_STEP(pB0, pB1, alB, pA0, pA1, alA, j); FR_STEP(pA0, pA1, alA, pB0, pB1, alB, j + 1); }
    if (j < nt) { FR_STEP(pB0, pB1, alB, pA0, pA1, alA, j); ++j; }
    if (nt & 1) { finishSM(pA0, pA1, alA, l_reg, pw); SBAR_(); pv(o, vb + vprev * vstride, lane, hi, pw); }
    else { finishSM(pB0, pB1, alB, l_reg, pw); SBAR_(); pv(o, vb + vprev * vstride, lane, hi, pw); }
#undef FR_STEP
    __syncthreads();
}
template <class Stg, class MaskF>
__device__ __forceinline__ void flash_loop_b(int t0, int nt, Stg& sg, const MaskF& mk, const bf16x8* qf, LAS unsigned char* kb, LAS unsigned char* vb, int bstride,
                                             float& m_reg, float& l_reg, f32x16* o, LAS float* wsf, int lane, int r32, int hi, bool preloaded = false) {
    f32x16 c0, c1; u32x4 pw[4]; float alpha = 1.f; bool seen = false;
    if (!preloaded) sg.load(t0);
    sg.store(0); __syncthreads();
    if (nt > 1) sg.load(t0 + 1); else sg.load_after();
    mk(c0, c1, t0, -m_reg); qkt(c0, c1, kb, qf, r32, hi); mk.post(c0, c1, t0);
    partialSM(c0, c1, m_reg, alpha, seen); finishSM(c0, c1, alpha, l_reg, pw);
    if (nt > 1) sg.store(1);
    __syncthreads();
    for (int j = 1; j < nt; ++j) {
        const int cb_ = (j & 1) * bstride, pb_ = ((j - 1) & 1) * bstride;
        if (j + 1 < nt) sg.load(t0 + j + 1); else sg.load_after();
        mk(c0, c1, t0 + j, -m_reg); SBAR_(); qkt(c0, c1, kb + cb_, qf, r32, hi);
        pv(o, vb + pb_, lane, hi, pw);
        mk.post(c0, c1, t0 + j);
        partialSM(c0, c1, m_reg, alpha, seen); finishSM(c0, c1, alpha, l_reg, pw);
        __syncthreads();
        if (j + 1 < nt) sg.store((j + 1) & 1);
        rescale_o(o, alpha, wsf, r32, hi);
        __syncthreads();
    }
    pv(o, vb + ((nt - 1) & 1) * bstride, lane, hi, pw);
    __syncthreads();
}
__device__ __forceinline__ float stage_o(const f32x16* o, float ltot, LAS float* wsf, LAS float* stg, int lane, int r32, int hi) {
    if (hi == 0) wsf[r32] = 1.f / fmaxf(ltot, 1e-30f);
#pragma unroll
    for (int r = 0; r < 16; ++r) { const int q = crow(r, hi); const float rl = wsf[q]; stg[q * 64 + r32] = o[0][r] * rl; stg[q * 64 + 32 + r32] = o[1][r] * rl; }
    const LAS f32x4* rowp = (const LAS f32x4*)(stg + (lane >> 1) * 64 + (lane & 1) * 32); float ss = 0.f;
#pragma unroll
    for (int i = 0; i < 8; ++i) { const f32x4 v = rowp[i]; ss += (v[0] * v[0] + v[1] * v[1]) + (v[2] * v[2] + v[3] * v[3]); }
    ss += __shfl_xor(ss, 1);
    return ss;
}
__device__ __forceinline__ void store_o(const LAS float* stg, float rinv, const float* __restrict__ gain, bf16* __restrict__ dst, int lane) {
    const LAS f32x4* rowp = (const LAS f32x4*)(stg + (lane >> 1) * 64 + (lane & 1) * 32); const f32x4* gp = (const f32x4*)(gain + (lane & 1) * 32);
#if MIXED_F8
    u32x4* dp = (u32x4*)((unsigned char*)dst + (lane & 1) * 32);
#pragma unroll
    for (int i = 0; i < 2; ++i) { u32x4 o;
#pragma unroll
        for (int d = 0; d < 4; ++d) { const f32x4 a = rowp[4 * i + d] * rinv * gp[4 * i + d];
            int p = __builtin_amdgcn_cvt_pk_fp8_f32(a[0], a[1], 0, false); p = __builtin_amdgcn_cvt_pk_fp8_f32(a[2], a[3], p, true); o[d] = (unsigned)p; }
        dp[i] = o; }
#else
    u32x4* dp = (u32x4*)(dst + (lane & 1) * 32);
#pragma unroll
    for (int i = 0; i < 4; ++i) { const f32x4 a = rowp[2 * i] * rinv * gp[2 * i], b2 = rowp[2 * i + 1] * rinv * gp[2 * i + 1];
        dp[i] = u32x4{cvtpk(a[0], a[1]), cvtpk(a[2], a[3]), cvtpk(b2[0], b2[1]), cvtpk(b2[2], b2[3])}; }
#endif
}

constexpr int NB = 256, CAP = 64;
constexpr int L_IQ = 0, L_NRM = 16384, L_KV = 0, L_HIST = 32768, HSTR = 257  , L_MASK = 65792, L_CAND = 73984, L_QI = 90368, L_WSF = 98304, L_ROWSQ = 100352, L_STG = 32768;
typedef u32x2 DsaCand;
__device__ __forceinline__ int idx_bin(float v, float lo, float invw, bool filt) { const float f = (v - lo) * invw; int b = (int)f; b = b > NB - 1 ? NB - 1 : b; return (f >= 0.f) ? b : (filt ? -1 : 0); }
__device__ __forceinline__ void idx_tile(float (&idx)[16], const bf16x8 a0, const bf16x8 a1, const LAS unsigned char* iqs, const float (&w)[8], int lane) {
#pragma unroll
    for (int r = 0; r < 16; ++r) idx[r] = 0.f;
    const LAS bf16x8* fq = (const LAS bf16x8*)(iqs + lane * 16);
    bf16x8 b0 = fq[0], b1 = fq[64], n0 = fq[128], n1 = fq[192];
    f32x16 c = __builtin_amdgcn_mfma_f32_32x32x16_bf16(a0, b0, f32x16{}, 0, 0, 0);
    c = __builtin_amdgcn_mfma_f32_32x32x16_bf16(a1, b1, c, 0, 0, 0);
#pragma unroll
    for (int h = 0; h < 8; ++h) {
        f32x16 cn = c;
        if (h < 7) { b0 = n0; b1 = n1;
            if (h < 6) { n0 = fq[((h + 2) * 2 + 0) * 64]; n1 = fq[((h + 2) * 2 + 1) * 64]; }
            cn = __builtin_amdgcn_mfma_f32_32x32x16_bf16(a0, b0, f32x16{}, 0, 0, 0);
            cn = __builtin_amdgcn_mfma_f32_32x32x16_bf16(a1, b1, cn, 0, 0, 0); }
#pragma unroll
        for (int r = 0; r < 16; ++r) idx[r] = fmaf(w[h], fmaxf(c[r], 0.f), idx[r]);
        c = cn;
        __builtin_amdgcn_sched_barrier(0);
    }
#pragma unroll
    for (int r = 0; r < 16; ++r) idx[r] *= IDX_SCALE;
}
__device__ __forceinline__ void dsa_unit(LAS unsigned char* L, const bf16* __restrict__ act, const float* __restrict__ mix_gain, bf16* __restrict__ mixed, DsaCand* __restrict__ gcand, float* __restrict__ gidx, int b, int qt) {
    int tid = threadIdx.x; asm volatile("" : "+v"(tid));
    const int lane = tid & 63, r32 = lane & 31, hi = lane >> 5; const int w = __builtin_amdgcn_readfirstlane(tid >> 6);
    LAS unsigned* hist = (LAS unsigned*)(L + L_HIST); LAS unsigned* mask = (LAS unsigned*)(L + L_MASK); LAS DsaCand* cand = (LAS DsaCand*)(L + L_CAND);
    LAS unsigned* q_cnt = (LAS unsigned*)(L + L_QI); LAS int* q_B = (LAS int*)(L + L_QI + 128); LAS int* q_need = (LAS int*)(L + L_QI + 256);
    LAS float* wsf = (LAS float*)(L + L_WSF) + w * 64; LAS float* rowsq = (LAS float*)(L + L_ROWSQ);
    const int tq = qt * 32 + r32; const size_t rowq = (size_t)b * SEQ + tq; const bf16* ab = act + (size_t)b * SEQ * ACT_COLS;
    bf16x8 qf[4]; u32x4 kpre, vpre;
    const bf16* kg0 = ab + (size_t)lane * ACT_COLS + C_DK + 8 * w;
    const bf16* vg0 = ab + (size_t)(16 * (w & 3) + (lane >> 2)) * ACT_COLS + C_DV + 32 * (w >> 2) + 8 * (lane & 3);
    TIC(11); TIC(20);
    {
        if (w == 0) { __builtin_amdgcn_fence(__ATOMIC_ACQUIRE, "agent"); asm volatile("s_waitcnt vmcnt(0)" ::: "memory"); }
        const bf16* ar = act + rowq * ACT_COLS;
        const bf16x8 i0 = *(const bf16x8*)(ar + C_IQ + w * 32 + 8 * hi), i1 = *(const bf16x8*)(ar + C_IQ + w * 32 + 16 + 8 * hi);
        const u32x4 wv = *(const u32x4*)(ar + C_IW);
        for (int i = tid; i < (L_CAND - L_HIST) / 16; i += NT) ((LAS u32x4*)(L + L_HIST))[i] = u32x4{0u, 0u, 0u, 0u};
        if (tid < 128) ((LAS unsigned*)(L + L_QI))[tid] = (tid >= 32 && tid < 64) ? 0xFFFFFFFFu : 0u;
        __syncthreads();
        float wq[8];
        const LAS unsigned char* iqs = L + L_IQ; LAS float* nrm = (LAS float*)(L + L_NRM);
        {
            *(LAS bf16x8*)(L + L_IQ + ((w * 2 + 0) * 64 + lane) * 16) = i0; *(LAS bf16x8*)(L + L_IQ + ((w * 2 + 1) * 64 + lane) * 16) = i1;
            float n2 = 0.f;
#pragma unroll
            for (int j = 0; j < 8; ++j) { const float a = __uint_as_float(((unsigned)(unsigned short)i0[j]) << 16), c = __uint_as_float(((unsigned)(unsigned short)i1[j]) << 16); n2 += a * a + c * c; }
            n2 += __shfl_xor(n2, 32);
            if (hi == 0) nrm[w * 32 + r32] = n2;
        }
        {
#pragma unroll
          for (int e = 0; e < 4; ++e) { wq[2 * e] = __uint_as_float(wv[e] << 16); wq[2 * e + 1] = __uint_as_float(wv[e] & 0xffff0000u); } }
        __syncthreads();
        TOC(20);
        float lo = 0.f, invw = 0.f; bool filtF = true;
        if (qt >= 8) {
            float sk2;
            { const bf16x8 k0 = *(const bf16x8*)(ar + C_IK + 8 * hi), k1 = *(const bf16x8*)(ar + C_IK + 16 + 8 * hi); float s = 0.f;
#pragma unroll
              for (int j = 0; j < 8; ++j) { const float a = __uint_as_float(((unsigned)(unsigned short)k0[j]) << 16), c = __uint_as_float(((unsigned)(unsigned short)k1[j]) << 16); s += a * a + c * c; }
              sk2 = wave_sum(s) * (1.f / 1024.f); }
            float sm = 0.f, sv = 0.f;
#pragma unroll
            for (int h = 0; h < 8; ++h) { const float n2 = nrm[h * 32 + r32]; sm += wq[h] * sqrtf(n2); sv += wq[h] * wq[h] * n2; }
            const float sk = sqrtf(sk2), mu = IDX_SCALE * sk * 0.3989423f * sm, sig = fmaxf(IDX_SCALE * sk * sqrtf(0.3408f * sv), 1e-20f);
            const float tail = fminf(1.f, 700.f / (float)(tq + 1));
            const float zq = tail < 0.95f ? -__logf(tail / (1.f - tail)) * (1.f / 1.702f) : -6.f;
            LAS unsigned* q_fail = (LAS unsigned*)(L + L_QI + 384);
            for (int attempt = 0; attempt < 2; ++attempt) {
                const bool filt = attempt == 0; filtF = filt;
                lo = mu + (filt ? zq : -6.f) * sig; invw = (float)NB / ((mu + 6.f * sig) - lo);
                if (attempt == 1) { for (int i = tid; i < (L_MASK - L_HIST) / 16; i += NT) ((LAS u32x4*)(L + L_HIST))[i] = u32x4{0u, 0u, 0u, 0u}; __syncthreads(); }
                TIC(21);
                for (int repH = 0; repH < ((PROBE_DUP == 28) ? 2 : 1); ++repH) {
                    const float lo_h = (PROBE_DUP == 28 && repH == 0) ? 3.0e38f : lo;
                    const bf16* ikp = ab + (size_t)r32 * ACT_COLS + C_IK + 8 * hi;
                    bf16x8 a0 = *(const bf16x8*)(ikp + (size_t)w * 32 * ACT_COLS), a1 = *(const bf16x8*)(ikp + (size_t)w * 32 * ACT_COLS + 16);
                    for (int kt = w; kt <= qt; kt += 8) {
                        const bf16x8 c0 = a0, c1 = a1;
                        if (kt + 8 <= qt) { a0 = *(const bf16x8*)(ikp + (size_t)(kt + 8) * 32 * ACT_COLS); a1 = *(const bf16x8*)(ikp + (size_t)(kt + 8) * 32 * ACT_COLS + 16); }
                        float idx[16]; idx_tile(idx, c0, c1, iqs, wq, lane);
                        if (filt) { f32x4* gp = (f32x4*)(gidx + ((size_t)kt * 64 + lane) * 16);
#pragma unroll
                            for (int i = 0; i < 4; ++i) gp[i] = f32x4{idx[4 * i], idx[4 * i + 1], idx[4 * i + 2], idx[4 * i + 3]}; }
                        const int lim = tq - kt * 32 - 4 * hi;
#pragma unroll
                        for (int r = 0; r < 16; ++r) { const int bn = idx_bin(idx[r], lo_h, invw, filt);
                            if (crow(r, 0) <= lim && bn >= 0) { __hip_atomic_fetch_add(hist + r32 * HSTR + bn, 1u, __ATOMIC_RELAXED, __HIP_MEMORY_SCOPE_WORKGROUP);
#if PROBE_DUP == 26
                                __hip_atomic_fetch_add((LAS unsigned*)(L + 17408) + tid * 7 + (bn % 7), 1u, __ATOMIC_RELAXED, __HIP_MEMORY_SCOPE_WORKGROUP);
#endif
#if PROBE_DUP == 27
                                { LAS unsigned* pp = (LAS unsigned*)(L + 17408) + tid * 7 + (bn % 7); *pp = *pp + 1u; }
#endif
                            } }
                    }
                }
                asm volatile("s_waitcnt vmcnt(0)" ::: "memory");
                __syncthreads();
                TOC(21); TIC(22);
                {
                    const int grp = lane >> 4, sl = lane & 15, q = w * 4 + grp; const LAS unsigned* hrow = hist + q * HSTR + 16 * sl;
                    int c[16];
#pragma unroll
                    for (int i = 0; i < 16; ++i) c[i] = (int)hrow[i];
                    int cl = 0;
#pragma unroll
                    for (int i = 0; i < 16; ++i) cl += c[i];
                    int S = cl;
#pragma unroll
                    for (int o = 1; o < 16; o <<= 1) { const int v = __shfl_down(S, o, 16); if (sl + o < 16) S += v; }
                    const unsigned long long bal = __ballot(S >= IDX_TOPK);
                    const unsigned gb = (unsigned)(bal >> (16 * grp)) & 0xFFFFu;
                    if (gb == 0u) { if (sl == 0) q_fail[0] = 1u; }
                    else {
                        const int Lh = 31 - __clz((int)gb);
                        int above = S - cl, Bq = -1, ca = 0;
#pragma unroll
                        for (int i = 15; i >= 0; --i) { if (Bq < 0) { if (above + c[i] >= IDX_TOPK) { Bq = 16 * sl + i; ca = above; } else above += c[i]; } }
                        if (sl == Lh) { q_B[q] = Bq; q_need[q] = IDX_TOPK - ca; }
                    }
                }
                __syncthreads();
                TOC(22);
                const bool failed = q_fail[0] != 0u;
                if (!failed || attempt == 1) break;
                __syncthreads();
                if (tid == 0) q_fail[0] = 0u;
            }
        }
        TIC(23);
        const int Bq = q_B[r32];
        if (qt >= 8) {
            const f32x4* gp0 = (const f32x4*)(gidx + (size_t)lane * 16);
            f32x4 v0 = gp0[(size_t)w * 256], v1 = gp0[(size_t)w * 256 + 1], v2 = gp0[(size_t)w * 256 + 2], v3 = gp0[(size_t)w * 256 + 3];
            for (int kt = w; kt <= qt; kt += 8) {
                const float idx[16] = {v0[0], v0[1], v0[2], v0[3], v1[0], v1[1], v1[2], v1[3], v2[0], v2[1], v2[2], v2[3], v3[0], v3[1], v3[2], v3[3]};
                if (kt + 8 <= qt) { const f32x4* gn = gp0 + (size_t)(kt + 8) * 256; v0 = gn[0]; v1 = gn[1]; v2 = gn[2]; v3 = gn[3]; }
                unsigned word = 0u; const int lim = tq - kt * 32 - 4 * hi;
#pragma unroll
                for (int r = 0; r < 16; ++r) {
                    if (crow(r, 0) <= lim) { const int bn = idx_bin(idx[r], lo, invw, filtF);
                        if (bn > Bq) word |= 1u << crow(r, 0);
                        else if (bn == Bq) { const unsigned slot = __hip_atomic_fetch_add(q_cnt + r32, 1u, __ATOMIC_RELAXED, __HIP_MEMORY_SCOPE_WORKGROUP); const DsaCand cnd = {__float_as_uint(idx[r]), (unsigned)(kt * 32 + crow(r, hi))};
                            if (slot < (unsigned)CAP) cand[r32 * CAP + slot] = cnd;
                            gcand[(size_t)r32 * SEQ + slot] = cnd; } } }
                if (word) __hip_atomic_fetch_or(mask + r32 * 64 + kt, word << (4 * hi), __ATOMIC_RELAXED, __HIP_MEMORY_SCOPE_WORKGROUP);
            }
        } else {
            for (int kt = w; kt <= qt; kt += 8) { const int lim = tq - kt * 32 - 4 * hi; unsigned word = 0u;
#pragma unroll
                for (int r = 0; r < 16; ++r) if (crow(r, 0) <= lim) word |= 1u << crow(r, 0);
                if (word) __hip_atomic_fetch_or(mask + r32 * 64 + kt, word << (4 * hi), __ATOMIC_RELAXED, __HIP_MEMORY_SCOPE_WORKGROUP); }
        }
        asm volatile("s_waitcnt vmcnt(0)" ::: "memory");
        __syncthreads();
        TOC(23); TIC(24);
        { const bf16* qp = ab + (size_t)tq * ACT_COLS + C_DQ + w * 64 + 8 * hi;
#pragma unroll
          for (int d0 = 0; d0 < 4; ++d0) qf[d0] = *(const bf16x8*)(qp + d0 * 16);
          kpre = *(const u32x4*)kg0; vpre = *(const u32x4*)vg0; }
#pragma unroll 1
        for (int qq = 0; qq < ((PROBE_DUP == 29) ? 8 : 4); ++qq) {
            const int q = w * 4 + (qq & 3); const int nc = (int)q_cnt[q], need = q_need[q];
            if (nc <= CAP) {
                DsaCand me = {0u, 0u}; if (lane < nc) me = cand[q * CAP + lane];
                const float mv = __uint_as_float(me[0]); int rk = 0;
                for (int j = 0; j < nc; ++j) { const float ov = __uint_as_float((unsigned)__builtin_amdgcn_readlane((int)me[0], j)); const unsigned ok = (unsigned)__builtin_amdgcn_readlane((int)me[1], j);
                    rk += (ov > mv || (ov == mv && ok < me[1])) ? 1 : 0; }
                if (lane < nc && rk < need) __hip_atomic_fetch_or(mask + q * 64 + (me[1] >> 5), 1u << (me[1] & 31u), __ATOMIC_RELAXED, __HIP_MEMORY_SCOPE_WORKGROUP);
            } else {
                const unsigned long long* gc = (const unsigned long long*)(gcand + (size_t)q * SEQ);
                for (int i0 = 0; i0 < nc; i0 += 64) { const int i = i0 + lane;
                    if (i < nc) { const unsigned long long me = __hip_atomic_load(gc + i, __ATOMIC_RELAXED, __HIP_MEMORY_SCOPE_AGENT); const float mv = __uint_as_float((unsigned)me); const unsigned mk = (unsigned)(me >> 32); int rk = 0;
                        for (int j = 0; j < nc; ++j) { const unsigned long long ot = __hip_atomic_load(gc + j, __ATOMIC_RELAXED, __HIP_MEMORY_SCOPE_AGENT); const float ov = __uint_as_float((unsigned)ot); const unsigned ok = (unsigned)(ot >> 32);
                            rk += (ov > mv || (ov == mv && ok < mk)) ? 1 : 0; }
                        if (rk < need) __hip_atomic_fetch_or(mask + q * 64 + (mk >> 5), 1u << (mk & 31u), __ATOMIC_RELAXED, __HIP_MEMORY_SCOPE_WORKGROUP); } }
            }
        }
        __syncthreads();
    }
    TOC(24); TOC(11);
    TIC(12);
    const int ntile = (qt >> 1) + 1;
    struct DsaStg { const bf16* kg; const bf16* vg; LAS unsigned char* kdst; u32x4 kreg, vreg;
        __device__ __forceinline__ void load(int t) { kreg = *(const u32x4*)(kg + (size_t)t * 64 * ACT_COLS); vreg = *(const u32x4*)(vg + (size_t)t * 64 * ACT_COLS); }
        __device__ __forceinline__ void store(int ks, int vs) { *(LAS u32x4*)(kdst + ks * 8192) = kreg; *(LAS u32x4*)(kdst + 16384 + vs * 8192) = vreg; }
        __device__ __forceinline__ void load_after() {} };
    struct DsaMask { const LAS unsigned* mrow; int hi;
        __device__ __forceinline__ void operator()(f32x16& c0, f32x16& c1, int t, float negm) const { cinit_splat(c0, negm); cinit_splat(c1, negm); }
        __device__ __forceinline__ void post(f32x16& p0, f32x16& p1, int t) const { const u32x2 mw = *(const LAS u32x2*)(mrow + 2 * t); mask_bits(p0, mw[0], hi); mask_bits(p1, mw[1], hi); } };
    DsaStg sg; sg.kg = kg0; sg.vg = vg0; sg.kreg = kpre; sg.vreg = vpre;
    sg.kdst = L + L_KV + w * 1024 + lane * 16;
    DsaMask mk{mask + r32 * 64, hi};
    float m = 0.f, l = 0.f; f32x16 o[2]; o[0] = f32x16{}; o[1] = f32x16{};
    flash_loop_r(0, ntile, sg, mk, qf, L + L_KV, 8192, L + L_KV + 16384, 8192, m, l, o, wsf, lane, r32, hi, true);
    const float ltot = l + __shfl_xor(l, 32);
    LAS float* stg = (LAS float*)(L + L_STG) + w * 2048;
    const float ss = stage_o(o, ltot, wsf, stg, lane, r32, hi);
    if ((lane & 1) == 0) rowsq[w * 32 + (lane >> 1)] = ss;
    __syncthreads();
    float tot = 0.f;
#pragma unroll
    for (int h = 0; h < 8; ++h) tot += rowsq[h * 32 + (lane >> 1)];
    const float rinv = rsqrtf(tot * (1.f / 512.f) + LN_EPS);
    store_o(stg, rinv, mix_gain + w * 64, MIXED_F8 ? (bf16*)((unsigned char*)mixed + ((size_t)b * SEQ + qt * 32 + (lane >> 1)) * D_MODEL + w * 64) : mixed + ((size_t)b * SEQ + qt * 32 + (lane >> 1)) * D_MODEL + w * 64, lane);
    __syncthreads();
    TOC(12);
}
}


namespace cmp {
using att::bf16x8; using att::f32x16; using att::crow; using att::cvtpk;
__device__ __forceinline__ void compress_unit(LAS unsigned char* L, const bf16* __restrict__ act, const bf16* __restrict__ w1t, const bf16* __restrict__ w2t, const float* __restrict__ bias1,
                                              bf16* __restrict__ kcb, float* __restrict__ kcf, int u) {
    const int tid = threadIdx.x, lane = tid & 63, r32 = lane & 31, hi = lane >> 5; const int w = __builtin_amdgcn_readfirstlane(tid >> 6);
    const int cb = u & 3, g = (u >> 2) & 1, b = (u >> 3) & 15, kv = u >> 7;
    const int c = cb * 32 + r32, cc = c < N_C ? c : N_C - 1;
    LAS float* part = (LAS float*)L;
    {
        const bf16* arow = act + ((size_t)b * SEQ + cc * CMP_STRIDE) * ACT_COLS + (kv ? C_VCM : C_KCM) + g * 64 + 8 * hi;
        const bf16* wrow = w1t + ((size_t)kv * CMP_HIDDEN + r32) * 2048 + 8 * hi;
        f32x16 acc[4]; acc[0] = f32x16{}; acc[1] = f32x16{}; acc[2] = f32x16{}; acc[3] = f32x16{};
#pragma unroll 4
        for (int i = 0; i < 16; ++i) { const int s = 16 * w + i;
            const bf16x8 bfr_ = *(const bf16x8*)(arow + (size_t)(s >> 2) * ACT_COLS + 16 * (s & 3));
#pragma unroll
            for (int nb = 0; nb < 4; ++nb) { const bf16x8 af = *(const bf16x8*)(wrow + (size_t)nb * 32 * 2048 + 16 * s); acc[nb] = __builtin_amdgcn_mfma_f32_32x32x16_bf16(af, bfr_, acc[nb], 0, 0, 0); } }
#pragma unroll
        for (int nb = 0; nb < 4; ++nb)
#pragma unroll
            for (int r = 0; r < 16; ++r) part[((w * 4 + nb) * 16 + r) * 64 + lane] = acc[nb][r];
    }
    __syncthreads();
    f32x16 acc2[2]; acc2[0] = f32x16{}; acc2[1] = f32x16{};
    {
        const int nb = w >> 1, s2 = w & 1; float x[8];
#pragma unroll
        for (int j = 0; j < 8; ++j) { const int r = 8 * s2 + j; float a = 0.f;
#pragma unroll
            for (int p = 0; p < 8; ++p) a += part[((p * 4 + nb) * 16 + r) * 64 + lane];
            a += bias1[kv * CMP_HIDDEN + 32 * nb + crow(r, hi)];
            const float uu = 0.7978845608028654f * (a + 0.044715f * a * a * a); x[j] = 0.5f * a * (1.f + tanhf(uu)); }
        const att::u32x4 xb = {cvtpk(x[0], x[1]), cvtpk(x[2], x[3]), cvtpk(x[4], x[5]), cvtpk(x[6], x[7])};
#pragma unroll
        for (int db = 0; db < 2; ++db) { const bf16* wp = w2t + ((size_t)kv * 64 + 32 * db + r32) * CMP_HIDDEN + 32 * nb + 16 * s2 + 4 * hi;
            const att::u32x2 lo = *(const att::u32x2*)wp, hh = *(const att::u32x2*)(wp + 8);
            const att::u32x4 af = {lo[0], lo[1], hh[0], hh[1]};
            acc2[db] = __builtin_amdgcn_mfma_f32_32x32x16_bf16(__builtin_bit_cast(bf16x8, af), __builtin_bit_cast(bf16x8, xb), acc2[db], 0, 0, 0); }
    }
    __syncthreads();
#pragma unroll
    for (int db = 0; db < 2; ++db)
#pragma unroll
        for (int r = 0; r < 16; ++r) part[((w * 2 + db) * 16 + r) * 64 + lane] = acc2[db][r];
    __syncthreads();
#pragma unroll
    for (int i = 0; i < 4; ++i) { const int e = tid + i * NT;
        const int ln = e & 63, r = (e >> 6) & 15, db = e >> 10; float a = 0.f;
#pragma unroll
        for (int p = 0; p < 8; ++p) a += part[((p * 2 + db) * 16 + r) * 64 + ln];
        const int c2 = cb * 32 + (ln & 31), d = 32 * db + crow(r, ln >> 5);
        const float v = c2 < N_C ? a : 0.f;
        kcb[(((size_t)kv * BATCH + b) * 128 + c2) * 128 + g * 64 + d] = (bf16)f2bf(v);
        if (kcf && c2 < N_C) kcf[(size_t)kv * BATCH * N_C * 128 + ((size_t)(b * N_C + c2) * 2 + g) * 64 + d] = bfr(v); }
    __syncthreads();
}
}

namespace att {
constexpr int N_SLAB = 65536, N_OUT = 65536, N_WSF = 135168, N_ROWSQ = 137216, N_SEL = 138240, N_IMPF = 139264;
struct KvStage { u32x4 k[2], v[2]; };
__device__ __forceinline__ void kv_load(KvStage& st, const bf16* __restrict__ kbase, const bf16* __restrict__ vbase, int pitch, int key0, int w, int lane) {
    const bf16* kp = kbase + (size_t)(key0 + lane) * pitch + 8 * w; const bf16* vp = vbase + (size_t)(key0 + 16 * (w & 3) + (lane >> 2)) * pitch + 32 * (w >> 2) + 8 * (lane & 3);
    st.k[0] = *(const u32x4*)kp; st.k[1] = *(const u32x4*)(kp + 64); st.v[0] = *(const u32x4*)vp; st.v[1] = *(const u32x4*)(vp + 64);
}
__device__ __forceinline__ void kv_store(const KvStage& st, LAS unsigned char* slot, int w, int lane) {
    LAS unsigned char* d = slot + w * 1024 + lane * 16;
    *(LAS u32x4*)d = st.k[0]; *(LAS u32x4*)(d + 8192) = st.k[1]; *(LAS u32x4*)(d + 16384) = st.v[0]; *(LAS u32x4*)(d + 24576) = st.v[1];
}
__device__ __forceinline__ void pack_p(u32x4 (&pw)[4], const f32x16& p0, const f32x16& p1) {
    pw[0] = u32x4{cvtpk(p0[0], p0[1]), cvtpk(p0[2], p0[3]), cvtpk(p0[4], p0[5]), cvtpk(p0[6], p0[7])};
    pw[1] = u32x4{cvtpk(p0[8], p0[9]), cvtpk(p0[10], p0[11]), cvtpk(p0[12], p0[13]), cvtpk(p0[14], p0[15])};
    pw[2] = u32x4{cvtpk(p1[0], p1[1]), cvtpk(p1[2], p1[3]), cvtpk(p1[4], p1[5]), cvtpk(p1[6], p1[7])};
    pw[3] = u32x4{cvtpk(p1[8], p1[9]), cvtpk(p1[10], p1[11]), cvtpk(p1[12], p1[13]), cvtpk(p1[14], p1[15])};
}
template <bool FIRST> __device__ __forceinline__ void accum_out(LAS float* OUTw, const f32x16* o, float fac, LAS float* wsf, int r32, int hi) {
    if (hi == 0) wsf[r32] = fac;
#pragma unroll
    for (int r = 0; r < 16; ++r) { const int q = crow(r, hi); const float f = wsf[q];
        if (FIRST) { OUTw[q * 64 + r32] = f * o[0][r]; OUTw[q * 64 + 32 + r32] = f * o[1][r]; }
        else { OUTw[q * 64 + r32] += f * o[0][r]; OUTw[q * 64 + 32 + r32] += f * o[1][r]; } }
}
__device__ __forceinline__ void nsa_unit(LAS unsigned char* L, const bf16* __restrict__ act, const bf16* __restrict__ kcb, const float* __restrict__ mix_gain, bf16* __restrict__ mixed, int b, int qt,
                                         bool pre_valid  , volatile LAS unsigned* nextp  , bool& prefetched) {
    int tid = threadIdx.x; asm volatile("" : "+v"(tid));
    const int lane = tid & 63, r32 = lane & 31, hi = lane >> 5; const int w = __builtin_amdgcn_readfirstlane(tid >> 6); const int g = w >> 2;
    LAS float* slab = (LAS float*)(L + N_SLAB); LAS float* OUTw = (LAS float*)(L + N_OUT) + w * 2048; LAS float* wsf = (LAS float*)(L + N_WSF) + w * 64;
    LAS float* rowsq = (LAS float*)(L + N_ROWSQ); LAS unsigned* selmask = (LAS unsigned*)(L + N_SEL); LAS float* impf = (LAS float*)(L + N_IMPF);
    const int tq = qt * 32 + r32; const size_t rowq = (size_t)b * SEQ + tq; const bf16* ab = act + (size_t)b * SEQ * ACT_COLS;
    bf16x8 qf[4];
    { const bf16* qp = act + rowq * ACT_COLS + C_NQ + w * 64 + 8 * hi;
#pragma unroll
      for (int d0 = 0; d0 < 4; ++d0) qf[d0] = *(const bf16x8*)(qp + d0 * 16); }
    const bf16* gp = act + rowq * ACT_COLS + C_NG + w * 3;
    const float gate0 = bf2f(gp[0]);
    LAS unsigned char* slot0 = L; LAS unsigned char* slot1 = L + 32768;
    f32x16 o[2];
    struct NsaStg { const bf16* kbase; const bf16* vbase; const bf16* kafter; const bf16* vafter; int key_after; LAS unsigned char* slot0; int w, lane; KvStage st;
        __device__ __forceinline__ void load(int t) { kv_load(st, kbase, vbase, ACT_COLS, t * 64, w, lane); }
        __device__ __forceinline__ void store(int bsel) { kv_store(st, slot0 + bsel * 32768, w, lane); }
        __device__ __forceinline__ void load_after() { if (kafter) kv_load(st, kafter, vafter, ACT_COLS, key_after, w, lane); } };
    NsaStg sg; sg.slot0 = slot0; sg.w = w; sg.lane = lane;
    TIC(13);
    {
        const bf16* kc = kcb + (size_t)b * 128 * 128; const bf16* vc = kcb + (size_t)(BATCH + b) * 128 * 128;
        if (!pre_valid) { KvStage a0, a1; kv_load(a0, kc, vc, 128, 0, w, lane); kv_load(a1, kc, vc, 128, 64, w, lane); kv_store(a0, slot0, w, lane); kv_store(a1, slot1, w, lane); }
        __syncthreads();
        kv_load(sg.st, ab + C_KSL, ab + C_VSL, ACT_COLS, 0, w, lane);
        f32x16 p[4];
        p[0] = f32x16{}; p[1] = f32x16{}; p[2] = f32x16{}; p[3] = f32x16{};
        qkt(p[0], p[1], slot0 + g * 8192, qf, r32, hi); qkt(p[2], p[3], slot1 + g * 8192, qf, r32, hi);
        const int n_adm = tq >= 31 ? min((tq - 31) / 16 + 1, N_C) : 0;
        float rm = NEG_INF;
#pragma unroll
        for (int u = 0; u < 4; ++u)
#pragma unroll
            for (int r = 0; r < 16; ++r) { const int c = 32 * u + crow(r, hi); p[u][r] = c < n_adm ? p[u][r] : NEG_INF; rm = fmaxf(rm, p[u][r]); }
        rm = fmaxf(rm, __shfl_xor(rm, 32));
        const float mc = rm > NEG_INF ? rm : 0.f; float s = 0.f;
#pragma unroll
        for (int u = 0; u < 4; ++u)
#pragma unroll
            for (int r = 0; r < 16; ++r) { p[u][r] = ex2(p[u][r] - mc); s += p[u][r]; }
        s += __shfl_xor(s, 32);
        const float inv = 1.f / fmaxf(s, 1e-30f);
#pragma unroll
        for (int u = 0; u < 4; ++u)
#pragma unroll
            for (int r = 0; r < 16; ++r) p[u][r] *= inv;
        float xl[16];
#pragma unroll
        for (int u = 0; u < 4; ++u)
#pragma unroll
            for (int k = 0; k < 4; ++k) xl[u * 4 + k] = __shfl_xor(p[u][4 * k + 3], 32);
#pragma unroll
        for (int u = 0; u < 4; ++u)
#pragma unroll
            for (int k = 0; k < 4; ++k) {
                const float A = (p[u][4 * k] + p[u][4 * k + 1]) + (p[u][4 * k + 2] + p[u][4 * k + 3]);
                const float xprev = (u * 4 + k) > 0 ? xl[(u * 4 + k) > 0 ? u * 4 + k - 1 : 0] : 0.f;
                const float val = A + (hi ? xl[u * 4 + k] : xprev);
                slab[(w * 32 + r32) * 32 + 8 * u + 2 * k + hi] = val;
            }
        u32x4 pw[4]; o[0] = f32x16{}; o[1] = f32x16{};
        pack_p(pw, p[0], p[1]); pv(o, slot0 + 16384 + g * 8192, lane, hi, pw);
        pack_p(pw, p[2], p[3]); pv(o, slot1 + 16384 + g * 8192, lane, hi, pw);
        __syncthreads();
#pragma unroll
        for (int i = 0; i < 4; ++i) { const int e = tid + i * NT, j = e & 31, q = (e >> 5) & 31, gg = e >> 10;
            float v = ((slab[((gg * 4 + 0) * 32 + q) * 32 + j] + slab[((gg * 4 + 1) * 32 + q) * 32 + j]) + slab[((gg * 4 + 2) * 32 + q) * 32 + j]) + slab[((gg * 4 + 3) * 32 + q) * 32 + j];
            const int cur = (qt * 32 + q) >> 6;
            if (j == 0 || j == cur || j == cur - 1) v = 1.0e4f;
            if (j > cur) v = -1.0f;
            impf[e] = v; }
        __syncthreads();
#pragma unroll
        for (int i = 0; i < 4; ++i) { const int gq = i * 16 + (tid >> 5), j = tid & 31; const float v = impf[gq * 32 + j]; int rk = 0;
#pragma unroll
            for (int i2 = 0; i2 < 32; ++i2) { const float vi = impf[gq * 32 + i2]; rk += (vi > v || (vi == v && i2 < j)) ? 1 : 0; }
            const unsigned long long bal = __ballot(rk < SLC_COUNT);
            if ((tid & 31) == 0) selmask[gq] = (lane < 32) ? (unsigned)bal : (unsigned)(bal >> 32); }
        __syncthreads();
        accum_out<true>(OUTw, o, gate0, wsf, r32, hi);
    }
    TOC(13); TIC(14);
    const int T0 = (qt * 32 - 511) > 0 ? ((qt * 32 - 511) >> 6) : 0, T1 = qt >> 1;
    {
        struct SlcMask { unsigned sel; int tq, hi, last;
            __device__ __forceinline__ void operator()(f32x16& c0, f32x16& c1, int t, float negm) const { cinit_splat(c0, negm); cinit_splat(c1, negm); }
            __device__ __forceinline__ void post(f32x16& p0, f32x16& p1, int t) const { const bool on = (sel >> t) & 1u;
                if (t == last) { const int lim = on ? tq - t * 64 - 4 * hi : -1;
#pragma unroll
                    for (int r = 0; r < 16; ++r) { p0[r] = (crow(r, 0) <= lim) ? p0[r] : NEG_INF; p1[r] = (crow(r, 0) + 32 <= lim) ? p1[r] : NEG_INF; }
                } else {
#pragma unroll
                    for (int r = 0; r < 16; ++r) { p0[r] = on ? p0[r] : NEG_INF; p1[r] = on ? p1[r] : NEG_INF; }
                } } };
        const int ntile = (qt >> 1) + 1;
        sg.kbase = ab + C_KSL; sg.vbase = ab + C_VSL; sg.kafter = ab + C_KWN; sg.vafter = ab + C_VWN; sg.key_after = T0 * 64;
        SlcMask mk{selmask[g * 32 + r32], tq, hi, ntile - 1}; const float gate1 = bf2f(gp[1]);
        float m = 0.f, l = 0.f; o[0] = f32x16{}; o[1] = f32x16{};
        flash_loop_b(0, ntile, sg, mk, qf, slot0 + g * 8192, slot0 + 16384 + g * 8192, 32768, m, l, o, wsf, lane, r32, hi, true);
        const float ltot = l + __shfl_xor(l, 32);
        accum_out<false>(OUTw, o, gate1 / fmaxf(ltot, 1e-30f), wsf, r32, hi);
    }
    TOC(14); TIC(15);
    {
        struct WinMask { int tq, hi, qt;
            __device__ __forceinline__ void operator()(f32x16& c0, f32x16& c1, int t, float negm) const { cinit_splat(c0, negm); cinit_splat(c1, negm); }
            __device__ __forceinline__ void post(f32x16& p0, f32x16& p1, int t) const {
                if (t * 64 < qt * 32 - 480 || t * 64 + 63 > qt * 32) { const int lim = tq - t * 64 - 4 * hi;
#pragma unroll
                    for (int r = 0; r < 16; ++r) {
                        p0[r] = ((unsigned)(lim - crow(r, 0)) < (unsigned)WINDOW) ? p0[r] : NEG_INF; p1[r] = ((unsigned)(lim - crow(r, 0) - 32) < (unsigned)WINDOW) ? p1[r] : NEG_INF; }
                } } };
        sg.kbase = ab + C_KWN; sg.vbase = ab + C_VWN; sg.kafter = nullptr; sg.vafter = nullptr;
        WinMask mk{tq, hi, qt}; const float gate2 = bf2f(gp[2]);
        float m = 0.f, l = 0.f; o[0] = f32x16{}; o[1] = f32x16{};
        flash_loop_b(T0, T1 - T0 + 1, sg, mk, qf, slot0 + g * 8192, slot0 + 16384 + g * 8192, 32768, m, l, o, wsf, lane, r32, hi, true);
        const float ltot = l + __shfl_xor(l, 32);
        accum_out<false>(OUTw, o, gate2 / fmaxf(ltot, 1e-30f), wsf, r32, hi);
    }
    KvStage pre0, pre1;
    {
        const unsigned rn = (unsigned)__builtin_amdgcn_readfirstlane((int)*nextp); const int next_b = (rn < 2048u && rn >= 1024u) ? (int)(rn & 15u) : -1;
        prefetched = next_b >= 0;
        if (next_b >= 0) { const bf16* kcn = kcb + (size_t)next_b * 128 * 128; const bf16* vcn = kcb + (size_t)(BATCH + next_b) * 128 * 128;
            kv_load(pre0, kcn, vcn, 128, 0, w, lane); kv_load(pre1, kcn, vcn, 128, 64, w, lane); }
    }
    TOC(15); TIC(16);
    float ss = 0.f;
    { const LAS f32x4* rowp = (const LAS f32x4*)(OUTw + (lane >> 1) * 64 + (lane & 1) * 32);
#pragma unroll
      for (int i = 0; i < 8; ++i) { const f32x4 v = rowp[i]; ss += (v[0] * v[0] + v[1] * v[1]) + (v[2] * v[2] + v[3] * v[3]); }
      ss += __shfl_xor(ss, 1); }
    if ((lane & 1) == 0) rowsq[w * 32 + (lane >> 1)] = ss;
    if (prefetched) { kv_store(pre0, slot0, w, lane); kv_store(pre1, slot1, w, lane); }
    __syncthreads();
    float tot = 0.f;
#pragma unroll
    for (int h = 0; h < 8; ++h) tot += rowsq[h * 32 + (lane >> 1)];
    const float rinv = rsqrtf(tot * (1.f / 512.f) + LN_EPS);
    store_o(OUTw, rinv, mix_gain + 512 + w * 64, MIXED_F8 ? (bf16*)((unsigned char*)mixed + ((size_t)b * SEQ + qt * 32 + (lane >> 1)) * D_MODEL + 512 + w * 64) : mixed + ((size_t)b * SEQ + qt * 32 + (lane >> 1)) * D_MODEL + 512 + w * 64, lane);
    __syncthreads();
    TOC(16);
}
}
struct Args { const float* in[16]; float* out; unsigned char* ws; int ph_lo, ph_hi, li, pad; };
constexpr int N_PHASES = 8;
__global__ void __launch_bounds__(NT, 2) mk_fwd(Args args) {
    extern __shared__ __attribute__((aligned(16))) unsigned char lds_raw[];
    LAS unsigned char* lds = (LAS unsigned char*)lds_raw;
    volatile LAS unsigned* MISC = (volatile LAS unsigned*)(lds + MISC_OFF);
    const int tid = threadIdx.x, lane = tid & 63, wave = __builtin_amdgcn_readfirstlane(tid >> 6);
    const int G = gridDim.x; const int vcu = (G % 8 == 0) ? ((int)blockIdx.x % 8) * (G / 8) + (int)blockIdx.x / 8 : (int)blockIdx.x;
    unsigned char* ws = args.ws;
    gu32* ctl = (gu32*)(ws + WS_CTL);
    const float* x = args.in[0]; const int* pos = (const int*)args.in[1]; const float* w_in = args.in[2]; const float* b_in = args.in[3];
    const float* cmp_pos = args.in[4]; const float* cmp_w1 = args.in[5]; const float* cmp_w2 = args.in[6]; const float* mix_gain = args.in[7];
    const float* w_out = args.in[8]; const float* ln1_g = args.in[9]; const float* ln1_b = args.in[10]; const float* w_gate = args.in[11];
    const float* w_up = args.in[12]; const float* w_down = args.in[13]; const float* ln2_g = args.in[14]; const float* ln2_b = args.in[15];
    float* out = args.out;
    float* stats1 = (float*)(ws + CTL_STATS1); float* cs = (float*)(ws + CTL_CS); float* bs = cs + 5632;
    float* rope = (float*)(ws + WS_ROPE); float* biasP = (float*)(ws + WS_BIASP);
    bf16* Wt_in = (bf16*)(ws + WS_WIN); bf16* Wt_out = (bf16*)(ws + WS_WOUT); bf16* Wt_gu = (bf16*)(ws + WS_WGU); bf16* Wt_dn = (bf16*)(ws + WS_WDN);
    float* kcvc = (float*)(ws + WS_KC); bf16* kcb = (bf16*)(ws + WS_KCB); bf16* w1t = (bf16*)(ws + WS_W1T); bf16* w2t = (bf16*)(ws + WS_W2T); float* cb1 = (float*)(ws + CTL_CB1);
    bf16* act = (bf16*)(ws + WS_ACT); bf16* actf = (bf16*)(ws + WS_ACTF); bf16* xb = (bf16*)(ws + WS_XB); bf16* mixed = (bf16*)(ws + WS_MIXED); unsigned char* v1q = ws + WS_GCAND; unsigned char* actq = ws + WS_ACTF;
    bf16* v1b = (bf16*)(ws + WS_V1B); bf16* v2b = (bf16*)(ws + WS_MIXED);

    for (int u = tid; u < (LDS_BYTES - LDSCTL_OFF) / 4; u += NT) ((LAS unsigned*)(lds + LDSCTL_OFF))[u] = 0u;
    __syncthreads();
#if PROBE_T >= 0
    if (blockIdx.x == 0 && tid == 0) t_acc = 0ull;
#endif
    XcdBarrier bar = xcd_barrier_post((unsigned*)(ctl + CW_BAR) + args.li * XCD_BAR_WORDS, MISC + 8);
    const int lo = args.ph_lo, hi = args.ph_hi;
#ifndef PROBE_DUP
#define PROBE_DUP -1
#endif
#define NREP(k) ((PROBE_DUP == (k)) ? 2 : 1)
#define IN(k) (lo <= (k) && (k) < hi)
#define SEAM(k) do { if (IN(k) && IN((k) + 1)) { TIC(8); TIC(60 + (k)); xcd_barrier(bar); TOC(60 + (k)); TOC(8); } } while (0)

    TIC(0);
    if (IN(0)) for (int rep = 0; rep < NREP(0); ++rep) {
        float* cs_ = (rep == NREP(0) - 1) ? cs : nullptr;
        const int gw = vcu * NWAVES + wave, NGW = G * NWAVES;
        constexpr int I_IN = 16 * 36, I_OUT = 16 * 16, I_GU = 16 * 88, I_DN = 44 * 16, I_W1 = 2 * 64, I_W2 = 2 * 2, NITEMS = I_IN + I_OUT + I_GU + I_DN + I_W1 + I_W2;
        TIC(30);
        for (int it = gw; it < NITEMS; it += NGW) {
            int r = it;
            if (r < I_GU) { const int kb = r / 88, nb = r % 88, n0 = 64 * nb, pn = n0 >> 8, within = n0 & 255; const bool isup = within >= 128;
                tr64<true>(isup ? w_up : w_gate, FFN, 1024, Wt_gu, n0, 64 * kb, pn * 128 + (within & 127) + lane, ln1_g, S_GU, ln1_b, cs_, cs_ ? bs : nullptr, lane); continue; } r -= I_GU;
            if (r < I_DN) { const int kb = r / 16, nb = r % 16; tr64<true>(w_down, 1024, FFN, Wt_dn, 64 * nb, 64 * kb, 64 * nb + lane, nullptr, S_DN, nullptr, nullptr, nullptr, lane); continue; } r -= I_DN;
            if (r < I_IN) { const int kb = r / 36, nb = r % 36; tr64<false>(w_in, IN_COLS, 1024, Wt_in, 64 * nb, 64 * kb, orig_col(64 * nb + lane), nullptr, 1.f, nullptr, nullptr, nullptr, lane); continue; } r -= I_IN;
            if (r < I_OUT) { const int kb = r / 16, nb = r % 16; if (MIXED_F8) tr64<true>(w_out, 1024, 1024, Wt_out, 64 * nb, 64 * kb, 64 * nb + lane, nullptr, S_OUT, nullptr, nullptr, nullptr, lane); else tr64<false>(w_out, 1024, 1024, Wt_out, 64 * nb, 64 * kb, 64 * nb + lane, nullptr, 1.f, nullptr, nullptr, nullptr, lane); continue; } r -= I_OUT;
            if (r < I_W1) { const int kv = r >> 6, kb = (r >> 1) & 31, nb = r & 1;
                tr64<false>(cmp_w1 + (size_t)kv * 2048 * 128, 128, 2048, w1t + (size_t)kv * 128 * 2048, 64 * nb, 64 * kb, 64 * nb + lane, nullptr, 1.f, cmp_pos + kv * 2048, nullptr, cs_ ? cb1 + kv * 128 : nullptr, lane); continue; } r -= I_W1;
            { const int kv = r >> 1, kb = r & 1; tr64<false>(cmp_w2 + (size_t)kv * 128 * 64, 64, 128, w2t + (size_t)kv * 64 * 128, 0, 64 * kb, lane, nullptr, 1.f, nullptr, nullptr, nullptr, lane); }
        }
        TOC(30); TIC(31);
        for (int m0 = gw * 4; m0 < T; m0 += NGW * 4) {
            f32x4 v[4][2][2];
#pragma unroll
            for (int rr = 0; rr < 4; ++rr)
#pragma unroll
                for (int j = 0; j < 2; ++j) { const GAS f32x4* xr = (const GAS f32x4*)(x + (size_t)(m0 + rr) * 1024 + 512 * j) + 2 * lane; v[rr][j][0] = xr[0]; v[rr][j][1] = xr[1]; }
#pragma unroll
            for (int rr = 0; rr < 4; ++rr)
#pragma unroll
                for (int j = 0; j < 2; ++j) { v4u o; o.x = pk2(v[rr][j][0].x, v[rr][j][0].y); o.y = pk2(v[rr][j][0].z, v[rr][j][0].w); o.z = pk2(v[rr][j][1].x, v[rr][j][1].y); o.w = pk2(v[rr][j][1].z, v[rr][j][1].w);
                    *((GAS v4u*)(xb + (size_t)(m0 + rr) * 1024 + 512 * j) + lane) = o; }
        }
        TOC(31); TIC(32);
        for (int i = gw * 64 + lane; i < T * 8; i += NGW * 64) {
            const float inv[8] = {1.0f, 0.19392274474868576f, 0.03760603093086393f, 0.007292664737217109f, 0.001414213562373095f, 0.0002742481756762073f, 5.318295896944988e-05f, 1.031338537721246e-05f};
            const int t = i >> 3, j = i & 7; float sn, cn; sincosf((float)pos[t] * inv[j], &sn, &cn);
            rope[2 * i] = cn; rope[2 * i + 1] = sn;
        }
        for (int i = gw * 64 + lane; i < ACT_COLS; i += NGW * 64) { const int oc = orig_col(i); biasP[i] = oc >= 0 ? b_in[oc] : 0.f; }
        TOC(32);
    }
    TOC(0);
    SEAM(0);
    TIC(1);
    if (IN(1)) for (int rep = 0; rep < NREP(1); ++rep) {
        pg8::Gemm g{xb, Wt_in, T, ACT_COLS, 1024}; pg8::StaticOrder S; S.init(T, ACT_COLS, G, (int)blockIdx.x);
        pg8::EpiInProj E{act, biasP, rope, att::C2};
        pg8::gemm_phase<pg8::EpiInProj, pg8::StaticOrder, true, true>(lds, g, S, E);
    }
    TOC(1);
    SEAM(1);
#if PROBE_T == 50
    unsigned long long sp_t0 = __builtin_amdgcn_s_memrealtime();
#endif
    TIC(2);
    if (IN(2)) for (int rep = 0; rep < NREP(2); ++rep) {
        gu32* cmp_cnt = ctl + 8192;
        TIC(10);
        for (int u = vcu; u < 256; u += G) { cmp::compress_unit(lds, act, w1t, w2t, cb1, kcb, nullptr, u);
            asm volatile("s_waitcnt vmcnt(0)" ::: "memory"); __syncthreads();
            if (tid == 0 && rep == NREP(2) - 1) { __builtin_amdgcn_fence(__ATOMIC_RELEASE, "agent"); asm volatile("s_waitcnt vmcnt(0)" ::: "memory"); __hip_atomic_fetch_add(cmp_cnt, 1u, RLX_AGENT); } }
        TOC(10);
        att::DsaCand* gcand = (att::DsaCand*)(ws + WS_GCAND) + (size_t)blockIdx.x * 32 * SEQ;
        float* gidx = (float*)(ws + WS_V1B) + (size_t)blockIdx.x * 65536;
        gu32* qhead = ctl + 8320;
        if (tid == 0) MISC[12] = __hip_atomic_fetch_add(qhead, 1u, RLX_AGENT);
        __syncthreads();
        bool cmp_ok = false;
        for (int k = 0;;) {
            unsigned r = (unsigned)__builtin_amdgcn_readfirstlane((int)MISC[12 + (k & 1)]);
            if (r >= 2048u) break;
            if (tid == 0) MISC[12 + ((k + 1) & 1)] = __hip_atomic_fetch_add(qhead, 1u, RLX_AGENT);
            if (r < 1024u) { att::dsa_unit(lds, act, mix_gain, mixed, gcand, gidx, (int)(r & 15u), 63 - (int)(r >> 4)); ++k; continue; }
            if (!cmp_ok) {
                if (tid == 0) { unsigned sp = 0; while (__hip_atomic_load(cmp_cnt, RLX_AGENT) < 256u) { __builtin_amdgcn_s_sleep(2); if (++sp > (1u << 22)) break; }
                    __builtin_amdgcn_fence(__ATOMIC_ACQUIRE, "agent"); asm volatile("s_waitcnt vmcnt(0)" ::: "memory"); }
                __syncthreads(); cmp_ok = true; }
            bool pre_valid = false;
            for (;;) {
                bool pf = false; att::nsa_unit(lds, act, kcb, mix_gain, mixed, (int)(r & 15u), 63 - (int)((r - 1024u) >> 4), pre_valid, MISC + 12 + ((k + 1) & 1), pf);
                ++k;
                if (!pf) break;
                r = (unsigned)__builtin_amdgcn_readfirstlane((int)MISC[12 + (k & 1)]); pre_valid = true;
                if (tid == 0) MISC[12 + ((k + 1) & 1)] = __hip_atomic_fetch_add(qhead, 1u, RLX_AGENT);
            }
        }
    }
    TOC(2);
#if PROBE_T == 50
    if (tid == 0) { const unsigned long long d = __builtin_amdgcn_s_memrealtime() - sp_t0; atomicMax((unsigned long long*)(ctl + 8200), d); atomicMax((unsigned long long*)(ctl + 8202), 1000000000ull - d); }
#endif
    SEAM(3);
    TIC(4);
    if (IN(4)) for (int rep = 0; rep < NREP(4); ++rep) {
        pg8::Gemm g{mixed, Wt_out, T, 1024, 1024}; pg8::StaticOrder S; S.init(T, 1024, G, (int)blockIdx.x);
        pg8::EpiOutProj E{xb, v1b, v1q, (rep == NREP(4) - 1) ? stats1 : nullptr, ALPHA, MIXED_F8 ? 1.f / S_OUT : 1.f};
        if constexpr (MIXED_F8) pg8::gemm_phase<pg8::EpiOutProj, pg8::StaticOrder, true, true, true>(lds, g, S, E); else pg8::gemm_phase<pg8::EpiOutProj, pg8::StaticOrder, true, true>(lds, g, S, E);
    }
    TOC(4);
    SEAM(4);
    TIC(5);
    if (IN(5)) for (int rep = 0; rep < NREP(5); ++rep) {
        pg8::Gemm g{(const bf16*)v1q, Wt_gu, T, 2 * FFN, 1024}; pg8::StaticOrder S; S.init(T, 2 * FFN, G, (int)blockIdx.x);
        pg8::EpiGateUp E{actf, actq, stats1, cs, bs, 1.f / S_GU};
        pg8::gemm_phase<pg8::EpiGateUp, pg8::StaticOrder, true, true, true>(lds, g, S, E);
    }
    TOC(5);
#if PROBE_T == 40
    { xcd_barrier(bar); TIC(40);
      pg8::Gemm g{(const bf16*)v1q, Wt_gu, T, 2 * FFN, 1024}; pg8::StaticOrder S; S.init(T, 2 * FFN, G, (int)blockIdx.x);
      pg8::EpiNull E{(float*)(ws + WS_MIXED)};
      pg8::gemm_phase<pg8::EpiNull, pg8::StaticOrder, true, true, true>(lds, g, S, E); TOC(40); }
#endif
    SEAM(5);
    TIC(6);
    if (IN(6)) for (int rep = 0; rep < NREP(6); ++rep) {
        pg8::Gemm g{(const bf16*)actq, Wt_dn, T, 1024, FFN}; pg8::StaticOrder S; S.init(T, 1024, G, (int)blockIdx.x);
#ifdef NO_LN2_FUSE
        pg8::EpiDown E{v1b, v2b, stats1, ln1_g, ln1_b, ALPHA, 1.f / S_DN};
        pg8::gemm_phase<pg8::EpiDown, pg8::StaticOrder, true, true, true>(lds, g, S, E);
#else
        pg8::RowStatsX rx{(unsigned long long*)(ws + WS_XCH), (unsigned*)(ctl + 16384), lds + 135168, LN_EPS};
        pg8::EpiDownLn E{v1b, out, stats1, ln1_g, ln1_b, ln2_g, ln2_b, ALPHA, 1.f / S_DN, rx};
        pg8::gemm_phase<pg8::EpiDownLn, pg8::StaticOrder, true, true, true>(lds, g, S, E);
#endif
    }
    TOC(6);
#ifdef NO_LN2_FUSE
    SEAM(6);
#endif
    TIC(7);
#ifdef NO_LN2_FUSE
    if (IN(7)) for (int rep = 0; rep < NREP(7); ++rep) {
        const int gw = vcu * NWAVES + wave, NGW = G * NWAVES;
        for (int m = gw; m < T; m += NGW) {
            const GAS v4u* xr = (const GAS v4u*)(v2b + (size_t)m * 1024) + lane; GAS f32x4* xw = (GAS f32x4*)(out + (size_t)m * 1024) + 2 * lane; f32x4 v[4]; float s = 0.f;
#pragma unroll
            for (int j = 0; j < 2; ++j) { const v4u t = xr[64 * j];
                v[2 * j] = f32x4{__uint_as_float(t[0] << 16), __uint_as_float(t[0] & 0xffff0000u), __uint_as_float(t[1] << 16), __uint_as_float(t[1] & 0xffff0000u)};
                v[2 * j + 1] = f32x4{__uint_as_float(t[2] << 16), __uint_as_float(t[2] & 0xffff0000u), __uint_as_float(t[3] << 16), __uint_as_float(t[3] & 0xffff0000u)}; }
#pragma unroll
            for (int j = 0; j < 4; ++j) s += (v[j].x + v[j].y) + (v[j].z + v[j].w);
            const float mean = wave_sum(s) * (1.f / 1024.f); float s2 = 0.f;
#pragma unroll
            for (int j = 0; j < 4; ++j) { v[j] = v[j] - mean; s2 += (v[j].x * v[j].x + v[j].y * v[j].y) + (v[j].z * v[j].z + v[j].w * v[j].w); }
            const float rstd = rsqrtf(wave_sum(s2) * (1.f / 1024.f) + LN_EPS);
#pragma unroll
            for (int j = 0; j < 4; ++j) { const int ci = 2 * lane + (j & 1) + 128 * (j >> 1);
                const f32x4 gg = *((const f32x4*)ln2_g + ci), bb = *((const f32x4*)ln2_b + ci); xw[(j & 1) + 128 * (j >> 1)] = v[j] * rstd * gg + bb; }
        }
    }
#endif
    TOC(7);
#if PROBE_T == 50
    if (blockIdx.x == 0 && tid == 0) { const unsigned long long mx = __hip_atomic_load((unsigned long long*)(ctl + 8200), RLX_AGENT), mn = 1000000000ull - __hip_atomic_load((unsigned long long*)(ctl + 8202), RLX_AGENT); t_acc = mx - mn; }
#endif
#if PROBE_T >= 0
    if (blockIdx.x == 0 && tid == 0) { const unsigned long long t0 = __builtin_amdgcn_s_memrealtime(); while (__builtin_amdgcn_s_memrealtime() - t0 < t_acc) __builtin_amdgcn_s_sleep(8); }
#endif
#undef IN
#undef SEAM
}

extern "C" void kernel_launch(void* const* d_in, const int* in_sizes, int n_in, void* d_out, int out_size, void* d_ws, size_t ws_size, hipStream_t stream) {
    static int grid = 0;
    if (grid == 0) {
        if (n_in != 16 || in_sizes[0] != T * D_MODEL || out_size != T * D_MODEL || ws_size < WS_NEED) { fprintf(stderr, "kernel_launch: unexpected shapes / workspace (%d inputs, ws %zu); nothing launched\n", n_in, ws_size); grid = -1; return; }
        int dev = 0, cus = 0, per_cu = 0;
        if (hipGetDevice(&dev) != hipSuccess || hipDeviceGetAttribute(&cus, hipDeviceAttributeMultiprocessorCount, dev) != hipSuccess) { grid = -1; return; }
        if (hipFuncSetAttribute((const void*)mk_fwd, hipFuncAttributeMaxDynamicSharedMemorySize, LDS_BYTES) != hipSuccess) { fprintf(stderr, "kernel_launch: hipFuncSetAttribute failed\n"); grid = -1; return; }
        if (hipOccupancyMaxActiveBlocksPerMultiprocessor(&per_cu, (const void*)mk_fwd, NT, LDS_BYTES) != hipSuccess || per_cu < 1) { fprintf(stderr, "kernel_launch: occupancy query says %d blocks per CU; nothing launched\n", per_cu); (void)hipGetLastError(); grid = -1; return; }
        grid = cus;
    }
    if (grid < 0) return;
    if (hipMemsetAsync((char*)d_ws + WS_CTL, 0, CTL_ZERO_BYTES, stream) != hipSuccess) return;
    Args a{};
    for (int i = 0; i < 16; ++i) a.in[i] = (const float*)d_in[i];
    a.out = (float*)d_out; a.ws = (unsigned char*)d_ws;
#if MK_N_LAUNCHES == 1
    a.ph_lo = 0; a.ph_hi = N_PHASES; a.li = 0;
    hipLaunchKernelGGL(mk_fwd, dim3(grid), dim3(NT), LDS_BYTES, stream, a);
#else
    for (int p = 0; p < N_PHASES; ++p) { a.ph_lo = p; a.ph_hi = p + 1; a.li = 0; hipLaunchKernelGGL(mk_fwd, dim3(grid), dim3(NT), LDS_BYTES, stream, a); }
#endif
}
```

```cpp
#include <hip/hip_runtime.h>
#include <cstdio>
#include <cstdint>
#include <cmath>

#ifndef PROBE_DUP
#define PROBE_DUP -1
#endif
#ifndef PROBE_T
#define PROBE_T -1
#endif
#if PROBE_T >= 0
__device__ unsigned long long t_tic, t_acc;
#define TIC(k) do { if (PROBE_T == (k) && blockIdx.x == 0 && threadIdx.x == 0) { t_tic = __builtin_amdgcn_s_memrealtime(); } } while (0)
#define TOC(k) do { if (PROBE_T == (k) && blockIdx.x == 0 && threadIdx.x == 0) { t_acc += __builtin_amdgcn_s_memrealtime() - t_tic; } } while (0)
#else
#define TIC(k) do { } while (0)
#define TOC(k) do { } while (0)
#endif
#ifndef MIXED_F8
#define MIXED_F8 1
#endif
#ifndef MK_N_LAUNCHES
#define MK_N_LAUNCHES 1
#endif

constexpr int D_MODEL = 1024, BATCH = 16, SEQ = 2048, T = BATCH * SEQ;
constexpr int IDX_TOPK = 256;
constexpr int CMP_BLOCK = 32, CMP_STRIDE = 16, CMP_HIDDEN = 128, N_C = (SEQ - CMP_BLOCK) / CMP_STRIDE + 1;
constexpr int SLC_BLOCK = 64, SLC_COUNT = 8, N_S = SEQ / SLC_BLOCK, WINDOW = 512;
constexpr int FFN = 2816;
constexpr int IN_COLS = 2240, ACT_COLS = 2304;
constexpr float ALPHA = 1.189207115002721f;
constexpr float LN_EPS = 1e-5f;
constexpr float ATT_SCALE = 0.125f;
constexpr float IDX_SCALE = 0.0625f;
constexpr int C_DQ = 0, C_DK = 512, C_DV = 576, C_IQ = 640, C_NQ = 896, C_KCM = 1408, C_VCM = 1536, C_KSL = 1664, C_VSL = 1792,
              C_KWN = 1920, C_VWN = 2048, C_IK = 2176, C_IW = 2208, C_NG = 2216;
__host__ __device__ __forceinline__ int orig_col(int pc) {
    if (pc < 896) return pc;
    if (pc < 1408) return 936 + (pc - 896);
    if (pc < 2176) return 1448 + (pc - 1408);
    if (pc < 2208) return 904 + (pc - 2176);
    if (pc < 2216) return 896 + (pc - 2208);
    if (pc < IN_COLS) return pc;
    return -1;
}
constexpr size_t MiB = 1u << 20;
constexpr size_t WS_CTL = 0, CTL_ZERO_BYTES = 1 * MiB;
constexpr size_t CTL_STATS1 = 256 * 1024;
constexpr size_t CTL_CS = 512 * 1024;
constexpr size_t CTL_CB1 = 600 * 1024;
constexpr size_t WS_ROPE = 1 * MiB;
constexpr size_t WS_BIASP = 3 * MiB;
constexpr size_t WS_WIN = 4 * MiB;
constexpr size_t WS_WOUT = 9 * MiB;
constexpr size_t WS_WGU = 11 * MiB;
constexpr size_t WS_WDN = 22 * MiB;
constexpr size_t WS_W1T = 28 * MiB;
constexpr size_t WS_W2T = 29 * MiB;
constexpr size_t WS_CB1 = 29 * MiB + 512 * 1024;
constexpr size_t WS_KCB = 30 * MiB;
constexpr size_t WS_XCH = 36 * MiB;
constexpr size_t WS_KC = 32 * MiB;
constexpr size_t WS_ACT = 48 * MiB;
constexpr size_t WS_ACTF = 48 * MiB;
constexpr size_t WS_XB = 192 * MiB;
constexpr size_t WS_MIXED = 256 * MiB;
constexpr size_t WS_V1B = 320 * MiB;
constexpr size_t WS_GCAND = 384 * MiB;
constexpr size_t WS_NEED = 512 * MiB;

namespace pg8 {
#define PG8_LAS __attribute__((address_space(3)))
typedef unsigned short bf16_t;
typedef short bf16x8 __attribute__((ext_vector_type(8)));
typedef float f32x4 __attribute__((ext_vector_type(4)));
typedef unsigned u32x4 __attribute__((ext_vector_type(4)));
constexpr int BM = 256, BK = 64, HALF = 128, HTB = HALF * BK * 2  , STAGE_BYTES = 8 * HTB, NXCD = 8, WGM = 8;

__host__ __device__ __forceinline__ int lds_byte(int r, int c) { const int st = (r >> 4) * 2 + (c >> 5), rr = r & 15, cc = c & 31, ob = rr * 64 + cc * 2; return st * 1024 + (ob ^ (((ob >> 9) & 1) << 5)); }
__host__ __device__ __forceinline__ void stage_rc(int b, int& R, int& C) { const int st = b / 1024, sb = b % 1024, swz = sb ^ (((sb >> 9) & 1) << 5); R = (st >> 1) * 16 + swz / 64; C = (st & 1) * 32 + (swz % 64) / 2; }
__host__ __device__ __forceinline__ int perm32(int rho) { const int n = rho >> 4, i = rho & 15; return 8 * (i >> 2) + 4 * n + (i & 3); }

struct Unit { int pm, pn; };
struct Gemm { const bf16_t* A; const bf16_t* Bt; int M, N, K; };

struct StaticOrder {
    int nM, nN, nwg, G, c;
    __host__ __device__ void init(int M, int N, int G_, int c_) { nM = M / BM; nN = N / BM; nwg = nM * nN; G = G_; c = c_; }
    __host__ __device__ bool next(int i, Unit& u) const {
        const long L = (long)i * G + c; if (L >= nwg) return false;
        int wgid = (int)L; { const int q = nwg / NXCD, r = nwg % NXCD, xcd = wgid % NXCD, off = wgid / NXCD; wgid = (xcd < r ? xcd * (q + 1) : r * (q + 1) + (xcd - r) * q) + off; }
        const int nig = WGM * nN, gid = wgid / nig, fm = gid * WGM, gsz = (nM - fm) < WGM ? (nM - fm) : WGM;
        u.pm = fm + ((wgid % nig) % gsz); u.pn = (wgid % nig) / gsz; return true;
    }
    __device__ __forceinline__ void a_ready(const Unit&) const {}
    __device__ __forceinline__ void done(const Unit&) const {}
};
__device__ __forceinline__ unsigned cvt_pk_bf16(float lo, float hi) { unsigned r; asm volatile("v_cvt_pk_bf16_f32 %0, %1, %2" : "=v"(r) : "v"(lo), "v"(hi)); return r; }
typedef float f32x2 __attribute__((ext_vector_type(2)));
__device__ __forceinline__ f32x4 shflx16(f32x4 v) { f32x4 r; r[0] = __shfl_xor(v[0], 16); r[1] = __shfl_xor(v[1], 16); r[2] = __shfl_xor(v[2], 16); r[3] = __shfl_xor(v[3], 16); return r; }
typedef unsigned u32x2 __attribute__((ext_vector_type(2)));
__device__ __forceinline__ u32x2 pack8_f8(f32x4 a, f32x4 b) {
    int p0 = __builtin_amdgcn_cvt_pk_fp8_f32(a[0], a[1], 0, false); p0 = __builtin_amdgcn_cvt_pk_fp8_f32(a[2], a[3], p0, true);
    int p1 = __builtin_amdgcn_cvt_pk_fp8_f32(b[0], b[1], 0, false); p1 = __builtin_amdgcn_cvt_pk_fp8_f32(b[2], b[3], p1, true);
    return u32x2{(unsigned)p0, (unsigned)p1}; }
__device__ __forceinline__ u32x4 pack8(f32x4 a, f32x4 b) { u32x4 w; w.x = cvt_pk_bf16(a[0], a[1]); w.y = cvt_pk_bf16(a[2], a[3]); w.z = cvt_pk_bf16(b[0], b[1]); w.w = cvt_pk_bf16(b[2], b[3]); return w; }
struct EpiNull {
    static constexpr bool PERM = true, AFTER_DRAIN = false;
    float* o;
    __device__ __forceinline__ void operator()(const f32x4 (&acc)[2][2][4][2], const Unit& u, int wr, int wc, int fr, int fq) const {
        f32x4 s = acc[0][0][0][0];
#pragma unroll
        for (int ai = 0; ai < 2; ++ai)
#pragma unroll
            for (int bj = 0; bj < 2; ++bj)
#pragma unroll
                for (int m = 0; m < 4; ++m)
#pragma unroll
                    for (int n = 0; n < 2; ++n) s += acc[ai][bj][m][n];
        *(f32x4*)(o + ((size_t)(u.pm * 8 + u.pn % 8) * 512 + threadIdx.x) * 4) = s;
    }
};
struct EpiInProj {
    static constexpr bool PERM = true, AFTER_DRAIN = false;
    bf16_t* act; const float* biasP; const float* rope; float qscale;
    __device__ __forceinline__ void operator()(const f32x4 (&acc)[2][2][4][2], const Unit& u, int wr, int wc, int fr, int fq) const {
        const int row0 = u.pm * BM + wr * 64 + fr; const bool lo = (wc & 1) == 0;
#pragma unroll
        for (int bj = 0; bj < 2; ++bj) {
            const int cgb = u.pn * BM + bj * HALF + wc * 32, H = cgb >> 6, col0 = cgb + 8 * fq;
            const f32x4 b0 = *(const f32x4*)(biasP + col0), b1 = *(const f32x4*)(biasP + col0 + 4);
            const bool k64 = lo && ((0xCCFFC1FFull >> H) & 1ull), k32 = (H >= 10 && H <= 13) || (H == 34 && lo), ksig = (H == 34 && !lo);
            const float qs = (H < 8 || (H >= 14 && H < 22)) ? qscale : 1.f;
#pragma unroll
            for (int ai = 0; ai < 2; ++ai)
#pragma unroll
                for (int m = 0; m < 4; ++m) {
                    const int row = row0 + ai * HALF + m * 16;
                    f32x4 v0 = acc[ai][bj][m][0] + b0, v1 = acc[ai][bj][m][1] + b1;
                    if (k64) {
                        const f32x4 p0 = shflx16(v0), p1 = shflx16(v1);
                        if (fq < 2) {
                            const f32x4* rp = (const f32x4*)(rope + (size_t)row * 16); const f32x4 t0 = rp[0], t1 = rp[1], t2 = rp[2], t3 = rp[3];
                            const float sg = fq == 0 ? -1.f : 1.f;
                            v0[0] = v0[0] * t0[0] + sg * p0[0] * t0[1]; v0[1] = v0[1] * t0[2] + sg * p0[1] * t0[3];
                            v0[2] = v0[2] * t1[0] + sg * p0[2] * t1[1]; v0[3] = v0[3] * t1[2] + sg * p0[3] * t1[3];
                            v1[0] = v1[0] * t2[0] + sg * p1[0] * t2[1]; v1[1] = v1[1] * t2[2] + sg * p1[1] * t2[3];
                            v1[2] = v1[2] * t3[0] + sg * p1[2] * t3[1]; v1[3] = v1[3] * t3[2] + sg * p1[3] * t3[3];
                        }
                    } else if (k32) {
                        if (fq == 0) {
                            const f32x4* rp = (const f32x4*)(rope + (size_t)row * 16); const f32x4 t0 = rp[0], t1 = rp[1], t2 = rp[2], t3 = rp[3];
                            const f32x4 x1 = v0, x2 = v1;
                            v0[0] = x1[0] * t0[0] - x2[0] * t0[1]; v1[0] = x2[0] * t0[0] + x1[0] * t0[1];
                            v0[1] = x1[1] * t1[0] - x2[1] * t1[1]; v1[1] = x2[1] * t1[0] + x1[1] * t1[1];
                            v0[2] = x1[2] * t2[0] - x2[2] * t2[1]; v1[2] = x2[2] * t2[0] + x1[2] * t2[1];
                            v0[3] = x1[3] * t3[0] - x2[3] * t3[1]; v1[3] = x2[3] * t3[0] + x1[3] * t3[1];
                        }
                    } else if (ksig) {
                        if (fq >= 1) {
#pragma unroll
                            for (int e = 0; e < 4; ++e) { v0[e] = 1.f / (1.f + __expf(-v0[e])); v1[e] = 1.f / (1.f + __expf(-v1[e])); }
                        }
                    }
                    *(u32x4*)(act + (size_t)row * 2304 + col0) = pack8(v0 * qs, v1 * qs);
                }
        }
    }
};
struct EpiOutProj {
    static constexpr bool PERM = true, AFTER_DRAIN = false;
    const bf16_t* xb; bf16_t* v1b; unsigned char* v1q; float* stats; float alpha, inv_s;
    __device__ __forceinline__ void operator()(const f32x4 (&acc)[2][2][4][2], const Unit& u, int wr, int wc, int fr, int fq) const {
        const int row0 = u.pm * BM + wr * 64 + fr;
#pragma unroll
        for (int ai = 0; ai < 2; ++ai)
#pragma unroll
            for (int m = 0; m < 4; ++m) {
                const int row = row0 + ai * HALF + m * 16; float s = 0.f, q = 0.f;
#pragma unroll
                for (int bj = 0; bj < 2; ++bj) {
                    const size_t off = (size_t)row * 1024 + u.pn * BM + bj * HALF + wc * 32 + 8 * fq;
                    const u32x4 xv = *(const u32x4*)(xb + off);
                    const f32x4 xa = {__uint_as_float(xv[0] << 16), __uint_as_float(xv[0] & 0xffff0000u), __uint_as_float(xv[1] << 16), __uint_as_float(xv[1] & 0xffff0000u)};
                    const f32x4 xc = {__uint_as_float(xv[2] << 16), __uint_as_float(xv[2] & 0xffff0000u), __uint_as_float(xv[3] << 16), __uint_as_float(xv[3] & 0xffff0000u)};
                    const f32x4 a = xa * alpha + acc[ai][bj][m][0] * inv_s, b = xc * alpha + acc[ai][bj][m][1] * inv_s;
                    *(u32x4*)(v1b + off) = pack8(a, b); if (v1q) *(u32x2*)(v1q + off) = pack8_f8(a, b);
                    s += ((a[0] + a[1]) + (a[2] + a[3])) + ((b[0] + b[1]) + (b[2] + b[3]));
                    q += ((a[0] * a[0] + a[1] * a[1]) + (a[2] * a[2] + a[3] * a[3])) + ((b[0] * b[0] + b[1] * b[1]) + (b[2] * b[2] + b[3] * b[3]));
                }
                s += __shfl_xor(s, 16); s += __shfl_xor(s, 32); q += __shfl_xor(q, 16); q += __shfl_xor(q, 32);
                if (fq == 0 && stats) { atomicAdd(stats + 2 * row, s); atomicAdd(stats + 2 * row + 1, q); }
            }
    }
};
struct EpiGateUp {
    static constexpr bool PERM = true, AFTER_DRAIN = false;
    bf16_t* actf; unsigned char* actq; const float* stats; const float* cs; const float* bs; float inv_s;
    __device__ __forceinline__ void operator()(const f32x4 (&acc)[2][2][4][2], const Unit& u, int wr, int wc, int fr, int fq) const {
        const int row0 = u.pm * BM + wr * 64 + fr; const int ng = u.pn * BM + wc * 32 + 8 * fq, nu = ng + HALF, jc = u.pn * HALF + wc * 32 + 8 * fq;
        f32x4 csg[2], bsg[2], csu[2], bsu[2];
#pragma unroll
        for (int n = 0; n < 2; ++n) { csg[n] = *(const f32x4*)(cs + ng + 4 * n); bsg[n] = *(const f32x4*)(bs + ng + 4 * n); csu[n] = *(const f32x4*)(cs + nu + 4 * n); bsu[n] = *(const f32x4*)(bs + nu + 4 * n); }
#pragma unroll
        for (int ai = 0; ai < 2; ++ai)
#pragma unroll
            for (int m = 0; m < 4; ++m) {
                const int row = row0 + ai * HALF + m * 16;
                typedef float f2_t __attribute__((ext_vector_type(2)));
                const f2_t st = *(const f2_t*)(stats + 2 * row);
                const float mean = st[0] * (1.f / 1024.f), var = st[1] * (1.f / 1024.f) - mean * mean, rstd = __builtin_amdgcn_rsqf(fmaxf(var, 0.f) + 1e-5f);
                const float a1 = inv_s * rstd, a0 = -mean * rstd;
                f32x4 o[2];
#pragma unroll
                for (int n = 0; n < 2; ++n) {
                    const f32x4 g = acc[ai][0][m][n] * a1 + (csg[n] * a0 + bsg[n]), up = acc[ai][1][m][n] * a1 + (csu[n] * a0 + bsu[n]);
#pragma unroll
                    for (int e = 0; e < 4; ++e) o[n][e] = g[e] * __builtin_amdgcn_rcpf(1.f + __builtin_amdgcn_exp2f(g[e] * -1.4426950408889634f)) * up[e];
                }
                if (actq) *(u32x2*)(actq + (size_t)row * 2816 + jc) = pack8_f8(o[0], o[1]); else *(u32x4*)(actf + (size_t)row * 2816 + jc) = pack8(o[0], o[1]);
            }
    }
};
struct RowStatsX {
    unsigned long long* xbuf;
    unsigned* cnt;
    PG8_LAS unsigned char* tab;
    float eps;
    __device__ __forceinline__ void run(const f32x4 (&v)[2][2][4][2], const Unit& u, int wr, int wc, int fr, int fq, int wid, int lane) const {
        typedef float f32x2v __attribute__((ext_vector_type(2)));
        PG8_LAS f32x2v* P = (PG8_LAS f32x2v*)tab; PG8_LAS f32x2v* S = (PG8_LAS f32x2v*)(tab + 8192);
#pragma unroll
        for (int ai = 0; ai < 2; ++ai)
#pragma unroll
            for (int m = 0; m < 4; ++m) {
                float s = 0.f;
#pragma unroll
                for (int bj = 0; bj < 2; ++bj)
#pragma unroll
                    for (int n = 0; n < 2; ++n) { const f32x4 x = v[ai][bj][m][n]; s += (x[0] + x[1]) + (x[2] + x[3]); }
                s += __shfl_xor(s, 16); s += __shfl_xor(s, 32);
                const float mw = s * (1.0f / 64.0f); float q = 0.f;
#pragma unroll
                for (int bj = 0; bj < 2; ++bj)
#pragma unroll
                    for (int n = 0; n < 2; ++n) { const f32x4 d = v[ai][bj][m][n] - mw; q += (d[0] * d[0] + d[1] * d[1]) + (d[2] * d[2] + d[3] * d[3]); }
                q += __shfl_xor(q, 16); q += __shfl_xor(q, 32);
                if (fq == 0) P[(ai * HALF + wr * 64 + m * 16 + fr) * 4 + wc] = (f32x2v){mw, q};
            }
        asm volatile("s_waitcnt lgkmcnt(0)" ::: "memory"); __builtin_amdgcn_s_barrier(); asm volatile("" ::: "memory");
        const int row = wid * 32 + (lane & 31);
        if (lane < 32) {
            const f32x2v a = P[row * 4 + 0], b = P[row * 4 + 1], c = P[row * 4 + 2], d = P[row * 4 + 3];
            const float mt = (a.x + b.x + c.x + d.x) * 0.25f;
            const float da = a.x - mt, db = b.x - mt, dc = c.x - mt, dd = d.x - mt;
            const float m2 = (a.y + b.y) + (c.y + d.y) + 64.0f * ((da * da + db * db) + (dc * dc + dd * dd));
            __hip_atomic_store(xbuf + ((size_t)(u.pm * BM + row) * 4 + u.pn), ((unsigned long long)__float_as_uint(m2) << 32) | __float_as_uint(mt), __ATOMIC_RELAXED, __HIP_MEMORY_SCOPE_AGENT);
        }
        asm volatile("s_waitcnt vmcnt(0)" ::: "memory");
        if (lane == 0) __hip_atomic_fetch_add(cnt + 64 * u.pm, 1u, __ATOMIC_RELAXED, __HIP_MEMORY_SCOPE_AGENT);
        if (wid == 0) {
            unsigned sp = 0;
            while ((unsigned)__builtin_amdgcn_readfirstlane((int)__hip_atomic_load(cnt + 64 * u.pm, __ATOMIC_RELAXED, __HIP_MEMORY_SCOPE_AGENT)) < 32u) { __builtin_amdgcn_s_sleep(2); if (++sp > (1u << 22)) break; }
            __builtin_amdgcn_fence(__ATOMIC_ACQUIRE, "agent");
        }
        asm volatile("s_waitcnt vmcnt(0) lgkmcnt(0)" ::: "memory"); __builtin_amdgcn_s_barrier(); asm volatile("" ::: "memory");
        if (lane < 32) {
            const unsigned long long* slot = xbuf + (size_t)(u.pm * BM + row) * 4; float mt[4], m2[4]; float ms = 0.f;
#pragma unroll
            for (int t = 0; t < 4; ++t) { const unsigned long long w = __hip_atomic_load(slot + t, __ATOMIC_RELAXED, __HIP_MEMORY_SCOPE_AGENT); mt[t] = __uint_as_float((unsigned)w); m2[t] = __uint_as_float((unsigned)(w >> 32)); ms += mt[t]; }
            const float mean = ms * 0.25f; float q = 0.f;
#pragma unroll
            for (int t = 0; t < 4; ++t) { const float dm = mt[t] - mean; q += m2[t] + 256.0f * dm * dm; }
            S[row] = (f32x2v){mean, __builtin_amdgcn_rsqf(q * (1.0f / 1024.0f) + eps)};
        }
        asm volatile("s_waitcnt lgkmcnt(0)" ::: "memory"); __builtin_amdgcn_s_barrier(); asm volatile("" ::: "memory");
    }
};
struct EpiDownLn {
    static constexpr bool PERM = true, AFTER_DRAIN = false;
    const bf16_t* v1b; float* out; const float* stats; const float* g1; const float* b1; const float* g2; const float* b2; float alpha, inv_s; RowStatsX rx;
    __device__ __forceinline__ void operator()(const f32x4 (&acc_)[2][2][4][2], const Unit& u, int wr, int wc, int fr, int fq) const {
        typedef float f32x2v __attribute__((ext_vector_type(2)));
        f32x4 (&acc)[2][2][4][2] = const_cast<f32x4 (&)[2][2][4][2]>(acc_);
        const int row0 = u.pm * BM + wr * 64 + fr; const int wid = wr * 4 + wc, lane = fq * 16 + fr;
#pragma unroll
        for (int bj = 0; bj < 2; ++bj) {
            const int col0 = u.pn * BM + bj * HALF + wc * 32 + 8 * fq;
            const f32x4 ga = *(const f32x4*)(g1 + col0), gb = *(const f32x4*)(g1 + col0 + 4), ba = *(const f32x4*)(b1 + col0), bb = *(const f32x4*)(b1 + col0 + 4);
#pragma unroll
            for (int ai = 0; ai < 2; ++ai)
#pragma unroll
                for (int m = 0; m < 4; ++m) {
                    const int row = row0 + ai * HALF + m * 16;
                    const f32x2v st = *(const f32x2v*)(stats + 2 * row);
                    const float mean = st[0] * (1.f / 1024.f), var = st[1] * (1.f / 1024.f) - mean * mean, rstd = __builtin_amdgcn_rsqf(fmaxf(var, 0.f) + 1e-5f);
                    const u32x4 vv = *(const u32x4*)(v1b + (size_t)row * 1024 + col0);
                    const f32x4 va = {__uint_as_float(vv[0] << 16), __uint_as_float(vv[0] & 0xffff0000u), __uint_as_float(vv[1] << 16), __uint_as_float(vv[1] & 0xffff0000u)};
                    const f32x4 vb = {__uint_as_float(vv[2] << 16), __uint_as_float(vv[2] & 0xffff0000u), __uint_as_float(vv[3] << 16), __uint_as_float(vv[3] & 0xffff0000u)};
                    acc[ai][bj][m][0] = ((va - mean) * rstd * ga + ba) * alpha + acc[ai][bj][m][0] * inv_s;
                    acc[ai][bj][m][1] = ((vb - mean) * rstd * gb + bb) * alpha + acc[ai][bj][m][1] * inv_s;
                    asm volatile("" : "+v"(acc[ai][bj][m][0]), "+v"(acc[ai][bj][m][1]));
                    if (m & 1) asm volatile("" ::: "memory");
                }
        }
        rx.run(acc, u, wr, wc, fr, fq, wid, lane);
        const PG8_LAS f32x2v* S = (const PG8_LAS f32x2v*)(rx.tab + 8192);
#pragma unroll
        for (int bj = 0; bj < 2; ++bj) {
            const int col0 = u.pn * BM + bj * HALF + wc * 32 + 8 * fq;
            const f32x4 ga = *(const f32x4*)(g2 + col0), gb = *(const f32x4*)(g2 + col0 + 4), ba = *(const f32x4*)(b2 + col0), bb = *(const f32x4*)(b2 + col0 + 4);
#pragma unroll
            for (int ai = 0; ai < 2; ++ai)
#pragma unroll
                for (int m = 0; m < 4; ++m) {
                    const int r = ai * HALF + wr * 64 + m * 16 + fr; const f32x2v sr = S[r]; float* po = out + (size_t)(u.pm * BM + r) * 1024 + col0;
                    *(f32x4*)po = (acc[ai][bj][m][0] - sr.x) * sr.y * ga + ba; *(f32x4*)(po + 4) = (acc[ai][bj][m][1] - sr.x) * sr.y * gb + bb;
                    if (m & 1) asm volatile("" ::: "memory");
                }
        }
        asm volatile("s_waitcnt lgkmcnt(0)" ::: "memory"); __builtin_amdgcn_s_barrier(); asm volatile("" ::: "memory");
    }
};
struct EpiDown {
    static constexpr bool PERM = true, AFTER_DRAIN = false;
    const bf16_t* v1b; bf16_t* v2b; const float* stats; const float* g1; const float* b1; float alpha, inv_s;
    __device__ __forceinline__ void operator()(const f32x4 (&acc)[2][2][4][2], const Unit& u, int wr, int wc, int fr, int fq) const {
        const int row0 = u.pm * BM + wr * 64 + fr;
#pragma unroll
        for (int bj = 0; bj < 2; ++bj) {
            const int col0 = u.pn * BM + bj * HALF + wc * 32 + 8 * fq;
            const f32x4 ga = *(const f32x4*)(g1 + col0), gb = *(const f32x4*)(g1 + col0 + 4), ba = *(const f32x4*)(b1 + col0), bb = *(const f32x4*)(b1 + col0 + 4);
#pragma unroll
            for (int ai = 0; ai < 2; ++ai)
#pragma unroll
                for (int m = 0; m < 4; ++m) {
                    const int row = row0 + ai * HALF + m * 16;
                    const float sm = stats[2 * row], sq = stats[2 * row + 1];
                    const float mean = sm * (1.f / 1024.f), var = sq * (1.f / 1024.f) - mean * mean, rstd = rsqrtf(fmaxf(var, 0.f) + 1e-5f);
                    const u32x4 vv = *(const u32x4*)(v1b + (size_t)row * 1024 + col0);
                    const f32x4 va = {__uint_as_float(vv[0] << 16), __uint_as_float(vv[0] & 0xffff0000u), __uint_as_float(vv[1] << 16), __uint_as_float(vv[1] & 0xffff0000u)};
                    const f32x4 vb = {__uint_as_float(vv[2] << 16), __uint_as_float(vv[2] & 0xffff0000u), __uint_as_float(vv[3] << 16), __uint_as_float(vv[3] & 0xffff0000u)};
                    const f32x4 ha = (va - mean) * rstd * ga + ba, hb = (vb - mean) * rstd * gb + bb;
                    *(u32x4*)(v2b + (size_t)row * 1024 + col0) = pack8(ha * alpha + acc[ai][bj][m][0] * inv_s, hb * alpha + acc[ai][bj][m][1] * inv_s);
                }
        }
    }
};

typedef int i32x8 __attribute__((ext_vector_type(8))); typedef int i32x4 __attribute__((ext_vector_type(4)));
__device__ __forceinline__ i32x8 cat8(bf16x8 a, bf16x8 b) { return __builtin_shufflevector(__builtin_bit_cast(i32x4, a), __builtin_bit_cast(i32x4, b), 0, 1, 2, 3, 4, 5, 6, 7); }
template <class Epi, class Sched, bool ALIGN_EPI = false, bool SP2 = false, bool F8 = false>
__device__ __forceinline__ void gemm_phase(PG8_LAS unsigned char* lds, const Gemm g, const Sched& S, const Epi& E) {
    int tid_ = threadIdx.x; asm volatile("" : "+v"(tid_));
    const int tid = tid_, wid = __builtin_amdgcn_readfirstlane(tid >> 6), lane = tid & 63, wr = wid >> 2, wc = wid & 3, fr = lane & 15, fq = lane >> 4;
    const int RB = F8 ? g.K : 2 * g.K  , nt = RB / 128;
    int sc7f = 0x7F7F7F7F; asm volatile("" : "+v"(sc7f));
    unsigned voffA[2], voffB[2];
#pragma unroll
    for (int i = 0; i < 2; ++i) { int R, C; stage_rc(tid * 16 + i * 8192, R, C); const int Rb = Epi::PERM ? ((R & ~31) + perm32(R & 31)) : R;
        voffA[i] = (unsigned)(R * RB + C * 2); voffB[i] = (unsigned)(Rb * RB + C * 2); }
    const size_t kstep = (size_t)(BK * 2);
    const size_t hstep = (size_t)HALF * RB;
    const size_t tstep = 2 * hstep;
    const unsigned ldsw = (unsigned)wid * 1024u;
    const int aoff = lds_byte(wr * 64 + fr, fq * 8), boff = lds_byte(wc * 32 + fr, fq * 8);
#define PG8_SA(b, h) (((b) * 2 + (h)) * HTB)
#define PG8_SB(b, h) ((4 + (b) * 2 + (h)) * HTB)
#define PG8_STAGE(bufoff, gbase, voff) do { _Pragma("unroll") for (int _i = 0; _i < 2; ++_i) \
        __builtin_amdgcn_global_load_lds((const unsigned*)((const char*)(gbase) + (voff)[_i]), (PG8_LAS unsigned*)(lds + (bufoff) + ldsw + _i * 8192), 16, 0, 0); } while (0)
#define PG8_LDA(dst, b, h) do { _Pragma("unroll") for (int m = 0; m < 4; ++m) _Pragma("unroll") for (int k = 0; k < 2; ++k) dst[m][k] = *(const PG8_LAS bf16x8*)(lds + PG8_SA(b, h) + aoff + m * 2048 + k * 1024); } while (0)
#define PG8_LDB(dst, b, h) do { _Pragma("unroll") for (int n = 0; n < 2; ++n) _Pragma("unroll") for (int k = 0; k < 2; ++k) dst[n][k] = *(const PG8_LAS bf16x8*)(lds + PG8_SB(b, h) + boff + n * 2048 + k * 1024); } while (0)
#define PG8_MMA(ai, bj, At, Bt) do { if constexpr (F8) __builtin_amdgcn_sched_barrier(0); __builtin_amdgcn_s_setprio(1); \
        if constexpr (F8) { _Pragma("unroll") for (int m = 0; m < 4; ++m) _Pragma("unroll") for (int n = 0; n < 2; ++n) \
            asm volatile("v_mfma_scale_f32_16x16x128_f8f6f4 %0, %1, %2, %0, %3, %3 op_sel_hi:[0,0,0]" : "+v"(acc[ai][bj][m][n]) : "v"(cat8(Bt[n][0], Bt[n][1])), "v"(cat8(At[m][0], At[m][1])), "v"(sc7f)); } \
        else { _Pragma("unroll") for (int m = 0; m < 4; ++m) _Pragma("unroll") for (int n = 0; n < 2; ++n) _Pragma("unroll") for (int k = 0; k < 2; ++k) \
            acc[ai][bj][m][n] = __builtin_amdgcn_mfma_f32_16x16x32_bf16(Bt[n][k], At[m][k], acc[ai][bj][m][n], 0, 0, 0); } \
        __builtin_amdgcn_s_setprio(0); if constexpr (F8) __builtin_amdgcn_sched_barrier(0); } while (0)
#define PG8_WAIT_V(n) asm volatile("s_waitcnt vmcnt(" #n ")" ::: "memory")
#define PG8_WAIT_L(n) asm volatile("s_waitcnt lgkmcnt(" #n ")" ::: "memory")
#define PG8_BAR __builtin_amdgcn_s_barrier()
#define PG8_SCHED __builtin_amdgcn_sched_barrier(0)
    Unit cur, nxt; int ui = 0;
    if (!S.next(0, cur)) return;
    f32x4 acc[2][2][4][2];
#pragma unroll
    for (int a = 0; a < 2; ++a)
#pragma unroll
        for (int b = 0; b < 2; ++b)
#pragma unroll
            for (int m = 0; m < 4; ++m)
#pragma unroll
                for (int n = 0; n < 2; ++n) acc[a][b][m][n] = (f32x4){0.f, 0.f, 0.f, 0.f};
    bf16x8 At[4][2], B0[2][2], B1[2][2];
    const char* cA = (const char*)g.A + (size_t)cur.pm * tstep; const char* cB = (const char*)g.Bt + (size_t)cur.pn * tstep;
    S.a_ready(cur);
    if constexpr (SP2) {
        PG8_STAGE(PG8_SB(0, 0), cB, voffB); PG8_STAGE(PG8_SB(0, 1), cB + hstep, voffB); PG8_STAGE(PG8_SA(0, 0), cA, voffA); PG8_STAGE(PG8_SA(0, 1), cA + hstep, voffA);
        if (wr == 1) PG8_BAR;
        PG8_WAIT_V(2); PG8_BAR;
        PG8_STAGE(PG8_SB(1, 0), cB + kstep, voffB); PG8_STAGE(PG8_SA(1, 0), cA + kstep, voffA); PG8_STAGE(PG8_SB(1, 1), cB + hstep + kstep, voffB);
        PG8_WAIT_V(6); PG8_BAR;
    } else {
        PG8_STAGE(PG8_SB(0, 0), cB, voffB); PG8_STAGE(PG8_SA(0, 0), cA, voffA); PG8_STAGE(PG8_SB(0, 1), cB + hstep, voffB); PG8_STAGE(PG8_SA(0, 1), cA + hstep, voffA);
        if (wr == 1) PG8_BAR;
        PG8_WAIT_V(4); PG8_BAR;
        PG8_STAGE(PG8_SB(1, 0), cB + kstep, voffB); PG8_STAGE(PG8_SA(1, 0), cA + kstep, voffA); PG8_STAGE(PG8_SB(1, 1), cB + hstep + kstep, voffB);
        PG8_WAIT_V(6); PG8_BAR;
    }
    for (;;) {
        const bool has_next = S.next(ui + 1, nxt);
        const char* nA = has_next ? (const char*)g.A + (size_t)nxt.pm * tstep : cA; const char* nB = has_next ? (const char*)g.Bt + (size_t)nxt.pn * tstep : cB;
        for (int t = 0; t < nt; t += 2) {
            const bool last = (t == nt - 2);
            const char* a1 = cA + (size_t)(t + 1) * kstep;
            const char* a2 = last ? nA : cA + (size_t)(t + 2) * kstep; const char* b2 = last ? nB : cB + (size_t)(t + 2) * kstep;
            const char* a3 = a2 + kstep; const char* b3 = b2 + kstep;
            if (last && has_next) S.a_ready(nxt);
            if constexpr (SP2) {
            PG8_LDB(B0, 0, 0); PG8_LDB(B1, 0, 1); PG8_SCHED; PG8_LDA(At, 0, 0); PG8_STAGE(PG8_SA(1, 1), a1 + hstep, voffA);
            PG8_WAIT_V(8); PG8_WAIT_L(0); PG8_BAR; PG8_MMA(0, 0, At, B0); PG8_MMA(0, 1, At, B1); PG8_BAR; PG8_SCHED;
            PG8_LDA(At, 0, 1); PG8_STAGE(PG8_SB(0, 0), b2, voffB); PG8_STAGE(PG8_SB(0, 1), b2 + hstep, voffB); PG8_STAGE(PG8_SA(0, 0), a2, voffA);
            PG8_WAIT_V(8); PG8_WAIT_L(0); PG8_BAR; PG8_MMA(1, 0, At, B0); PG8_MMA(1, 1, At, B1); PG8_BAR; PG8_SCHED;
            PG8_LDB(B0, 1, 0); PG8_LDB(B1, 1, 1); PG8_SCHED; PG8_LDA(At, 1, 0); PG8_STAGE(PG8_SA(0, 1), a2 + hstep, voffA);
            PG8_WAIT_V(8); PG8_WAIT_L(0); PG8_BAR; PG8_MMA(0, 0, At, B0); PG8_MMA(0, 1, At, B1); PG8_BAR; PG8_SCHED;
            PG8_LDA(At, 1, 1); PG8_STAGE(PG8_SB(1, 0), b3, voffB); PG8_STAGE(PG8_SB(1, 1), b3 + hstep, voffB); PG8_STAGE(PG8_SA(1, 0), a3, voffA);
            PG8_WAIT_V(8); PG8_WAIT_L(0); PG8_BAR; PG8_MMA(1, 0, At, B0); PG8_MMA(1, 1, At, B1); PG8_BAR; PG8_SCHED;
            } else {
            PG8_LDB(B0, 0, 0); PG8_SCHED; PG8_LDA(At, 0, 0); PG8_STAGE(PG8_SA(1, 1), a1 + hstep, voffA);
            PG8_WAIT_L(8); PG8_BAR; PG8_WAIT_L(0); PG8_MMA(0, 0, At, B0); PG8_BAR; PG8_SCHED;
            PG8_LDB(B1, 0, 1); PG8_STAGE(PG8_SB(0, 0), b2, voffB);
            PG8_BAR; PG8_WAIT_L(0); PG8_MMA(0, 1, At, B1); PG8_BAR;
            PG8_LDA(At, 0, 1); PG8_STAGE(PG8_SA(0, 0), a2, voffA);
            PG8_BAR; PG8_WAIT_L(0); PG8_MMA(1, 0, At, B0); PG8_BAR; PG8_SCHED;
            PG8_STAGE(PG8_SB(0, 1), b2 + hstep, voffB);
            PG8_WAIT_V(6); PG8_BAR; PG8_MMA(1, 1, At, B1); PG8_BAR;
            PG8_LDB(B0, 1, 0); PG8_SCHED; PG8_LDA(At, 1, 0); PG8_STAGE(PG8_SA(0, 1), a2 + hstep, voffA);
            PG8_WAIT_L(8); PG8_BAR; PG8_WAIT_L(0); PG8_MMA(0, 0, At, B0); PG8_BAR; PG8_SCHED;
            PG8_LDB(B1, 1, 1); PG8_STAGE(PG8_SB(1, 0), b3, voffB);
            PG8_BAR; PG8_WAIT_L(0); PG8_MMA(0, 1, At, B1); PG8_BAR;
            PG8_LDA(At, 1, 1); PG8_STAGE(PG8_SA(1, 0), a3, voffA);
            PG8_BAR; PG8_WAIT_L(0); PG8_MMA(1, 0, At, B0); PG8_BAR; PG8_SCHED;
            PG8_STAGE(PG8_SB(1, 1), b3 + hstep, voffB);
            PG8_WAIT_V(6); PG8_BAR; PG8_MMA(1, 1, At, B1); PG8_BAR;
            }
        }
        if constexpr (ALIGN_EPI) { if (wr == 0) PG8_BAR; }
        if constexpr (F8) asm volatile("s_nop 15\n\ts_nop 7" ::: "memory");
        if constexpr (!Epi::AFTER_DRAIN) { E(acc, cur, wr, wc, fr, fq); S.done(cur); }
        if (!has_next) break;
#pragma unroll
        for (int a = 0; a < 2; ++a)
#pragma unroll
            for (int b = 0; b < 2; ++b)
#pragma unroll
                for (int m = 0; m < 4; ++m)
#pragma unroll
                    for (int n = 0; n < 2; ++n) acc[a][b][m][n] = (f32x4){0.f, 0.f, 0.f, 0.f};
        cur = nxt; cA = nA; cB = nB; ++ui;
        if constexpr (ALIGN_EPI) { if (wr == 1) PG8_BAR; }
    }
    PG8_WAIT_V(0);
    if constexpr (!ALIGN_EPI) { if (wr == 0) PG8_BAR; }
    PG8_BAR;
    if constexpr (Epi::AFTER_DRAIN) { E.fused(acc, cur, wr, wc, fr, fq, lds, wid, lane); S.done(cur); }
#undef PG8_SA
#undef PG8_SB
#undef PG8_STAGE
#undef PG8_LDA
#undef PG8_LDB
#undef PG8_MMA
#undef PG8_WAIT_V
#undef PG8_WAIT_L
#undef PG8_BAR
#undef PG8_SCHED
}
}
#define GAS __attribute__((address_space(1)))
#define LAS __attribute__((address_space(3)))
typedef unsigned short bf16;
typedef unsigned v4u __attribute__((ext_vector_type(4)));
typedef float f32x4 __attribute__((ext_vector_type(4)));
typedef short bf16x8 __attribute__((ext_vector_type(8)));
typedef GAS unsigned gu32;
typedef GAS unsigned long long gu64;
#define RLX_AGENT __ATOMIC_RELAXED, __HIP_MEMORY_SCOPE_AGENT
#define LDS_WAIT() asm volatile("s_waitcnt lgkmcnt(0)" ::: "memory")
#define VM_WAIT() asm volatile("s_waitcnt vmcnt(0)" ::: "memory")
__device__ __forceinline__ unsigned long long rt() { return __builtin_amdgcn_s_memrealtime(); }
__device__ __forceinline__ unsigned f2bf(float f) { unsigned u = __builtin_bit_cast(unsigned, f); return (u + 0x7fffu + ((u >> 16) & 1u)) >> 16; }
__device__ __forceinline__ unsigned pk2(float lo, float hi) { return f2bf(lo) | (f2bf(hi) << 16); }

#define XB_TMO      128
#define XB_XCNT(j)  (256  + 64 * (j))
#define XB_XSUB(j)  (1280 + 64 * (j))
#define XB_XGEN(j)  (2304 + 64 * (j))
#define XB_TOP      3328
#define XB_TOPGEN   3392
#define XCD_BAR_WORDS 3456
#define XB_SPIN_CAP (1u << 18)

__device__ __forceinline__ unsigned xb_ld(unsigned* p)              { return __hip_atomic_load(p, __ATOMIC_RELAXED, __HIP_MEMORY_SCOPE_AGENT); }
__device__ __forceinline__ unsigned xb_add(unsigned* p, unsigned v) { return __hip_atomic_fetch_add(p, v, __ATOMIC_RELAXED, __HIP_MEMORY_SCOPE_AGENT); }
__device__ __forceinline__ unsigned xb_xcc_id() { return (unsigned)__builtin_amdgcn_s_getreg((3 << 11) | 20) & 0xFu; }
#define XB_SPIN(cond, bar) do { unsigned _sp = 0; while (cond) { __builtin_amdgcn_s_sleep(1); \
    if ((++_sp & 255u) == 0u) { if (xb_ld(&(bar)[XB_TMO])) break; if (_sp > XB_SPIN_CAP) { atomicAdd(&(bar)[XB_TMO], 1u); break; } } } } while (0)

struct XcdBarrier {
    unsigned* bar; unsigned x;
    volatile LAS unsigned* st;
};

__device__ __forceinline__ XcdBarrier xcd_barrier_post(unsigned* bar, volatile LAS unsigned* st) {
    XcdBarrier b; b.bar = bar; b.x = xb_xcc_id(); b.st = st;
    if (threadIdx.x == 0) (void)xb_add(&bar[XB_XCNT(b.x)], 1u);
    return b;
}
__device__ __forceinline__ void xcd_barrier_complete(unsigned* bar, unsigned x, unsigned& nloc, unsigned& nx) {
    const unsigned G = gridDim.x * gridDim.y * gridDim.z;
    unsigned sum, cnt, mine, sp = 0u;
    for (;;) {
        sum = 0u; cnt = 0u; mine = 0u;
#pragma unroll
        for (unsigned j = 0; j < 16; ++j) { const unsigned c = xb_ld(&bar[XB_XCNT(j)]); sum += c; cnt += (c > 0u) ? 1u : 0u; mine = (j == x) ? c : mine; }
        if (sum == G) break;
        __builtin_amdgcn_s_sleep(1);
        if ((++sp & 255u) == 0u) { if (xb_ld(&bar[XB_TMO])) break; if (sp > XB_SPIN_CAP) { atomicAdd(&bar[XB_TMO], 1u); break; } }
    }
    nloc = mine > 0u ? mine : 1u; nx = cnt > 0u ? cnt : 1u;
}

__device__ __forceinline__ void xcd_barrier(const XcdBarrier& b) {
    asm volatile("s_waitcnt vmcnt(0)" ::: "memory");
    __syncthreads();
    if (threadIdx.x == 0) {
        unsigned* bar = b.bar;
        __builtin_amdgcn_s_waitcnt(0);
        unsigned nloc = b.st[0], nx = b.st[1];
        if (nloc == 0u) { xcd_barrier_complete(bar, b.x, nloc, nx); b.st[0] = nloc; b.st[1] = nx; }
        const unsigned old = xb_add(&bar[XB_XSUB(b.x)], 1u);
        const unsigned gen = old / nloc;
        if (old + 1u == (gen + 1u) * nloc) {
            __builtin_amdgcn_fence(__ATOMIC_RELEASE, "agent");
            asm volatile("s_waitcnt vmcnt(0)" ::: "memory");
            const unsigned og = xb_add(&bar[XB_TOP], 1u);
            const unsigned tg = og / nx;
            if (og + 1u == (tg + 1u) * nx) xb_add(&bar[XB_TOPGEN], 1u);
            else XB_SPIN(xb_ld(&bar[XB_TOPGEN]) == tg, bar);
            __builtin_amdgcn_fence(__ATOMIC_ACQUIRE, "agent");
            xb_add(&bar[XB_XGEN(b.x)], 1u);
            asm volatile("s_waitcnt vmcnt(0)" ::: "memory");
        } else {
            XB_SPIN(xb_ld(&bar[XB_XGEN(b.x)]) == gen, bar);
            __builtin_amdgcn_fence(__ATOMIC_ACQUIRE, "agent");
            asm volatile("s_waitcnt vmcnt(0)" ::: "memory");
        }
    }
    __syncthreads();
}
constexpr int NWAVES = 8, NT = 512;
constexpr float S_GU = 32.f, S_DN = 64.f, S_OUT = 32.f;
constexpr int RING_BYTES = 131072, LDSCTL_OFF = RING_BYTES, MISC_OFF = LDSCTL_OFF + 320, LDS_BYTES = 147456;
constexpr int CW_TMO = 0, CW_BAR = 4096;
__device__ __forceinline__ float bf2f(bf16 v) { return __uint_as_float(((unsigned)v) << 16); }
__device__ __forceinline__ float bfr(float f) { return __uint_as_float(f2bf(f) << 16); }
__device__ __forceinline__ float wave_sum(float v) {
#pragma unroll
    for (int o = 1; o < 64; o <<= 1) v += __shfl_xor(v, o);
    return v;
}
template <bool F8>
__device__ __forceinline__ void tr64(const float* __restrict__ W, int Nsrc, int K, void* WT, int n0, int k0, int srccol, const float* __restrict__ kscale, float S, const float* __restrict__ kbias, float* csum, float* bsum, int lane) {
    const float* wp = W + (size_t)k0 * Nsrc + (srccol >= 0 ? srccol : 0); float cs = 0.f, bs = 0.f; const float rS = 1.f / S;
#pragma unroll 1
    for (int ch = 0; ch < 4; ++ch) {
        float v[16];
#pragma unroll
        for (int i = 0; i < 16; ++i) v[i] = srccol >= 0 ? wp[(size_t)(ch * 16 + i) * Nsrc] : 0.f;
        if (bsum) {
#pragma unroll
            for (int i = 0; i < 16; ++i) bs = fmaf(kbias[k0 + ch * 16 + i], v[i], bs); }
        if (kscale) {
#pragma unroll
            for (int i = 0; i < 16; ++i) v[i] *= kscale[k0 + ch * 16 + i]; }
        if constexpr (F8) {
            v4u o;
#pragma unroll
            for (int d = 0; d < 4; ++d) { int p = __builtin_amdgcn_cvt_pk_fp8_f32(v[4 * d] * S, v[4 * d + 1] * S, 0, false); p = __builtin_amdgcn_cvt_pk_fp8_f32(v[4 * d + 2] * S, v[4 * d + 3] * S, p, true); o[d] = (unsigned)p;
                if (csum) cs += ((__builtin_amdgcn_cvt_f32_fp8(p, 0) + __builtin_amdgcn_cvt_f32_fp8(p, 1)) + (__builtin_amdgcn_cvt_f32_fp8(p, 2) + __builtin_amdgcn_cvt_f32_fp8(p, 3))) * rS; }
            *(GAS v4u*)((unsigned char*)WT + (size_t)(n0 + lane) * K + k0 + ch * 16) = o;
        } else {
            v4u o0, o1;
#pragma unroll
            for (int d = 0; d < 4; ++d) { o0[d] = pk2(v[2 * d], v[2 * d + 1]); o1[d] = pk2(v[8 + 2 * d], v[8 + 2 * d + 1]); }
            GAS v4u* dst = (GAS v4u*)((bf16*)WT + (size_t)(n0 + lane) * K + k0 + ch * 16); dst[0] = o0; dst[1] = o1;
        }
    }
    if (csum) atomicAdd(csum + n0 + lane, cs);
    if (bsum) atomicAdd(bsum + n0 + lane, bs);
}


namespace att {
typedef short bf16x8 __attribute__((ext_vector_type(8)));
typedef short s16x4 __attribute__((ext_vector_type(4)));
typedef short v4i16_t __attribute__((ext_vector_type(4)));
typedef float f32x16 __attribute__((ext_vector_type(16)));
typedef unsigned u32x4 __attribute__((ext_vector_type(4)));
typedef unsigned u32x2 __attribute__((ext_vector_type(2)));
constexpr float C2 = 0.125f * 1.4426950408889634f;
constexpr float NEG_INF = -INFINITY;
__device__ __forceinline__ int crow(int r, int hi) { return (r & 3) + 8 * (r >> 2) + 4 * hi; }
__device__ __forceinline__ s16x4 vtr(const LAS unsigned char* p) { return __builtin_bit_cast(s16x4, __builtin_amdgcn_ds_read_tr16_b64_v4i16((LAS v4i16_t*)p)); }
__device__ __forceinline__ unsigned cvtpk(float lo, float hi) { typedef float f2_t __attribute__((ext_vector_type(2))); typedef __bf16 b2_t __attribute__((ext_vector_type(2))); f2_t v = {lo, hi}; b2_t b = __builtin_convertvector(v, b2_t); return __builtin_bit_cast(unsigned, b); }
__device__ __forceinline__ float ex2(float x) { return __builtin_amdgcn_exp2f(x); }

__device__ __forceinline__ void qkt(f32x16& p0, f32x16& p1, const LAS unsigned char* Ks, const bf16x8* qf, int r32, int hi) {
    const LAS unsigned char* kb = Ks + hi * 1024 + r32 * 16;
#pragma unroll
    for (int dh = 0; dh < 2; ++dh) {
        const bf16x8 b0 = *(const LAS bf16x8*)(kb + (2 * dh) * 2048), b1 = *(const LAS bf16x8*)(kb + (2 * dh) * 2048 + 512);
        const bf16x8 b2 = *(const LAS bf16x8*)(kb + (2 * dh + 1) * 2048), b3 = *(const LAS bf16x8*)(kb + (2 * dh + 1) * 2048 + 512);
        __builtin_amdgcn_s_setprio(1);
        p0 = __builtin_amdgcn_mfma_f32_32x32x16_bf16(b0, qf[2 * dh], p0, 0, 0, 0); p1 = __builtin_amdgcn_mfma_f32_32x32x16_bf16(b1, qf[2 * dh], p1, 0, 0, 0);
        p0 = __builtin_amdgcn_mfma_f32_32x32x16_bf16(b2, qf[2 * dh + 1], p0, 0, 0, 0); p1 = __builtin_amdgcn_mfma_f32_32x32x16_bf16(b3, qf[2 * dh + 1], p1, 0, 0, 0);
        __builtin_amdgcn_s_setprio(0);
        if (dh == 0) __builtin_amdgcn_sched_barrier(0);
    }
}
__device__ __forceinline__ float max3f(float a, float b, float c) { float r; asm("v_max3_f32 %0, %1, %2, %3" : "=v"(r) : "v"(a), "v"(b), "v"(c)); return r; }
__device__ __forceinline__ void cinit_bits(f32x16& c, unsigned w, int hi, float negm) {
    const unsigned w2 = w >> (4 * hi), nb = __float_as_uint(negm);
#pragma unroll
    for (int r = 0; r < 16; ++r) { const unsigned mm = (unsigned)__builtin_amdgcn_sbfe((int)w2, crow(r, 0), 1); c[r] = __uint_as_float((nb & mm) | (0xFF800000u & ~mm)); }
}
__device__ __forceinline__ void cinit_splat(f32x16& c, float v) {
#pragma unroll
    for (int r = 0; r < 16; ++r) c[r] = v;
}
__device__ __forceinline__ void pv(f32x16* o, const LAS unsigned char* Vs, int lane, int hi, const u32x4 (&pw)[4]) {
    const LAS unsigned char* vb = Vs + ((lane >> 4) & 1) * 32 + (lane & 3) * 8 + (4 * hi + ((lane & 15) >> 2)) * 64;
#pragma unroll
    for (int d0 = 0; d0 < 2; ++d0) {
        s16x4 lo[4], hh[4];
#pragma unroll
        for (int ks = 0; ks < 4; ++ks) { lo[ks] = vtr(vb + d0 * 4096 + ks * 1024); hh[ks] = vtr(vb + d0 * 4096 + ks * 1024 + 512); }
        asm volatile("s_waitcnt lgkmcnt(0)" ::: "memory"); __builtin_amdgcn_sched_barrier(0);
        __builtin_amdgcn_s_setprio(1);
#pragma unroll
        for (int ks = 0; ks < 4; ++ks) { const bf16x8 vf = {lo[ks][0], lo[ks][1], lo[ks][2], lo[ks][3], hh[ks][0], hh[ks][1], hh[ks][2], hh[ks][3]};
            o[d0] = __builtin_amdgcn_mfma_f32_32x32x16_bf16(__builtin_bit_cast(bf16x8, pw[ks]), vf, o[d0], 0, 0, 0); }
        __builtin_amdgcn_s_setprio(0);
    }
}
__device__ __forceinline__ void softmax_step(f32x16& p0, f32x16& p1, float& m, float& l, f32x16* o, LAS float* wsf, int r32, int hi, u32x4 (&pw)[4]) {
    float rm = fmaxf(p0[0], p1[0]);
#pragma unroll
    for (int r = 1; r < 16; ++r) rm = fmaxf(rm, fmaxf(p0[r], p1[r]));
    rm = fmaxf(rm, __shfl_xor(rm, 32));
    if (__any(rm > m)) {
        const float mn = fmaxf(m, rm), f = ex2(m - mn);
        l *= f; m = mn;
        if (hi == 0) wsf[r32] = f;
#pragma unroll
        for (int r = 0; r < 16; ++r) { const float fr = wsf[crow(r, hi)]; o[0][r] *= fr; o[1][r] *= fr; }
    }
    float s = 0.f;
#pragma unroll
    for (int r = 0; r < 16; ++r) { p0[r] = ex2(p0[r] - m); p1[r] = ex2(p1[r] - m); s += p0[r] + p1[r]; }
    l += s;
    pw[0] = u32x4{cvtpk(p0[0], p0[1]), cvtpk(p0[2], p0[3]), cvtpk(p0[4], p0[5]), cvtpk(p0[6], p0[7])};
    pw[1] = u32x4{cvtpk(p0[8], p0[9]), cvtpk(p0[10], p0[11]), cvtpk(p0[12], p0[13]), cvtpk(p0[14], p0[15])};
    pw[2] = u32x4{cvtpk(p1[0], p1[1]), cvtpk(p1[2], p1[3]), cvtpk(p1[4], p1[5]), cvtpk(p1[6], p1[7])};
    pw[3] = u32x4{cvtpk(p1[8], p1[9]), cvtpk(p1[10], p1[11]), cvtpk(p1[12], p1[13]), cvtpk(p1[14], p1[15])};
}
__device__ __forceinline__ void mask_bits(f32x16& p, unsigned w, int hi) {
    const unsigned w2 = w >> (4 * hi);
#pragma unroll
    for (int r = 0; r < 16; ++r) p[r] = ((w2 >> crow(r, 0)) & 1u) ? p[r] : NEG_INF;
}
constexpr float THRL = 8.f;
__device__ __forceinline__ void partialSM(f32x16& p0, f32x16& p1, float& m_reg, float& alpha, bool& seen) {
    float a = max3f(p0[0], p0[1], p1[0]), b = max3f(p0[2], p0[3], p1[1]); a = max3f(a, p1[2], p1[3]);
#pragma unroll
    for (int r = 4; r < 16; r += 4) { a = max3f(a, p0[r], p0[r + 1]); b = max3f(b, p0[r + 2], p0[r + 3]); a = max3f(a, p1[r], p1[r + 1]); b = max3f(b, p1[r + 2], p1[r + 3]); }
    float pmax = max3f(a, b, b);
    { auto rr = __builtin_amdgcn_permlane32_swap(__float_as_uint(pmax), __float_as_uint(pmax), false, false); pmax = max3f(__uint_as_float(rr[0]), __uint_as_float(rr[1]), __uint_as_float(rr[1])); }
    const bool fin = pmax > NEG_INF, init = fin && !seen, up = seen && pmax > THRL;
    alpha = 1.f;
    if (__builtin_expect(__any(init || up), 0)) { const float dl = (init || up) ? pmax : 0.f; alpha = up ? ex2(-dl) : 1.f; m_reg += dl;
#pragma unroll
        for (int r = 0; r < 16; ++r) { p0[r] -= dl; p1[r] -= dl; } }
    seen = seen || fin;
#pragma unroll
    for (int r = 0; r < 16; ++r) p0[r] = ex2(p0[r]);
}
__device__ __forceinline__ void finishSM(f32x16& p0, f32x16& p1, float alpha, float& l_reg, u32x4 (&pw)[4]) {
#pragma unroll
    for (int r = 0; r < 16; ++r) p1[r] = ex2(p1[r]);
    float ps = 0.f;
#pragma unroll
    for (int r = 0; r < 16; ++r) ps += p0[r] + p1[r];
    l_reg = l_reg * alpha + ps;
    pw[0] = u32x4{cvtpk(p0[0], p0[1]), cvtpk(p0[2], p0[3]), cvtpk(p0[4], p0[5]), cvtpk(p0[6], p0[7])};
    pw[1] = u32x4{cvtpk(p0[8], p0[9]), cvtpk(p0[10], p0[11]), cvtpk(p0[12], p0[13]), cvtpk(p0[14], p0[15])};
    pw[2] = u32x4{cvtpk(p1[0], p1[1]), cvtpk(p1[2], p1[3]), cvtpk(p1[4], p1[5]), cvtpk(p1[6], p1[7])};
    pw[3] = u32x4{cvtpk(p1[8], p1[9]), cvtpk(p1[10], p1[11]), cvtpk(p1[12], p1[13]), cvtpk(p1[14], p1[15])};
}
__device__ __forceinline__ void rescale_o(f32x16* o, float alpha, LAS float* wsf, int r32, int hi) {
    if (__any(alpha < 1.f)) { if (hi == 0) wsf[r32] = alpha;
#pragma unroll
        for (int r = 0; r < 16; ++r) { const float fr = wsf[crow(r, hi)]; o[0][r] *= fr; o[1][r] *= fr; } }
}
#define SBAR_() __builtin_amdgcn_sched_barrier(0)
template <class Stg, class MaskF>
__device__ __forceinline__ void flash_loop(int t0, int nt, Stg& sg, const MaskF& mk, const bf16x8* qf, LAS unsigned char* kb, LAS unsigned char* vb, int bstride,
                                           float& m_reg, float& l_reg, f32x16* o, LAS float* wsf, int lane, int r32, int hi, bool preloaded = false) {
    f32x16 pA0, pA1, pB0, pB1; float alA = 1.f, alB = 1.f; u32x4 pw[4]; bool seen = false;
    if (!preloaded) sg.load(t0);
    sg.store(0); __syncthreads();
    if (nt > 1) sg.load(t0 + 1); else sg.load_after();
    mk(pA0, pA1, t0, -m_reg); qkt(pA0, pA1, kb, qf, r32, hi); mk.post(pA0, pA1, t0); partialSM(pA0, pA1, m_reg, alA, seen);
    if (nt > 1) sg.store(1);
    __syncthreads();
#define FL_STEP(C0, C1, ALC, P0, P1, ALP, J) do { const int cb_ = ((J) & 1) * bstride, pb_ = (((J) - 1) & 1) * bstride; \
        if ((J) + 1 < nt) sg.load(t0 + (J) + 1); else sg.load_after(); \
        mk(C0, C1, t0 + (J), -m_reg); SBAR_(); qkt(C0, C1, kb + cb_, qf, r32, hi); \
        finishSM(P0, P1, ALP, l_reg, pw); SBAR_(); \
        pv(o, vb + pb_, lane, hi, pw); mk.post(C0, C1, t0 + (J)); partialSM(C0, C1, m_reg, ALC, seen); \
        __syncthreads(); \
        if ((J) + 1 < nt) sg.store(((J) + 1) & 1); \
        rescale_o(o, ALC, wsf, r32, hi); \
        __syncthreads(); } while (0)
    int j = 1;
    for (; j + 1 < nt; j += 2) { FL_STEP(pB0, pB1, alB, pA0, pA1, alA, j); FL_STEP(pA0, pA1, alA, pB0, pB1, alB, j + 1); }
    if (j < nt) { FL_STEP(pB0, pB1, alB, pA0, pA1, alA, j); ++j; }
    if (nt & 1) { finishSM(pA0, pA1, alA, l_reg, pw); SBAR_(); pv(o, vb, lane, hi, pw); }
    else { finishSM(pB0, pB1, alB, l_reg, pw); SBAR_(); pv(o, vb + bstride, lane, hi, pw); }
#undef FL_STEP
    __syncthreads();
}
template <class Stg, class MaskF>
__device__ __forceinline__ void flash_loop_r(int t0, int nt, Stg& sg, const MaskF& mk, const bf16x8* qf, LAS unsigned char* kb, int kstride, LAS unsigned char* vb, int vstride,
                                             float& m_reg, float& l_reg, f32x16* o, LAS float* wsf, int lane, int r32, int hi, bool preloaded = false) {
    f32x16 pA0, pA1, pB0, pB1; float alA = 1.f, alB = 1.f; u32x4 pw[4]; bool seen = false;
    if (!preloaded) sg.load(t0);
    sg.store(0, 0); __syncthreads();
    if (nt > 1) sg.load(t0 + 1); else sg.load_after();
    mk(pA0, pA1, t0, -m_reg); qkt(pA0, pA1, kb, qf, r32, hi); mk.post(pA0, pA1, t0); partialSM(pA0, pA1, m_reg, alA, seen);
    if (nt > 1) sg.store(1, 1);
    __syncthreads();
    int vprev = 0, vcur = 1, vnext = 2;
#define FR_STEP(C0, C1, ALC, P0, P1, ALP, J) do { \
        if ((J) + 1 < nt) sg.load(t0 + (J) + 1); else sg.load_after(); \
        mk(C0, C1, t0 + (J), -m_reg); SBAR_(); qkt(C0, C1, kb + ((J) & 1) * kstride, qf, r32, hi); \
        finishSM(P0, P1, ALP, l_reg, pw); SBAR_(); \
        pv(o, vb + vprev * vstride, lane, hi, pw); mk.post(C0, C1, t0 + (J)); partialSM(C0, C1, m_reg, ALC, seen); \
        rescale_o(o, ALC, wsf, r32, hi); \
        if ((J) + 1 < nt) sg.store(((J) + 1) & 1, vnext); \
        __syncthreads(); \
        { const int t_ = vprev; vprev = vcur; vcur = vnext; vnext = t_; } } while (0)
    int j = 1;
    for (; j + 1 < nt; j += 2) { FR_STEP(pB0, pB1, alB, pA0, pA1, alA, j); FR_STEP(pA0, pA1, alA, pB0, pB1, alB, j + 1); }
    if (j < nt) { FR_STEP(pB0, pB1, alB, pA0, pA1, alA, j); ++j; }
    if (nt & 1) { finishSM(pA0, pA1, alA, l_reg, pw); SBAR_(); pv(o, vb + vprev * vstride, lane, hi, pw); }
    else { finishSM(pB0, pB1, alB, l_reg, pw); SBAR_(); pv(o, vb + vprev * vstride, lane, hi, pw); }
#undef FR_STEP
    __syncthreads();
}
template <class Stg, class MaskF>
__device__ __forceinline__ void flash_loop_b(int t0, int nt, Stg& sg, const MaskF& mk, const bf16x8* qf, LAS unsigned char* kb, LAS unsigned char* vb, int bstride,
                                             float& m_reg, float& l_reg, f32x16* o, LAS float* wsf, int lane, int r32, int hi, bool preloaded = false) {
    f32x16 c0, c1; u32x4 pw[4]; float alpha = 1.f; bool seen = false;
    if (!preloaded) sg.load(t0);
    sg.store(0); __syncthreads();
    if (nt > 1) sg.load(t0 + 1); else sg.load_after();
    mk(c0, c1, t0, -m_reg); qkt(c0, c1, kb, qf, r32, hi); mk.post(c0, c1, t0);
    partialSM(c0, c1, m_reg, alpha, seen); finishSM(c0, c1, alpha, l_reg, pw);
    if (nt > 1) sg.store(1);
    __syncthreads();
    for (int j = 1; j < nt; ++j) {
        const int cb_ = (j & 1) * bstride, pb_ = ((j - 1) & 1) * bstride;
        if (j + 1 < nt) sg.load(t0 + j + 1); else sg.load_after();
        mk(c0, c1, t0 + j, -m_reg); SBAR_(); qkt(c0, c1, kb + cb_, qf, r32, hi);
        pv(o, vb + pb_, lane, hi, pw);
        mk.post(c0, c1, t0 + j);
        partialSM(c0, c1, m_reg, alpha, seen); finishSM(c0, c1, alpha, l_reg, pw);
        __syncthreads();
        if (j + 1 < nt) sg.store((j + 1) & 1);
        rescale_o(o, alpha, wsf, r32, hi);
        __syncthreads();
    }
    pv(o, vb + ((nt - 1) & 1) * bstride, lane, hi, pw);
    __syncthreads();
}
__device__ __forceinline__ float stage_o(const f32x16* o, float ltot, LAS float* wsf, LAS float* stg, int lane, int r32, int hi) {
    if (hi == 0) wsf[r32] = 1.f / fmaxf(ltot, 1e-30f);
#pragma unroll
    for (int r = 0; r < 16; ++r) { const int q = crow(r, hi); const float rl = wsf[q]; stg[q * 64 + r32] = o[0][r] * rl; stg[q * 64 + 32 + r32] = o[1][r] * rl; }
    const LAS f32x4* rowp = (const LAS f32x4*)(stg + (lane >> 1) * 64 + (lane & 1) * 32); float ss = 0.f;
#pragma unroll
    for (int i = 0; i < 8; ++i) { const f32x4 v = rowp[i]; ss += (v[0] * v[0] + v[1] * v[1]) + (v[2] * v[2] + v[3] * v[3]); }
    ss += __shfl_xor(ss, 1);
    return ss;
}
__device__ __forceinline__ void store_o(const LAS float* stg, float rinv, const float* __restrict__ gain, bf16* __restrict__ dst, int lane) {
    const LAS f32x4* rowp = (const LAS f32x4*)(stg + (lane >> 1) * 64 + (lane & 1) * 32); const f32x4* gp = (const f32x4*)(gain + (lane & 1) * 32);
#if MIXED_F8
    u32x4* dp = (u32x4*)((unsigned char*)dst + (lane & 1) * 32);
#pragma unroll
    for (int i = 0; i < 2; ++i) { u32x4 o;
#pragma unroll
        for (int d = 0; d < 4; ++d) { const f32x4 a = rowp[4 * i + d] * rinv * gp[4 * i + d];
            int p = __builtin_amdgcn_cvt_pk_fp8_f32(a[0], a[1], 0, false); p = __builtin_amdgcn_cvt_pk_fp8_f32(a[2], a[3], p, true); o[d] = (unsigned)p; }
        dp[i] = o; }
#else
    u32x4* dp = (u32x4*)(dst + (lane & 1) * 32);
#pragma unroll
    for (int i = 0; i < 4; ++i) { const f32x4 a = rowp[2 * i] * rinv * gp[2 * i], b2 = rowp[2 * i + 1] * rinv * gp[2 * i + 1];
        dp[i] = u32x4{cvtpk(a[0], a[1]), cvtpk(a[2], a[3]), cvtpk(b2[0], b2[1]), cvtpk(b2[2], b2[3])}; }
#endif
}

constexpr int NB = 256, CAP = 64;
constexpr int L_IQ = 0, L_NRM = 16384, L_KV = 0, L_HIST = 32768, HSTR = 257  , L_MASK = 65792, L_CAND = 73984, L_QI = 90368, L_WSF = 98304, L_ROWSQ = 100352, L_STG = 32768;
typedef u32x2 DsaCand;
__device__ __forceinline__ int idx_bin(float v, float lo, float invw, bool filt) { const float f = (v - lo) * invw; int b = (int)f; b = b > NB - 1 ? NB - 1 : b; return (f >= 0.f) ? b : (filt ? -1 : 0); }
__device__ __forceinline__ void idx_tile(float (&idx)[16], const bf16x8 a0, const bf16x8 a1, const LAS unsigned char* iqs, const float (&w)[8], int lane) {
#pragma unroll
    for (int r = 0; r < 16; ++r) idx[r] = 0.f;
    const LAS bf16x8* fq = (const LAS bf16x8*)(iqs + lane * 16);
    bf16x8 b0 = fq[0], b1 = fq[64], n0 = fq[128], n1 = fq[192];
    f32x16 c = __builtin_amdgcn_mfma_f32_32x32x16_bf16(a0, b0, f32x16{}, 0, 0, 0);
    c = __builtin_amdgcn_mfma_f32_32x32x16_bf16(a1, b1, c, 0, 0, 0);
#pragma unroll
    for (int h = 0; h < 8; ++h) {
        f32x16 cn = c;
        if (h < 7) { b0 = n0; b1 = n1;
            if (h < 6) { n0 = fq[((h + 2) * 2 + 0) * 64]; n1 = fq[((h + 2) * 2 + 1) * 64]; }
            cn = __builtin_amdgcn_mfma_f32_32x32x16_bf16(a0, b0, f32x16{}, 0, 0, 0);
            cn = __builtin_amdgcn_mfma_f32_32x32x16_bf16(a1, b1, cn, 0, 0, 0); }
#pragma unroll
        for (int r = 0; r < 16; ++r) idx[r] = fmaf(w[h], fmaxf(c[r], 0.f), idx[r]);
        c = cn;
        __builtin_amdgcn_sched_barrier(0);
    }
#pragma unroll
    for (int r = 0; r < 16; ++r) idx[r] *= IDX_SCALE;
}
__device__ __forceinline__ void dsa_unit(LAS unsigned char* L, const bf16* __restrict__ act, const float* __restrict__ mix_gain, bf16* __restrict__ mixed, DsaCand* __restrict__ gcand, float* __restrict__ gidx, int b, int qt) {
    int tid = threadIdx.x; asm volatile("" : "+v"(tid));
    const int lane = tid & 63, r32 = lane & 31, hi = lane >> 5; const int w = __builtin_amdgcn_readfirstlane(tid >> 6);
    LAS unsigned* hist = (LAS unsigned*)(L + L_HIST); LAS unsigned* mask = (LAS unsigned*)(L + L_MASK); LAS DsaCand* cand = (LAS DsaCand*)(L + L_CAND);
    LAS unsigned* q_cnt = (LAS unsigned*)(L + L_QI); LAS int* q_B = (LAS int*)(L + L_QI + 128); LAS int* q_need = (LAS int*)(L + L_QI + 256);
    LAS float* wsf = (LAS float*)(L + L_WSF) + w * 64; LAS float* rowsq = (LAS float*)(L + L_ROWSQ);
    const int tq = qt * 32 + r32; const size_t rowq = (size_t)b * SEQ + tq; const bf16* ab = act + (size_t)b * SEQ * ACT_COLS;
    bf16x8 qf[4]; u32x4 kpre, vpre;
    const bf16* kg0 = ab + (size_t)lane * ACT_COLS + C_DK + 8 * w;
    const bf16* vg0 = ab + (size_t)(16 * (w & 3) + (lane >> 2)) * ACT_COLS + C_DV + 32 * (w >> 2) + 8 * (lane & 3);
    TIC(11); TIC(20);
    {
        if (w == 0) { __builtin_amdgcn_fence(__ATOMIC_ACQUIRE, "agent"); asm volatile("s_waitcnt vmcnt(0)" ::: "memory"); }
        const bf16* ar = act + rowq * ACT_COLS;
        const bf16x8 i0 = *(const bf16x8*)(ar + C_IQ + w * 32 + 8 * hi), i1 = *(const bf16x8*)(ar + C_IQ + w * 32 + 16 + 8 * hi);
        const u32x4 wv = *(const u32x4*)(ar + C_IW);
        for (int i = tid; i < (L_CAND - L_HIST) / 16; i += NT) ((LAS u32x4*)(L + L_HIST))[i] = u32x4{0u, 0u, 0u, 0u};
        if (tid < 128) ((LAS unsigned*)(L + L_QI))[tid] = (tid >= 32 && tid < 64) ? 0xFFFFFFFFu : 0u;
        __syncthreads();
        float wq[8];
        const LAS unsigned char* iqs = L + L_IQ; LAS float* nrm = (LAS float*)(L + L_NRM);
        {
            *(LAS bf16x8*)(L + L_IQ + ((w * 2 + 0) * 64 + lane) * 16) = i0; *(LAS bf16x8*)(L + L_IQ + ((w * 2 + 1) * 64 + lane) * 16) = i1;
            float n2 = 0.f;
#pragma unroll
            for (int j = 0; j < 8; ++j) { const float a = __uint_as_float(((unsigned)(unsigned short)i0[j]) << 16), c = __uint_as_float(((unsigned)(unsigned short)i1[j]) << 16); n2 += a * a + c * c; }
            n2 += __shfl_xor(n2, 32);
            if (hi == 0) nrm[w * 32 + r32] = n2;
        }
        {
#pragma unroll
          for (int e = 0; e < 4; ++e) { wq[2 * e] = __uint_as_float(wv[e] << 16); wq[2 * e + 1] = __uint_as_float(wv[e] & 0xffff0000u); } }
        __syncthreads();
        TOC(20);
        float lo = 0.f, invw = 0.f; bool filtF = true;
        if (qt >= 8) {
            float sk2;
            { const bf16x8 k0 = *(const bf16x8*)(ar + C_IK + 8 * hi), k1 = *(const bf16x8*)(ar + C_IK + 16 + 8 * hi); float s = 0.f;
#pragma unroll
              for (int j = 0; j < 8; ++j) { const float a = __uint_as_float(((unsigned)(unsigned short)k0[j]) << 16), c = __uint_as_float(((unsigned)(unsigned short)k1[j]) << 16); s += a * a + c * c; }
              sk2 = wave_sum(s) * (1.f / 1024.f); }
            float sm = 0.f, sv = 0.f;
#pragma unroll
            for (int h = 0; h < 8; ++h) { const float n2 = nrm[h * 32 + r32]; sm += wq[h] * sqrtf(n2); sv += wq[h] * wq[h] * n2; }
            const float sk = sqrtf(sk2), mu = IDX_SCALE * sk * 0.3989423f * sm, sig = fmaxf(IDX_SCALE * sk * sqrtf(0.3408f * sv), 1e-20f);
            const float tail = fminf(1.f, 700.f / (float)(tq + 1));
            const float zq = tail < 0.95f ? -__logf(tail / (1.f - tail)) * (1.f / 1.702f) : -6.f;
            LAS unsigned* q_fail = (LAS unsigned*)(L + L_QI + 384);
            for (int attempt = 0; attempt < 2; ++attempt) {
                const bool filt = attempt == 0; filtF = filt;
                lo = mu + (filt ? zq : -6.f) * sig; invw = (float)NB / ((mu + 6.f * sig) - lo);
                if (attempt == 1) { for (int i = tid; i < (L_MASK - L_HIST) / 16; i += NT) ((LAS u32x4*)(L + L_HIST))[i] = u32x4{0u, 0u, 0u, 0u}; __syncthreads(); }
                TIC(21);
                for (int repH = 0; repH < ((PROBE_DUP == 28) ? 2 : 1); ++repH) {
                    const float lo_h = (PROBE_DUP == 28 && repH == 0) ? 3.0e38f : lo;
                    const bf16* ikp = ab + (size_t)r32 * ACT_COLS + C_IK + 8 * hi;
                    bf16x8 a0 = *(const bf16x8*)(ikp + (size_t)w * 32 * ACT_COLS), a1 = *(const bf16x8*)(ikp + (size_t)w * 32 * ACT_COLS + 16);
                    for (int kt = w; kt <= qt; kt += 8) {
                        const bf16x8 c0 = a0, c1 = a1;
                        if (kt + 8 <= qt) { a0 = *(const bf16x8*)(ikp + (size_t)(kt + 8) * 32 * ACT_COLS); a1 = *(const bf16x8*)(ikp + (size_t)(kt + 8) * 32 * ACT_COLS + 16); }
                        float idx[16]; idx_tile(idx, c0, c1, iqs, wq, lane);
                        if (filt) { f32x4* gp = (f32x4*)(gidx + ((size_t)kt * 64 + lane) * 16);
#pragma unroll
                            for (int i = 0; i < 4; ++i) gp[i] = f32x4{idx[4 * i], idx[4 * i + 1], idx[4 * i + 2], idx[4 * i + 3]}; }
                        const int lim = tq - kt * 32 - 4 * hi;
#pragma unroll
                        for (int r = 0; r < 16; ++r) { const int bn = idx_bin(idx[r], lo_h, invw, filt);
                            if (crow(r, 0) <= lim && bn >= 0) { __hip_atomic_fetch_add(hist + r32 * HSTR + bn, 1u, __ATOMIC_RELAXED, __HIP_MEMORY_SCOPE_WORKGROUP);
#if PROBE_DUP == 26
                                __hip_atomic_fetch_add((LAS unsigned*)(L + 17408) + tid * 7 + (bn % 7), 1u, __ATOMIC_RELAXED, __HIP_MEMORY_SCOPE_WORKGROUP);
#endif
#if PROBE_DUP == 27
                                { LAS unsigned* pp = (LAS unsigned*)(L + 17408) + tid * 7 + (bn % 7); *pp = *pp + 1u; }
#endif
                            } }
                    }
                }
                asm volatile("s_waitcnt vmcnt(0)" ::: "memory");
                __syncthreads();
                TOC(21); TIC(22);
                {
                    const int grp = lane >> 4, sl = lane & 15, q = w * 4 + grp; const LAS unsigned* hrow = hist + q * HSTR + 16 * sl;
                    int c[16];
#pragma unroll
                    for (int i = 0; i < 16; ++i) c[i] = (int)hrow[i];
                    int cl = 0;
#pragma unroll
                    for (int i = 0; i < 16; ++i) cl += c[i];
                    int S = cl;
#pragma unroll
                    for (int o = 1; o < 16; o <<= 1) { const int v = __shfl_down(S, o, 16); if (sl + o < 16) S += v; }
                    const unsigned long long bal = __ballot(S >= IDX_TOPK);
                    const unsigned gb = (unsigned)(bal >> (16 * grp)) & 0xFFFFu;
                    if (gb == 0u) { if (sl == 0) q_fail[0] = 1u; }
                    else {
                        const int Lh = 31 - __clz((int)gb);
                        int above = S - cl, Bq = -1, ca = 0;
#pragma unroll
                        for (int i = 15; i >= 0; --i) { if (Bq < 0) { if (above + c[i] >= IDX_TOPK) { Bq = 16 * sl + i; ca = above; } else above += c[i]; } }
                        if (sl == Lh) { q_B[q] = Bq; q_need[q] = IDX_TOPK - ca; }
                    }
                }
                __syncthreads();
                TOC(22);
                const bool failed = q_fail[0] != 0u;
                if (!failed || attempt == 1) break;
                __syncthreads();
                if (tid == 0) q_fail[0] = 0u;
            }
        }
        TIC(23);
        const int Bq = q_B[r32];
        if (qt >= 8) {
            const f32x4* gp0 = (const f32x4*)(gidx + (size_t)lane * 16);
            f32x4 v0 = gp0[(size_t)w * 256], v1 = gp0[(size_t)w * 256 + 1], v2 = gp0[(size_t)w * 256 + 2], v3 = gp0[(size_t)w * 256 + 3];
            for (int kt = w; kt <= qt; kt += 8) {
                const float idx[16] = {v0[0], v0[1], v0[2], v0[3], v1[0], v1[1], v1[2], v1[3], v2[0], v2[1], v2[2], v2[3], v3[0], v3[1], v3[2], v3[3]};
                if (kt + 8 <= qt) { const f32x4* gn = gp0 + (size_t)(kt + 8) * 256; v0 = gn[0]; v1 = gn[1]; v2 = gn[2]; v3 = gn[3]; }
                unsigned word = 0u; const int lim = tq - kt * 32 - 4 * hi;
#pragma unroll
                for (int r = 0; r < 16; ++r) {
                    if (crow(r, 0) <= lim) { const int bn = idx_bin(idx[r], lo, invw, filtF);
                        if (bn > Bq) word |= 1u << crow(r, 0);
                        else if (bn == Bq) { const unsigned slot = __hip_atomic_fetch_add(q_cnt + r32, 1u, __ATOMIC_RELAXED, __HIP_MEMORY_SCOPE_WORKGROUP); const DsaCand cnd = {__float_as_uint(idx[r]), (unsigned)(kt * 32 + crow(r, hi))};
                            if (slot < (unsigned)CAP) cand[r32 * CAP + slot] = cnd;
                            gcand[(size_t)r32 * SEQ + slot] = cnd; } } }
                if (word) __hip_atomic_fetch_or(mask + r32 * 64 + kt, word << (4 * hi), __ATOMIC_RELAXED, __HIP_MEMORY_SCOPE_WORKGROUP);
            }
        } else {
            for (int kt = w; kt <= qt; kt += 8) { const int lim = tq - kt * 32 - 4 * hi; unsigned word = 0u;
#pragma unroll
                for (int r = 0; r < 16; ++r) if (crow(r, 0) <= lim) word |= 1u << crow(r, 0);
                if (word) __hip_atomic_fetch_or(mask + r32 * 64 + kt, word << (4 * hi), __ATOMIC_RELAXED, __HIP_MEMORY_SCOPE_WORKGROUP); }
        }
        asm volatile("s_waitcnt vmcnt(0)" ::: "memory");
        __syncthreads();
        TOC(23); TIC(24);
        { const bf16* qp = ab + (size_t)tq * ACT_COLS + C_DQ + w * 64 + 8 * hi;
#pragma unroll
          for (int d0 = 0; d0 < 4; ++d0) qf[d0] = *(const bf16x8*)(qp + d0 * 16);
          kpre = *(const u32x4*)kg0; vpre = *(const u32x4*)vg0; }
#pragma unroll 1
        for (int qq = 0; qq < ((PROBE_DUP == 29) ? 8 : 4); ++qq) {
            const int q = w * 4 + (qq & 3); const int nc = (int)q_cnt[q], need = q_need[q];
            if (nc <= CAP) {
                DsaCand me = {0u, 0u}; if (lane < nc) me = cand[q * CAP + lane];
                const float mv = __uint_as_float(me[0]); int rk = 0;
                for (int j = 0; j < nc; ++j) { const float ov = __uint_as_float((unsigned)__builtin_amdgcn_readlane((int)me[0], j)); const unsigned ok = (unsigned)__builtin_amdgcn_readlane((int)me[1], j);
                    rk += (ov > mv || (ov == mv && ok < me[1])) ? 1 : 0; }
                if (lane < nc && rk < need) __hip_atomic_fetch_or(mask + q * 64 + (me[1] >> 5), 1u << (me[1] & 31u), __ATOMIC_RELAXED, __HIP_MEMORY_SCOPE_WORKGROUP);
            } else {
                const unsigned long long* gc = (const unsigned long long*)(gcand + (size_t)q * SEQ);
                for (int i0 = 0; i0 < nc; i0 += 64) { const int i = i0 + lane;
                    if (i < nc) { const unsigned long long me = __hip_atomic_load(gc + i, __ATOMIC_RELAXED, __HIP_MEMORY_SCOPE_AGENT); const float mv = __uint_as_float((unsigned)me); const unsigned mk = (unsigned)(me >> 32); int rk = 0;
                        for (int j = 0; j < nc; ++j) { const unsigned long long ot = __hip_atomic_load(gc + j, __ATOMIC_RELAXED, __HIP_MEMORY_SCOPE_AGENT); const float ov = __uint_as_float((unsigned)ot); const unsigned ok = (unsigned)(ot >> 32);
                            rk += (ov > mv || (ov == mv && ok < mk)) ? 1 : 0; }
                        if (rk < need) __hip_atomic_fetch_or(mask + q * 64 + (mk >> 5), 1u << (mk & 31u), __ATOMIC_RELAXED, __HIP_MEMORY_SCOPE_WORKGROUP); } }
            }
        }
        __syncthreads();
    }
    TOC(24); TOC(11);
    TIC(12);
    const int ntile = (qt >> 1) + 1;
    struct DsaStg { const bf16* kg; const bf16* vg; LAS unsigned char* kdst; u32x4 kreg, vreg;
        __device__ __forceinline__ void load(int t) { kreg = *(const u32x4*)(kg + (size_t)t * 64 * ACT_COLS); vreg = *(const u32x4*)(vg + (size_t)t * 64 * ACT_COLS); }
        __device__ __forceinline__ void store(int ks, int vs) { *(LAS u32x4*)(kdst + ks * 8192) = kreg; *(LAS u32x4*)(kdst + 16384 + vs * 8192) = vreg; }
        __device__ __forceinline__ void load_after() {} };
    struct DsaMask { const LAS unsigned* mrow; int hi;
        __device__ __forceinline__ void operator()(f32x16& c0, f32x16& c1, int t, float negm) const { cinit_splat(c0, negm); cinit_splat(c1, negm); }
        __device__ __forceinline__ void post(f32x16& p0, f32x16& p1, int t) const { const u32x2 mw = *(const LAS u32x2*)(mrow + 2 * t); mask_bits(p0, mw[0], hi); mask_bits(p1, mw[1], hi); } };
    DsaStg sg; sg.kg = kg0; sg.vg = vg0; sg.kreg = kpre; sg.vreg = vpre;
    sg.kdst = L + L_KV + w * 1024 + lane * 16;
    DsaMask mk{mask + r32 * 64, hi};
    float m = 0.f, l = 0.f; f32x16 o[2]; o[0] = f32x16{}; o[1] = f32x16{};
    flash_loop_r(0, ntile, sg, mk, qf, L + L_KV, 8192, L + L_KV + 16384, 8192, m, l, o, wsf, lane, r32, hi, true);
    const float ltot = l + __shfl_xor(l, 32);
    LAS float* stg = (LAS float*)(L + L_STG) + w * 2048;
    const float ss = stage_o(o, ltot, wsf, stg, lane, r32, hi);
    if ((lane & 1) == 0) rowsq[w * 32 + (lane >> 1)] = ss;
    __syncthreads();
    float tot = 0.f;
#pragma unroll
    for (int h = 0; h < 8; ++h) tot += rowsq[h * 32 + (lane >> 1)];
    const float rinv = rsqrtf(tot * (1.f / 512.f) + LN_EPS);
    store_o(stg, rinv, mix_gain + w * 64, MIXED_F8 ? (bf16*)((unsigned char*)mixed + ((size_t)b * SEQ + qt * 32 + (lane >> 1)) * D_MODEL + w * 64) : mixed + ((size_t)b * SEQ + qt * 32 + (lane >> 1)) * D_MODEL + w * 64, lane);
    __syncthreads();
    TOC(12);
}
}


namespace cmp {
using att::bf16x8; using att::f32x16; using att::crow; using att::cvtpk;
__device__ __forceinline__ void compress_unit(LAS unsigned char* L, const bf16* __restrict__ act, const bf16* __restrict__ w1t, const bf16* __restrict__ w2t, const float* __restrict__ bias1,
                                              bf16* __restrict__ kcb, float* __restrict__ kcf, int u) {
    const int tid = threadIdx.x, lane = tid & 63, r32 = lane & 31, hi = lane >> 5; const int w = __builtin_amdgcn_readfirstlane(tid >> 6);
    const int cb = u & 3, g = (u >> 2) & 1, b = (u >> 3) & 15, kv = u >> 7;
    const int c = cb * 32 + r32, cc = c < N_C ? c : N_C - 1;
    LAS float* part = (LAS float*)L;
    {
        const bf16* arow = act + ((size_t)b * SEQ + cc * CMP_STRIDE) * ACT_COLS + (kv ? C_VCM : C_KCM) + g * 64 + 8 * hi;
        const bf16* wrow = w1t + ((size_t)kv * CMP_HIDDEN + r32) * 2048 + 8 * hi;
        f32x16 acc[4]; acc[0] = f32x16{}; acc[1] = f32x16{}; acc[2] = f32x16{}; acc[3] = f32x16{};
#pragma unroll 4
        for (int i = 0; i < 16; ++i) { const int s = 16 * w + i;
            const bf16x8 bfr_ = *(const bf16x8*)(arow + (size_t)(s >> 2) * ACT_COLS + 16 * (s & 3));
#pragma unroll
            for (int nb = 0; nb < 4; ++nb) { const bf16x8 af = *(const bf16x8*)(wrow + (size_t)nb * 32 * 2048 + 16 * s); acc[nb] = __builtin_amdgcn_mfma_f32_32x32x16_bf16(af, bfr_, acc[nb], 0, 0, 0); } }
#pragma unroll
        for (int nb = 0; nb < 4; ++nb)
#pragma unroll
            for (int r = 0; r < 16; ++r) part[((w * 4 + nb) * 16 + r) * 64 + lane] = acc[nb][r];
    }
    __syncthreads();
    f32x16 acc2[2]; acc2[0] = f32x16{}; acc2[1] = f32x16{};
    {
        const int nb = w >> 1, s2 = w & 1; float x[8];
#pragma unroll
        for (int j = 0; j < 8; ++j) { const int r = 8 * s2 + j; float a = 0.f;
#pragma unroll
            for (int p = 0; p < 8; ++p) a += part[((p * 4 + nb) * 16 + r) * 64 + lane];
            a += bias1[kv * CMP_HIDDEN + 32 * nb + crow(r, hi)];
            const float uu = 0.7978845608028654f * (a + 0.044715f * a * a * a); x[j] = 0.5f * a * (1.f + tanhf(uu)); }
        const att::u32x4 xb = {cvtpk(x[0], x[1]), cvtpk(x[2], x[3]), cvtpk(x[4], x[5]), cvtpk(x[6], x[7])};
#pragma unroll
        for (int db = 0; db < 2; ++db) { const bf16* wp = w2t + ((size_t)kv * 64 + 32 * db + r32) * CMP_HIDDEN + 32 * nb + 16 * s2 + 4 * hi;
            const att::u32x2 lo = *(const att::u32x2*)wp, hh = *(const att::u32x2*)(wp + 8);
            const att::u32x4 af = {lo[0], lo[1], hh[0], hh[1]};
            acc2[db] = __builtin_amdgcn_mfma_f32_32x32x16_bf16(__builtin_bit_cast(bf16x8, af), __builtin_bit_cast(bf16x8, xb), acc2[db], 0, 0, 0); }
    }
    __syncthreads();
#pragma unroll
    for (int db = 0; db < 2; ++db)
#pragma unroll
        for (int r = 0; r < 16; ++r) part[((w * 2 + db) * 16 + r) * 64 + lane] = acc2[db][r];
    __syncthreads();
#pragma unroll
    for (int i = 0; i < 4; ++i) { const int e = tid + i * NT;
        const int ln = e & 63, r = (e >> 6) & 15, db = e >> 10; float a = 0.f;
#pragma unroll
        for (int p = 0; p < 8; ++p) a += part[((p * 2 + db) * 16 + r) * 64 + ln];
        const int c2 = cb * 32 + (ln & 31), d = 32 * db + crow(r, ln >> 5);
        const float v = c2 < N_C ? a : 0.f;
        kcb[(((size_t)kv * BATCH + b) * 128 + c2) * 128 + g * 64 + d] = (bf16)f2bf(v);
        if (kcf && c2 < N_C) kcf[(size_t)kv * BATCH * N_C * 128 + ((size_t)(b * N_C + c2) * 2 + g) * 64 + d] = bfr(v); }
    __syncthreads();
}
}

namespace att {
constexpr int N_SLAB = 65536, N_OUT = 65536, N_WSF = 135168, N_ROWSQ = 137216, N_SEL = 138240, N_IMPF = 139264;
struct KvStage { u32x4 k[2], v[2]; };
__device__ __forceinline__ void kv_load(KvStage& st, const bf16* __restrict__ kbase, const bf16* __restrict__ vbase, int pitch, int key0, int w, int lane) {
    const bf16* kp = kbase + (size_t)(key0 + lane) * pitch + 8 * w; const bf16* vp = vbase + (size_t)(key0 + 16 * (w & 3) + (lane >> 2)) * pitch + 32 * (w >> 2) + 8 * (lane & 3);
    st.k[0] = *(const u32x4*)kp; st.k[1] = *(const u32x4*)(kp + 64); st.v[0] = *(const u32x4*)vp; st.v[1] = *(const u32x4*)(vp + 64);
}
__device__ __forceinline__ void kv_store(const KvStage& st, LAS unsigned char* slot, int w, int lane) {
    LAS unsigned char* d = slot + w * 1024 + lane * 16;
    *(LAS u32x4*)d = st.k[0]; *(LAS u32x4*)(d + 8192) = st.k[1]; *(LAS u32x4*)(d + 16384) = st.v[0]; *(LAS u32x4*)(d + 24576) = st.v[1];
}
__device__ __forceinline__ void pack_p(u32x4 (&pw)[4], const f32x16& p0, const f32x16& p1) {
    pw[0] = u32x4{cvtpk(p0[0], p0[1]), cvtpk(p0[2], p0[3]), cvtpk(p0[4], p0[5]), cvtpk(p0[6], p0[7])};
    pw[1] = u32x4{cvtpk(p0[8], p0[9]), cvtpk(p0[10], p0[11]), cvtpk(p0[12], p0[13]), cvtpk(p0[14], p0[15])};
    pw[2] = u32x4{cvtpk(p1[0], p1[1]), cvtpk(p1[2], p1[3]), cvtpk(p1[4], p1[5]), cvtpk(p1[6], p1[7])};
    pw[3] = u32x4{cvtpk(p1[8], p1[9]), cvtpk(p1[10], p1[11]), cvtpk(p1[12], p1[13]), cvtpk(p1[14], p1[15])};
}
template <bool FIRST> __device__ __forceinline__ void accum_out(LAS float* OUTw, const f32x16* o, float fac, LAS float* wsf, int r32, int hi) {
    if (hi == 0) wsf[r32] = fac;
#pragma unroll
    for (int r = 0; r < 16; ++r) { const int q = crow(r, hi); const float f = wsf[q];
        if (FIRST) { OUTw[q * 64 + r32] = f * o[0][r]; OUTw[q * 64 + 32 + r32] = f * o[1][r]; }
        else { OUTw[q * 64 + r32] += f * o[0][r]; OUTw[q * 64 + 32 + r32] += f * o[1][r]; } }
}
__device__ __forceinline__ void nsa_unit(LAS unsigned char* L, const bf16* __restrict__ act, const bf16* __restrict__ kcb, const float* __restrict__ mix_gain, bf16* __restrict__ mixed, int b, int qt,
                                         bool pre_valid  , volatile LAS unsigned* nextp  , bool& prefetched) {
    int tid = threadIdx.x; asm volatile("" : "+v"(tid));
    const int lane = tid & 63, r32 = lane & 31, hi = lane >> 5; const int w = __builtin_amdgcn_readfirstlane(tid >> 6); const int g = w >> 2;
    LAS float* slab = (LAS float*)(L + N_SLAB); LAS float* OUTw = (LAS float*)(L + N_OUT) + w * 2048; LAS float* wsf = (LAS float*)(L + N_WSF) + w * 64;
    LAS float* rowsq = (LAS float*)(L + N_ROWSQ); LAS unsigned* selmask = (LAS unsigned*)(L + N_SEL); LAS float* impf = (LAS float*)(L + N_IMPF);
    const int tq = qt * 32 + r32; const size_t rowq = (size_t)b * SEQ + tq; const bf16* ab = act + (size_t)b * SEQ * ACT_COLS;
    bf16x8 qf[4];
    { const bf16* qp = act + rowq * ACT_COLS + C_NQ + w * 64 + 8 * hi;
#pragma unroll
      for (int d0 = 0; d0 < 4; ++d0) qf[d0] = *(const bf16x8*)(qp + d0 * 16); }
    const bf16* gp = act + rowq * ACT_COLS + C_NG + w * 3;
    const float gate0 = bf2f(gp[0]);
    LAS unsigned char* slot0 = L; LAS unsigned char* slot1 = L + 32768;
    f32x16 o[2];
    struct NsaStg { const bf16* kbase; const bf16* vbase; const bf16* kafter; const bf16* vafter; int key_after; LAS unsigned char* slot0; int w, lane; KvStage st;
        __device__ __forceinline__ void load(int t) { kv_load(st, kbase, vbase, ACT_COLS, t * 64, w, lane); }
        __device__ __forceinline__ void store(int bsel) { kv_store(st, slot0 + bsel * 32768, w, lane); }
        __device__ __forceinline__ void load_after() { if (kafter) kv_load(st, kafter, vafter, ACT_COLS, key_after, w, lane); } };
    NsaStg sg; sg.slot0 = slot0; sg.w = w; sg.lane = lane;
    TIC(13);
    {
        const bf16* kc = kcb + (size_t)b * 128 * 128; const bf16* vc = kcb + (size_t)(BATCH + b) * 128 * 128;
        if (!pre_valid) { KvStage a0, a1; kv_load(a0, kc, vc, 128, 0, w, lane); kv_load(a1, kc, vc, 128, 64, w, lane); kv_store(a0, slot0, w, lane); kv_store(a1, slot1, w, lane); }
        __syncthreads();
        kv_load(sg.st, ab + C_KSL, ab + C_VSL, ACT_COLS, 0, w, lane);
        f32x16 p[4];
        p[0] = f32x16{}; p[1] = f32x16{}; p[2] = f32x16{}; p[3] = f32x16{};
        qkt(p[0], p[1], slot0 + g * 8192, qf, r32, hi); qkt(p[2], p[3], slot1 + g * 8192, qf, r32, hi);
        const int n_adm = tq >= 31 ? min((tq - 31) / 16 + 1, N_C) : 0;
        float rm = NEG_INF;
#pragma unroll
        for (int u = 0; u < 4; ++u)
#pragma unroll
            for (int r = 0; r < 16; ++r) { const int c = 32 * u + crow(r, hi); p[u][r] = c < n_adm ? p[u][r] : NEG_INF; rm = fmaxf(rm, p[u][r]); }
        rm = fmaxf(rm, __shfl_xor(rm, 32));
        const float mc = rm > NEG_INF ? rm : 0.f; float s = 0.f;
#pragma unroll
        for (int u = 0; u < 4; ++u)
#pragma unroll
            for (int r = 0; r < 16; ++r) { p[u][r] = ex2(p[u][r] - mc); s += p[u][r]; }
        s += __shfl_xor(s, 32);
        const float inv = 1.f / fmaxf(s, 1e-30f);
#pragma unroll
        for (int u = 0; u < 4; ++u)
#pragma unroll
            for (int r = 0; r < 16; ++r) p[u][r] *= inv;
        float xl[16];
#pragma unroll
        for (int u = 0; u < 4; ++u)
#pragma unroll
            for (int k = 0; k < 4; ++k) xl[u * 4 + k] = __shfl_xor(p[u][4 * k + 3], 32);
#pragma unroll
        for (int u = 0; u < 4; ++u)
#pragma unroll
            for (int k = 0; k < 4; ++k) {
                const float A = (p[u][4 * k] + p[u][4 * k + 1]) + (p[u][4 * k + 2] + p[u][4 * k + 3]);
                const float xprev = (u * 4 + k) > 0 ? xl[(u * 4 + k) > 0 ? u * 4 + k - 1 : 0] : 0.f;
                const float val = A + (hi ? xl[u * 4 + k] : xprev);
                slab[(w * 32 + r32) * 32 + 8 * u + 2 * k + hi] = val;
            }
        u32x4 pw[4]; o[0] = f32x16{}; o[1] = f32x16{};
        pack_p(pw, p[0], p[1]); pv(o, slot0 + 16384 + g * 8192, lane, hi, pw);
        pack_p(pw, p[2], p[3]); pv(o, slot1 + 16384 + g * 8192, lane, hi, pw);
        __syncthreads();
#pragma unroll
        for (int i = 0; i < 4; ++i) { const int e = tid + i * NT, j = e & 31, q = (e >> 5) & 31, gg = e >> 10;
            float v = ((slab[((gg * 4 + 0) * 32 + q) * 32 + j] + slab[((gg * 4 + 1) * 32 + q) * 32 + j]) + slab[((gg * 4 + 2) * 32 + q) * 32 + j]) + slab[((gg * 4 + 3) * 32 + q) * 32 + j];
            const int cur = (qt * 32 + q) >> 6;
            if (j == 0 || j == cur || j == cur - 1) v = 1.0e4f;
            if (j > cur) v = -1.0f;
            impf[e] = v; }
        __syncthreads();
#pragma unroll
        for (int i = 0; i < 4; ++i) { const int gq = i * 16 + (tid >> 5), j = tid & 31; const float v = impf[gq * 32 + j]; int rk = 0;
#pragma unroll
            for (int i2 = 0; i2 < 32; ++i2) { const float vi = impf[gq * 32 + i2]; rk += (vi > v || (vi == v && i2 < j)) ? 1 : 0; }
            const unsigned long long bal = __ballot(rk < SLC_COUNT);
            if ((tid & 31) == 0) selmask[gq] = (lane < 32) ? (unsigned)bal : (unsigned)(bal >> 32); }
        __syncthreads();
        accum_out<true>(OUTw, o, gate0, wsf, r32, hi);
    }
    TOC(13); TIC(14);
    const int T0 = (qt * 32 - 511) > 0 ? ((qt * 32 - 511) >> 6) : 0, T1 = qt >> 1;
    {
        struct SlcMask { unsigned sel; int tq, hi, last;
            __device__ __forceinline__ void operator()(f32x16& c0, f32x16& c1, int t, float negm) const { cinit_splat(c0, negm); cinit_splat(c1, negm); }
            __device__ __forceinline__ void post(f32x16& p0, f32x16& p1, int t) const { const bool on = (sel >> t) & 1u;
                if (t == last) { const int lim = on ? tq - t * 64 - 4 * hi : -1;
#pragma unroll
                    for (int r = 0; r < 16; ++r) { p0[r] = (crow(r, 0) <= lim) ? p0[r] : NEG_INF; p1[r] = (crow(r, 0) + 32 <= lim) ? p1[r] : NEG_INF; }
                } else {
#pragma unroll
                    for (int r = 0; r < 16; ++r) { p0[r] = on ? p0[r] : NEG_INF; p1[r] = on ? p1[r] : NEG_INF; }
                } } };
        const int ntile = (qt >> 1) + 1;
        sg.kbase = ab + C_KSL; sg.vbase = ab + C_VSL; sg.kafter = ab + C_KWN; sg.vafter = ab + C_VWN; sg.key_after = T0 * 64;
        SlcMask mk{selmask[g * 32 + r32], tq, hi, ntile - 1}; const float gate1 = bf2f(gp[1]);
        float m = 0.f, l = 0.f; o[0] = f32x16{}; o[1] = f32x16{};
        flash_loop_b(0, ntile, sg, mk, qf, slot0 + g * 8192, slot0 + 16384 + g * 8192, 32768, m, l, o, wsf, lane, r32, hi, true);
        const float ltot = l + __shfl_xor(l, 32);
        accum_out<false>(OUTw, o, gate1 / fmaxf(ltot, 1e-30f), wsf, r32, hi);
    }
    TOC(14); TIC(15);
    {
        struct WinMask { int tq, hi, qt;
            __device__ __forceinline__ void operator()(f32x16& c0, f32x16& c1, int t, float negm) const { cinit_splat(c0, negm); cinit_splat(c1, negm); }
            __device__ __forceinline__ void post(f32x16& p0, f32x16& p1, int t) const {
                if (t * 64 < qt * 32 - 480 || t * 64 + 63 > qt * 32) { const int lim = tq - t * 64 - 4 * hi;
#pragma unroll
                    for (int r = 0; r < 16; ++r) {
                        p0[r] = ((unsigned)(lim - crow(r, 0)) < (unsigned)WINDOW) ? p0[r] : NEG_INF; p1[r] = ((unsigned)(lim - crow(r, 0) - 32) < (unsigned)WINDOW) ? p1[r] : NEG_INF; }
                } } };
        sg.kbase = ab + C_KWN; sg.vbase = ab + C_VWN; sg.kafter = nullptr; sg.vafter = nullptr;
        WinMask mk{tq, hi, qt}; const float gate2 = bf2f(gp[2]);
        float m = 0.f, l = 0.f; o[0] = f32x16{}; o[1] = f32x16{};
        flash_loop_b(T0, T1 - T0 + 1, sg, mk, qf, slot0 + g * 8192, slot0 + 16384 + g * 8192, 32768, m, l, o, wsf, lane, r32, hi, true);
        const float ltot = l + __shfl_xor(l, 32);
        accum_out<false>(OUTw, o, gate2 / fmaxf(ltot, 1e-30f), wsf, r32, hi);
    }
    KvStage pre0, pre1;
    {
        const unsigned rn = (unsigned)__builtin_amdgcn_readfirstlane((int)*nextp); const int next_b = (rn < 2048u && (rn & 255u) >= 128u) ? (int)(2u * (rn >> 8) + (rn & 1u)) : -1;
        prefetched = next_b >= 0;
        if (next_b >= 0) { const bf16* kcn = kcb + (size_t)next_b * 128 * 128; const bf16* vcn = kcb + (size_t)(BATCH + next_b) * 128 * 128;
            kv_load(pre0, kcn, vcn, 128, 0, w, lane); kv_load(pre1, kcn, vcn, 128, 64, w, lane); }
    }
    TOC(15); TIC(16);
    float ss = 0.f;
    { const LAS f32x4* rowp = (const LAS f32x4*)(OUTw + (lane >> 1) * 64 + (lane & 1) * 32);
#pragma unroll
      for (int i = 0; i < 8; ++i) { const f32x4 v = rowp[i]; ss += (v[0] * v[0] + v[1] * v[1]) + (v[2] * v[2] + v[3] * v[3]); }
      ss += __shfl_xor(ss, 1); }
    if ((lane & 1) == 0) rowsq[w * 32 + (lane >> 1)] = ss;
    if (prefetched) { kv_store(pre0, slot0, w, lane); kv_store(pre1, slot1, w, lane); }
    __syncthreads();
    float tot = 0.f;
#pragma unroll
    for (int h = 0; h < 8; ++h) tot += rowsq[h * 32 + (lane >> 1)];
    const float rinv = rsqrtf(tot * (1.f / 512.f) + LN_EPS);
    store_o(OUTw, rinv, mix_gain + 512 + w * 64, MIXED_F8 ? (bf16*)((unsigned char*)mixed + ((size_t)b * SEQ + qt * 32 + (lane >> 1)) * D_MODEL + 512 + w * 64) : mixed + ((size_t)b * SEQ + qt * 32 + (lane >> 1)) * D_MODEL + 512 + w * 64, lane);
    __syncthreads();
    TOC(16);
}
}
struct Args { const float* in[16]; float* out; unsigned char* ws; int ph_lo, ph_hi, li, pad; };
constexpr int N_PHASES = 8;
__global__ void __launch_bounds__(NT, 2) mk_fwd(Args args) {
    extern __shared__ __attribute__((aligned(16))) unsigned char lds_raw[];
    LAS unsigned char* lds = (LAS unsigned char*)lds_raw;
    volatile LAS unsigned* MISC = (volatile LAS unsigned*)(lds + MISC_OFF);
    const int tid = threadIdx.x, lane = tid & 63, wave = __builtin_amdgcn_readfirstlane(tid >> 6);
    const int G = gridDim.x; const int vcu = (G % 8 == 0) ? ((int)blockIdx.x % 8) * (G / 8) + (int)blockIdx.x / 8 : (int)blockIdx.x;
    unsigned char* ws = args.ws;
    gu32* ctl = (gu32*)(ws + WS_CTL);
    const float* x = args.in[0]; const int* pos = (const int*)args.in[1]; const float* w_in = args.in[2]; const float* b_in = args.in[3];
    const float* cmp_pos = args.in[4]; const float* cmp_w1 = args.in[5]; const float* cmp_w2 = args.in[6]; const float* mix_gain = args.in[7];
    const float* w_out = args.in[8]; const float* ln1_g = args.in[9]; const float* ln1_b = args.in[10]; const float* w_gate = args.in[11];
    const float* w_up = args.in[12]; const float* w_down = args.in[13]; const float* ln2_g = args.in[14]; const float* ln2_b = args.in[15];
    float* out = args.out;
    float* stats1 = (float*)(ws + CTL_STATS1); float* cs = (float*)(ws + CTL_CS); float* bs = cs + 5632;
    float* rope = (float*)(ws + WS_ROPE); float* biasP = (float*)(ws + WS_BIASP);
    bf16* Wt_in = (bf16*)(ws + WS_WIN); bf16* Wt_out = (bf16*)(ws + WS_WOUT); bf16* Wt_gu = (bf16*)(ws + WS_WGU); bf16* Wt_dn = (bf16*)(ws + WS_WDN);
    float* kcvc = (float*)(ws + WS_KC); bf16* kcb = (bf16*)(ws + WS_KCB); bf16* w1t = (bf16*)(ws + WS_W1T); bf16* w2t = (bf16*)(ws + WS_W2T); float* cb1 = (float*)(ws + CTL_CB1);
    bf16* act = (bf16*)(ws + WS_ACT); bf16* actf = (bf16*)(ws + WS_ACTF); bf16* xb = (bf16*)(ws + WS_XB); bf16* mixed = (bf16*)(ws + WS_MIXED); unsigned char* v1q = ws + WS_GCAND; unsigned char* actq = ws + WS_ACTF;
    bf16* v1b = (bf16*)(ws + WS_V1B); bf16* v2b = (bf16*)(ws + WS_MIXED);

    for (int u = tid; u < (LDS_BYTES - LDSCTL_OFF) / 4; u += NT) ((LAS unsigned*)(lds + LDSCTL_OFF))[u] = 0u;
    __syncthreads();
#if PROBE_T >= 0
    if (blockIdx.x == 0 && tid == 0) t_acc = 0ull;
#endif
    XcdBarrier bar = xcd_barrier_post((unsigned*)(ctl + CW_BAR) + args.li * XCD_BAR_WORDS, MISC + 8);
    const int lo = args.ph_lo, hi = args.ph_hi;
#ifndef PROBE_DUP
#define PROBE_DUP -1
#endif
#define NREP(k) ((PROBE_DUP == (k)) ? 2 : 1)
#define IN(k) (lo <= (k) && (k) < hi)
#define SEAM(k) do { if (IN(k) && IN((k) + 1)) { TIC(8); TIC(60 + (k)); xcd_barrier(bar); TOC(60 + (k)); TOC(8); } } while (0)

    TIC(0);
    if (IN(0)) for (int rep = 0; rep < NREP(0); ++rep) {
        float* cs_ = (rep == NREP(0) - 1) ? cs : nullptr;
        const int gw = vcu * NWAVES + wave, NGW = G * NWAVES;
        constexpr int I_IN = 16 * 36, I_OUT = 16 * 16, I_GU = 16 * 88, I_DN = 44 * 16, I_W1 = 2 * 64, I_W2 = 2 * 2, NITEMS = I_IN + I_OUT + I_GU + I_DN + I_W1 + I_W2;
        TIC(30);
        for (int it = gw; it < NITEMS; it += NGW) {
            int r = it;
            if (r < I_GU) { const int kb = r / 88, nb = r % 88, n0 = 64 * nb, pn = n0 >> 8, within = n0 & 255; const bool isup = within >= 128;
                tr64<true>(isup ? w_up : w_gate, FFN, 1024, Wt_gu, n0, 64 * kb, pn * 128 + (within & 127) + lane, ln1_g, S_GU, ln1_b, cs_, cs_ ? bs : nullptr, lane); continue; } r -= I_GU;
            if (r < I_DN) { const int kb = r / 16, nb = r % 16; tr64<true>(w_down, 1024, FFN, Wt_dn, 64 * nb, 64 * kb, 64 * nb + lane, nullptr, S_DN, nullptr, nullptr, nullptr, lane); continue; } r -= I_DN;
            if (r < I_IN) { const int kb = r / 36, nb = r % 36; tr64<false>(w_in, IN_COLS, 1024, Wt_in, 64 * nb, 64 * kb, orig_col(64 * nb + lane), nullptr, 1.f, nullptr, nullptr, nullptr, lane); continue; } r -= I_IN;
            if (r < I_OUT) { const int kb = r / 16, nb = r % 16; if (MIXED_F8) tr64<true>(w_out, 1024, 1024, Wt_out, 64 * nb, 64 * kb, 64 * nb + lane, nullptr, S_OUT, nullptr, nullptr, nullptr, lane); else tr64<false>(w_out, 1024, 1024, Wt_out, 64 * nb, 64 * kb, 64 * nb + lane, nullptr, 1.f, nullptr, nullptr, nullptr, lane); continue; } r -= I_OUT;
            if (r < I_W1) { const int kv = r >> 6, kb = (r >> 1) & 31, nb = r & 1;
                tr64<false>(cmp_w1 + (size_t)kv * 2048 * 128, 128, 2048, w1t + (size_t)kv * 128 * 2048, 64 * nb, 64 * kb, 64 * nb + lane, nullptr, 1.f, cmp_pos + kv * 2048, nullptr, cs_ ? cb1 + kv * 128 : nullptr, lane); continue; } r -= I_W1;
            { const int kv = r >> 1, kb = r & 1; tr64<false>(cmp_w2 + (size_t)kv * 128 * 64, 64, 128, w2t + (size_t)kv * 64 * 128, 0, 64 * kb, lane, nullptr, 1.f, nullptr, nullptr, nullptr, lane); }
        }
        TOC(30); TIC(31);
        for (int m0 = gw * 4; m0 < T; m0 += NGW * 4) {
            f32x4 v[4][2][2];
#pragma unroll
            for (int rr = 0; rr < 4; ++rr)
#pragma unroll
                for (int j = 0; j < 2; ++j) { const GAS f32x4* xr = (const GAS f32x4*)(x + (size_t)(m0 + rr) * 1024 + 512 * j) + 2 * lane; v[rr][j][0] = xr[0]; v[rr][j][1] = xr[1]; }
#pragma unroll
            for (int rr = 0; rr < 4; ++rr)
#pragma unroll
                for (int j = 0; j < 2; ++j) { v4u o; o.x = pk2(v[rr][j][0].x, v[rr][j][0].y); o.y = pk2(v[rr][j][0].z, v[rr][j][0].w); o.z = pk2(v[rr][j][1].x, v[rr][j][1].y); o.w = pk2(v[rr][j][1].z, v[rr][j][1].w);
                    *((GAS v4u*)(xb + (size_t)(m0 + rr) * 1024 + 512 * j) + lane) = o; }
        }
        TOC(31); TIC(32);
        for (int i = gw * 64 + lane; i < T * 8; i += NGW * 64) {
            const float inv[8] = {1.0f, 0.19392274474868576f, 0.03760603093086393f, 0.007292664737217109f, 0.001414213562373095f, 0.0002742481756762073f, 5.318295896944988e-05f, 1.031338537721246e-05f};
            const int t = i >> 3, j = i & 7; float sn, cn; sincosf((float)pos[t] * inv[j], &sn, &cn);
            rope[2 * i] = cn; rope[2 * i + 1] = sn;
        }
        for (int i = gw * 64 + lane; i < ACT_COLS; i += NGW * 64) { const int oc = orig_col(i); biasP[i] = oc >= 0 ? b_in[oc] : 0.f; }
        TOC(32);
    }
    TOC(0);
    SEAM(0);
    TIC(1);
    if (IN(1)) for (int rep = 0; rep < NREP(1); ++rep) {
        pg8::Gemm g{xb, Wt_in, T, ACT_COLS, 1024}; pg8::StaticOrder S; S.init(T, ACT_COLS, G, (int)blockIdx.x);
        pg8::EpiInProj E{act, biasP, rope, att::C2};
        pg8::gemm_phase<pg8::EpiInProj, pg8::StaticOrder, true, true>(lds, g, S, E);
    }
    TOC(1);
    SEAM(1);
#if PROBE_T == 50
    unsigned long long sp_t0 = __builtin_amdgcn_s_memrealtime();
#endif
    TIC(2);
    if (IN(2)) for (int rep = 0; rep < NREP(2); ++rep) {
        gu32* cmp_cnt = ctl + 8192;
        TIC(10);
        for (int u = vcu; u < 256; u += G) { cmp::compress_unit(lds, act, w1t, w2t, cb1, kcb, nullptr, u);
            asm volatile("s_waitcnt vmcnt(0)" ::: "memory"); __syncthreads();
            if (tid == 0 && rep == NREP(2) - 1) { __builtin_amdgcn_fence(__ATOMIC_RELEASE, "agent"); asm volatile("s_waitcnt vmcnt(0)" ::: "memory"); __hip_atomic_fetch_add(cmp_cnt, 1u, RLX_AGENT); } }
        TOC(10);
        att::DsaCand* gcand = (att::DsaCand*)(ws + WS_GCAND) + (size_t)blockIdx.x * 32 * SEQ;
        float* gidx = (float*)(ws + WS_V1B) + (size_t)blockIdx.x * 65536;
        gu32* qhead = ctl + 8320;
        unsigned curq = bar.x & 7u;
#define DRAW_UNIT(dst) do { unsigned u_ = 0xFFFFFFFFu; for (int t_ = 0; t_ < 8; ++t_) { const unsigned r_ = __hip_atomic_fetch_add(qhead + 64 * curq, 1u, RLX_AGENT); if (r_ < 256u) { u_ = curq * 256u + r_; break; } curq = (curq + 1u) & 7u; } (dst) = u_; } while (0)
        if (tid == 0) DRAW_UNIT(MISC[12]);
        __syncthreads();
        bool cmp_ok = false;
        for (int k = 0;;) {
            unsigned u = (unsigned)__builtin_amdgcn_readfirstlane((int)MISC[12 + (k & 1)]);
            if (u >= 2048u) break;
            if (tid == 0) DRAW_UNIT(MISC[12 + ((k + 1) & 1)]);
            if ((u & 255u) < 128u) { att::dsa_unit(lds, act, mix_gain, mixed, gcand, gidx, (int)(2u * (u >> 8) + (u & 1u)), 63 - (int)((u & 127u) >> 1)); ++k; continue; }
            if (!cmp_ok) {
                if (tid == 0) { unsigned sp = 0; while (__hip_atomic_load(cmp_cnt, RLX_AGENT) < 256u) { __builtin_amdgcn_s_sleep(2); if (++sp > (1u << 22)) break; }
                    __builtin_amdgcn_fence(__ATOMIC_ACQUIRE, "agent"); asm volatile("s_waitcnt vmcnt(0)" ::: "memory"); }
                __syncthreads(); cmp_ok = true; }
            bool pre_valid = false;
            for (;;) {
                bool pf = false; att::nsa_unit(lds, act, kcb, mix_gain, mixed, (int)(2u * (u >> 8) + (u & 1u)), 63 - (int)((u & 127u) >> 1), pre_valid, MISC + 12 + ((k + 1) & 1), pf);
                ++k;
                if (!pf) break;
                u = (unsigned)__builtin_amdgcn_readfirstlane((int)MISC[12 + (k & 1)]); pre_valid = true;
                if (tid == 0) DRAW_UNIT(MISC[12 + ((k + 1) & 1)]);
            }
        }
#undef DRAW_UNIT
    }
    TOC(2);
#if PROBE_T == 50
    if (tid == 0) { const unsigned long long d = __builtin_amdgcn_s_memrealtime() - sp_t0; atomicMax((unsigned long long*)(ctl + 8200), d); atomicMax((unsigned long long*)(ctl + 8202), 1000000000ull - d); }
#endif
    SEAM(3);
    TIC(4);
    if (IN(4)) for (int rep = 0; rep < NREP(4); ++rep) {
        pg8::Gemm g{mixed, Wt_out, T, 1024, 1024}; pg8::StaticOrder S; S.init(T, 1024, G, (int)blockIdx.x);
        pg8::EpiOutProj E{xb, v1b, v1q, (rep == NREP(4) - 1) ? stats1 : nullptr, ALPHA, MIXED_F8 ? 1.f / S_OUT : 1.f};
        if constexpr (MIXED_F8) pg8::gemm_phase<pg8::EpiOutProj, pg8::StaticOrder, true, true, true>(lds, g, S, E); else pg8::gemm_phase<pg8::EpiOutProj, pg8::StaticOrder, true, true>(lds, g, S, E);
    }
    TOC(4);
    SEAM(4);
    TIC(5);
    if (IN(5)) for (int rep = 0; rep < NREP(5); ++rep) {
        pg8::Gemm g{(const bf16*)v1q, Wt_gu, T, 2 * FFN, 1024}; pg8::StaticOrder S; S.init(T, 2 * FFN, G, (int)blockIdx.x);
        pg8::EpiGateUp E{actf, actq, stats1, cs, bs, 1.f / S_GU};
        pg8::gemm_phase<pg8::EpiGateUp, pg8::StaticOrder, true, true, true>(lds, g, S, E);
    }
    TOC(5);
#if PROBE_T == 40
    { xcd_barrier(bar); TIC(40);
      pg8::Gemm g{(const bf16*)v1q, Wt_gu, T, 2 * FFN, 1024}; pg8::StaticOrder S; S.init(T, 2 * FFN, G, (int)blockIdx.x);
      pg8::EpiNull E{(float*)(ws + WS_MIXED)};
      pg8::gemm_phase<pg8::EpiNull, pg8::StaticOrder, true, true, true>(lds, g, S, E); TOC(40); }
#endif
    SEAM(5);
    TIC(6);
    if (IN(6)) for (int rep = 0; rep < NREP(6); ++rep) {
        pg8::Gemm g{(const bf16*)actq, Wt_dn, T, 1024, FFN}; pg8::StaticOrder S; S.init(T, 1024, G, (int)blockIdx.x);
#ifdef NO_LN2_FUSE
        pg8::EpiDown E{v1b, v2b, stats1, ln1_g, ln1_b, ALPHA, 1.f / S_DN};
        pg8::gemm_phase<pg8::EpiDown, pg8::StaticOrder, true, true, true>(lds, g, S, E);
#else
        pg8::RowStatsX rx{(unsigned long long*)(ws + WS_XCH), (unsigned*)(ctl + 16384), lds + 135168, LN_EPS};
        pg8::EpiDownLn E{v1b, out, stats1, ln1_g, ln1_b, ln2_g, ln2_b, ALPHA, 1.f / S_DN, rx};
        pg8::gemm_phase<pg8::EpiDownLn, pg8::StaticOrder, true, true, true>(lds, g, S, E);
#endif
    }
    TOC(6);
#ifdef NO_LN2_FUSE
    SEAM(6);
#endif
    TIC(7);
#ifdef NO_LN2_FUSE
    if (IN(7)) for (int rep = 0; rep < NREP(7); ++rep) {
        const int gw = vcu * NWAVES + wave, NGW = G * NWAVES;
        for (int m = gw; m < T; m += NGW) {
            const GAS v4u* xr = (const GAS v4u*)(v2b + (size_t)m * 1024) + lane; GAS f32x4* xw = (GAS f32x4*)(out + (size_t)m * 1024) + 2 * lane; f32x4 v[4]; float s = 0.f;
#pragma unroll
            for (int j = 0; j < 2; ++j) { const v4u t = xr[64 * j];
                v[2 * j] = f32x4{__uint_as_float(t[0] << 16), __uint_as_float(t[0] & 0xffff0000u), __uint_as_float(t[1] << 16), __uint_as_float(t[1] & 0xffff0000u)};
                v[2 * j + 1] = f32x4{__uint_as_float(t[2] << 16), __uint_as_float(t[2] & 0xffff0000u), __uint_as_float(t[3] << 16), __uint_as_float(t[3] & 0xffff0000u)}; }
#pragma unroll
            for (int j = 0; j < 4; ++j) s += (v[j].x + v[j].y) + (v[j].z + v[j].w);
            const float mean = wave_sum(s) * (1.f / 1024.f); float s2 = 0.f;
#pragma unroll
            for (int j = 0; j < 4; ++j) { v[j] = v[j] - mean; s2 += (v[j].x * v[j].x + v[j].y * v[j].y) + (v[j].z * v[j].z + v[j].w * v[j].w); }
            const float rstd = rsqrtf(wave_sum(s2) * (1.f / 1024.f) + LN_EPS);
#pragma unroll
            for (int j = 0; j < 4; ++j) { const int ci = 2 * lane + (j & 1) + 128 * (j >> 1);
                const f32x4 gg = *((const f32x4*)ln2_g + ci), bb = *((const f32x4*)ln2_b + ci); xw[(j & 1) + 128 * (j >> 1)] = v[j] * rstd * gg + bb; }
        }
    }
#endif
    TOC(7);
#if PROBE_T == 50
    if (blockIdx.x == 0 && tid == 0) { const unsigned long long mx = __hip_atomic_load((unsigned long long*)(ctl + 8200), RLX_AGENT), mn = 1000000000ull - __hip_atomic_load((unsigned long long*)(ctl + 8202), RLX_AGENT); t_acc = mx - mn; }
#endif
#if PROBE_T >= 0
    if (blockIdx.x == 0 && tid == 0) { const unsigned long long t0 = __builtin_amdgcn_s_memrealtime(); while (__builtin_amdgcn_s_memrealtime() - t0 < t_acc) __builtin_amdgcn_s_sleep(8); }
#endif
#undef IN
#undef SEAM
}

extern "C" void kernel_launch(void* const* d_in, const int* in_sizes, int n_in, void* d_out, int out_size, void* d_ws, size_t ws_size, hipStream_t stream) {
    static int grid = 0;
    if (grid == 0) {
        if (n_in != 16 || in_sizes[0] != T * D_MODEL || out_size != T * D_MODEL || ws_size < WS_NEED) { fprintf(stderr, "kernel_launch: unexpected shapes / workspace (%d inputs, ws %zu); nothing launched\n", n_in, ws_size); grid = -1; return; }
        int dev = 0, cus = 0, per_cu = 0;
        if (hipGetDevice(&dev) != hipSuccess || hipDeviceGetAttribute(&cus, hipDeviceAttributeMultiprocessorCount, dev) != hipSuccess) { grid = -1; return; }
        if (hipFuncSetAttribute((const void*)mk_fwd, hipFuncAttributeMaxDynamicSharedMemorySize, LDS_BYTES) != hipSuccess) { fprintf(stderr, "kernel_launch: hipFuncSetAttribute failed\n"); grid = -1; return; }
        if (hipOccupancyMaxActiveBlocksPerMultiprocessor(&per_cu, (const void*)mk_fwd, NT, LDS_BYTES) != hipSuccess || per_cu < 1) { fprintf(stderr, "kernel_launch: occupancy query says %d blocks per CU; nothing launched\n", per_cu); (void)hipGetLastError(); grid = -1; return; }
        grid = cus;
    }
    if (grid < 0) return;
    if (hipMemsetAsync((char*)d_ws + WS_CTL, 0, CTL_ZERO_BYTES, stream) != hipSuccess) return;
    Args a{};
    for (int i = 0; i < 16; ++i) a.in[i] = (const float*)d_in[i];
    a.out = (float*)d_out; a.ws = (unsigned char*)d_ws;
#if MK_N_LAUNCHES == 1
    a.ph_lo = 0; a.ph_hi = N_PHASES; a.li = 0;
    hipLaunchKernelGGL(mk_fwd, dim3(grid), dim3(NT), LDS_BYTES, stream, a);
#else
    for (int p = 0; p < N_PHASES; ++p) { a.ph_lo = p; a.ph_hi = p + 1; a.li = 0; hipLaunchKernelGGL(mk_fwd, dim3(grid), dim3(NT), LDS_BYTES, stream, a); }
#endif
}
```

```cpp
#include <hip/hip_runtime.h>
#include <cstdio>
#include <cstdint>
#include <cmath>

#ifndef PROBE_DUP
#define PROBE_DUP -1
#endif
#ifndef PROBE_T
#define PROBE_T -1
#endif
#if PROBE_T >= 0
__device__ unsigned long long t_tic, t_acc;
#define TIC(k) do { if (PROBE_T == (k) && blockIdx.x == 0 && threadIdx.x == 0) { t_tic = __builtin_amdgcn_s_memrealtime(); } } while (0)
#define TOC(k) do { if (PROBE_T == (k) && blockIdx.x == 0 && threadIdx.x == 0) { t_acc += __builtin_amdgcn_s_memrealtime() - t_tic; } } while (0)
#else
#define TIC(k) do { } while (0)
#define TOC(k) do { } while (0)
#endif
#ifndef INPROJ_F8
#define INPROJ_F8 1
#endif
#ifndef MIXED_F8
#define MIXED_F8 1
#endif
#ifndef MK_N_LAUNCHES
#define MK_N_LAUNCHES 1
#endif

constexpr int D_MODEL = 1024, BATCH = 16, SEQ = 2048, T = BATCH * SEQ;
constexpr int IDX_TOPK = 256;
constexpr int CMP_BLOCK = 32, CMP_STRIDE = 16, CMP_HIDDEN = 128, N_C = (SEQ - CMP_BLOCK) / CMP_STRIDE + 1;
constexpr int SLC_BLOCK = 64, SLC_COUNT = 8, N_S = SEQ / SLC_BLOCK, WINDOW = 512;
constexpr int FFN = 2816;
constexpr int IN_COLS = 2240, ACT_COLS = 2304;
constexpr float ALPHA = 1.189207115002721f;
constexpr float LN_EPS = 1e-5f;
constexpr float ATT_SCALE = 0.125f;
constexpr float IDX_SCALE = 0.0625f;
constexpr int C_DQ = 0, C_DK = 512, C_DV = 576, C_IQ = 640, C_NQ = 896, C_KCM = 1408, C_VCM = 1536, C_KSL = 1664, C_VSL = 1792,
              C_KWN = 1920, C_VWN = 2048, C_IK = 2176, C_IW = 2208, C_NG = 2216;
__host__ __device__ __forceinline__ int orig_col(int pc) {
    if (pc < 896) return pc;
    if (pc < 1408) return 936 + (pc - 896);
    if (pc < 2176) return 1448 + (pc - 1408);
    if (pc < 2208) return 904 + (pc - 2176);
    if (pc < 2216) return 896 + (pc - 2208);
    if (pc < IN_COLS) return pc;
    return -1;
}
constexpr size_t MiB = 1u << 20;
constexpr size_t WS_CTL = 0, CTL_ZERO_BYTES = 1 * MiB;
constexpr size_t CTL_STATS1 = 256 * 1024;
constexpr size_t CTL_CS = 512 * 1024;
constexpr size_t CTL_CB1 = 600 * 1024;
constexpr size_t WS_ROPE = 1 * MiB;
constexpr size_t WS_BIASP = 3 * MiB;
constexpr size_t WS_WIN = 4 * MiB;
constexpr size_t WS_WOUT = 9 * MiB;
constexpr size_t WS_WGU = 11 * MiB;
constexpr size_t WS_WDN = 22 * MiB;
constexpr size_t WS_W1T = 28 * MiB;
constexpr size_t WS_W2T = 29 * MiB;
constexpr size_t WS_CB1 = 29 * MiB + 512 * 1024;
constexpr size_t WS_KCB = 30 * MiB;
constexpr size_t WS_WINQ = 37 * MiB;
constexpr size_t WS_XCH = 36 * MiB;
constexpr size_t WS_KC = 32 * MiB;
constexpr size_t WS_ACT = 48 * MiB;
constexpr size_t WS_ACTF = 48 * MiB;
constexpr size_t WS_XB = 192 * MiB;
constexpr size_t WS_MIXED = 256 * MiB;
constexpr size_t WS_V1B = 320 * MiB;
constexpr size_t WS_GCAND = 384 * MiB;
constexpr size_t WS_NEED = 512 * MiB;

namespace pg8 {
#define PG8_LAS __attribute__((address_space(3)))
typedef unsigned short bf16_t;
typedef short bf16x8 __attribute__((ext_vector_type(8)));
typedef float f32x4 __attribute__((ext_vector_type(4)));
typedef unsigned u32x4 __attribute__((ext_vector_type(4)));
constexpr int BM = 256, BK = 64, HALF = 128, HTB = HALF * BK * 2  , STAGE_BYTES = 8 * HTB, NXCD = 8, WGM = 8;

__host__ __device__ __forceinline__ int lds_byte(int r, int c) { const int st = (r >> 4) * 2 + (c >> 5), rr = r & 15, cc = c & 31, ob = rr * 64 + cc * 2; return st * 1024 + (ob ^ (((ob >> 9) & 1) << 5)); }
__host__ __device__ __forceinline__ void stage_rc(int b, int& R, int& C) { const int st = b / 1024, sb = b % 1024, swz = sb ^ (((sb >> 9) & 1) << 5); R = (st >> 1) * 16 + swz / 64; C = (st & 1) * 32 + (swz % 64) / 2; }
__host__ __device__ __forceinline__ int perm32(int rho) { const int n = rho >> 4, i = rho & 15; return 8 * (i >> 2) + 4 * n + (i & 3); }

struct Unit { int pm, pn; };
struct Gemm { const bf16_t* A; const bf16_t* Bt; int M, N, K; };

struct StaticOrder {
    int nM, nN, nwg, G, c;
    __host__ __device__ void init(int M, int N, int G_, int c_) { nM = M / BM; nN = N / BM; nwg = nM * nN; G = G_; c = c_; }
    __host__ __device__ bool next(int i, Unit& u) const {
        const long L = (long)i * G + c; if (L >= nwg) return false;
        int wgid = (int)L; { const int q = nwg / NXCD, r = nwg % NXCD, xcd = wgid % NXCD, off = wgid / NXCD; wgid = (xcd < r ? xcd * (q + 1) : r * (q + 1) + (xcd - r) * q) + off; }
        const int nig = WGM * nN, gid = wgid / nig, fm = gid * WGM, gsz = (nM - fm) < WGM ? (nM - fm) : WGM;
        u.pm = fm + ((wgid % nig) % gsz); u.pn = (wgid % nig) / gsz; return true;
    }
    __device__ __forceinline__ void a_ready(const Unit&) const {}
    __device__ __forceinline__ void done(const Unit&) const {}
};
__device__ __forceinline__ unsigned cvt_pk_bf16(float lo, float hi) { unsigned r; asm volatile("v_cvt_pk_bf16_f32 %0, %1, %2" : "=v"(r) : "v"(lo), "v"(hi)); return r; }
typedef float f32x2 __attribute__((ext_vector_type(2)));
__device__ __forceinline__ f32x4 shflx16(f32x4 v) { f32x4 r; r[0] = __shfl_xor(v[0], 16); r[1] = __shfl_xor(v[1], 16); r[2] = __shfl_xor(v[2], 16); r[3] = __shfl_xor(v[3], 16); return r; }
typedef unsigned u32x2 __attribute__((ext_vector_type(2)));
__device__ __forceinline__ u32x2 pack8_f8(f32x4 a, f32x4 b) {
    int p0 = __builtin_amdgcn_cvt_pk_fp8_f32(a[0], a[1], 0, false); p0 = __builtin_amdgcn_cvt_pk_fp8_f32(a[2], a[3], p0, true);
    int p1 = __builtin_amdgcn_cvt_pk_fp8_f32(b[0], b[1], 0, false); p1 = __builtin_amdgcn_cvt_pk_fp8_f32(b[2], b[3], p1, true);
    return u32x2{(unsigned)p0, (unsigned)p1}; }
__device__ __forceinline__ u32x4 pack8(f32x4 a, f32x4 b) { u32x4 w; w.x = cvt_pk_bf16(a[0], a[1]); w.y = cvt_pk_bf16(a[2], a[3]); w.z = cvt_pk_bf16(b[0], b[1]); w.w = cvt_pk_bf16(b[2], b[3]); return w; }
struct EpiNull {
    static constexpr bool PERM = true, AFTER_DRAIN = false;
    float* o;
    __device__ __forceinline__ void operator()(const f32x4 (&acc)[2][2][4][2], const Unit& u, int wr, int wc, int fr, int fq) const {
        f32x4 s = acc[0][0][0][0];
#pragma unroll
        for (int ai = 0; ai < 2; ++ai)
#pragma unroll
            for (int bj = 0; bj < 2; ++bj)
#pragma unroll
                for (int m = 0; m < 4; ++m)
#pragma unroll
                    for (int n = 0; n < 2; ++n) s += acc[ai][bj][m][n];
        *(f32x4*)(o + ((size_t)(u.pm * 8 + u.pn % 8) * 512 + threadIdx.x) * 4) = s;
    }
};
struct SubOrderB {
    StaticOrder s;
    __device__ void init(int M, int G_, int c_) { s.init(M, 5 * BM, G_, c_); }
    __device__ bool next(int i, Unit& u) const { if (!s.next(i, u)) return false; u.pn = u.pn < 4 ? u.pn + 2 : 8; return true; }
    __device__ __forceinline__ void a_ready(const Unit&) const {}
    __device__ __forceinline__ void done(const Unit&) const {}
};
struct SubOrderQ {
    int G, c;
    __device__ bool next(int i, Unit& u) const { long L;
        if (G == 256) { if (c < 128) { if (i >= 1) return false; L = c; } else { if (i >= 3) return false; L = 128 + (c - 128) * 3 + i; } }
        else { L = (long)i * G + c; if (L >= 512) return false; }
        const int idx = (int)(L & 3); u.pm = (int)(L >> 2); u.pn = idx < 2 ? idx : idx + 4; return true; }
    __device__ __forceinline__ void a_ready(const Unit&) const {}
    __device__ __forceinline__ void done(const Unit&) const {}
};
struct EpiInProj {
    static constexpr bool PERM = true, AFTER_DRAIN = false;
    bf16_t* act; const float* biasP; const float* rope; float qscale, inv_s;
    __device__ __forceinline__ void operator()(const f32x4 (&acc)[2][2][4][2], const Unit& u, int wr, int wc, int fr, int fq) const {
        const int row0 = u.pm * BM + wr * 64 + fr; const bool lo = (wc & 1) == 0;
#pragma unroll
        for (int bj = 0; bj < 2; ++bj) {
            const int cgb = u.pn * BM + bj * HALF + wc * 32, H = cgb >> 6, col0 = cgb + 8 * fq;
            const f32x4 b0 = *(const f32x4*)(biasP + col0), b1 = *(const f32x4*)(biasP + col0 + 4);
            const bool k64 = lo && ((0xCCFFC1FFull >> H) & 1ull), k32 = (H >= 10 && H <= 13) || (H == 34 && lo), ksig = (H == 34 && !lo);
            const float qs = (H < 8 || (H >= 14 && H < 22)) ? qscale : 1.f;
#pragma unroll
            for (int ai = 0; ai < 2; ++ai)
#pragma unroll
                for (int m = 0; m < 4; ++m) {
                    const int row = row0 + ai * HALF + m * 16;
                    f32x4 v0 = acc[ai][bj][m][0] * inv_s + b0, v1 = acc[ai][bj][m][1] * inv_s + b1;
                    if (k64) {
                        const f32x4 p0 = shflx16(v0), p1 = shflx16(v1);
                        if (fq < 2) {
                            const f32x4* rp = (const f32x4*)(rope + (size_t)row * 16); const f32x4 t0 = rp[0], t1 = rp[1], t2 = rp[2], t3 = rp[3];
                            const float sg = fq == 0 ? -1.f : 1.f;
                            v0[0] = v0[0] * t0[0] + sg * p0[0] * t0[1]; v0[1] = v0[1] * t0[2] + sg * p0[1] * t0[3];
                            v0[2] = v0[2] * t1[0] + sg * p0[2] * t1[1]; v0[3] = v0[3] * t1[2] + sg * p0[3] * t1[3];
                            v1[0] = v1[0] * t2[0] + sg * p1[0] * t2[1]; v1[1] = v1[1] * t2[2] + sg * p1[1] * t2[3];
                            v1[2] = v1[2] * t3[0] + sg * p1[2] * t3[1]; v1[3] = v1[3] * t3[2] + sg * p1[3] * t3[3];
                        }
                    } else if (k32) {
                        if (fq == 0) {
                            const f32x4* rp = (const f32x4*)(rope + (size_t)row * 16); const f32x4 t0 = rp[0], t1 = rp[1], t2 = rp[2], t3 = rp[3];
                            const f32x4 x1 = v0, x2 = v1;
                            v0[0] = x1[0] * t0[0] - x2[0] * t0[1]; v1[0] = x2[0] * t0[0] + x1[0] * t0[1];
                            v0[1] = x1[1] * t1[0] - x2[1] * t1[1]; v1[1] = x2[1] * t1[0] + x1[1] * t1[1];
                            v0[2] = x1[2] * t2[0] - x2[2] * t2[1]; v1[2] = x2[2] * t2[0] + x1[2] * t2[1];
                            v0[3] = x1[3] * t3[0] - x2[3] * t3[1]; v1[3] = x2[3] * t3[0] + x1[3] * t3[1];
                        }
                    } else if (ksig) {
                        if (fq >= 1) {
#pragma unroll
                            for (int e = 0; e < 4; ++e) { v0[e] = 1.f / (1.f + __expf(-v0[e])); v1[e] = 1.f / (1.f + __expf(-v1[e])); }
                        }
                    }
                    *(u32x4*)(act + (size_t)row * 2304 + col0) = pack8(v0 * qs, v1 * qs);
                }
        }
    }
};
struct EpiOutProj {
    static constexpr bool PERM = true, AFTER_DRAIN = false;
    const bf16_t* xb; bf16_t* v1b; unsigned char* v1q; float* stats; float alpha, inv_s;
    __device__ __forceinline__ void operator()(const f32x4 (&acc)[2][2][4][2], const Unit& u, int wr, int wc, int fr, int fq) const {
        const int row0 = u.pm * BM + wr * 64 + fr;
#pragma unroll
        for (int ai = 0; ai < 2; ++ai)
#pragma unroll
            for (int m = 0; m < 4; ++m) {
                const int row = row0 + ai * HALF + m * 16; float s = 0.f, q = 0.f;
#pragma unroll
                for (int bj = 0; bj < 2; ++bj) {
                    const size_t off = (size_t)row * 1024 + u.pn * BM + bj * HALF + wc * 32 + 8 * fq;
                    const u32x4 xv = *(const u32x4*)(xb + off);
                    const f32x4 xa = {__uint_as_float(xv[0] << 16), __uint_as_float(xv[0] & 0xffff0000u), __uint_as_float(xv[1] << 16), __uint_as_float(xv[1] & 0xffff0000u)};
                    const f32x4 xc = {__uint_as_float(xv[2] << 16), __uint_as_float(xv[2] & 0xffff0000u), __uint_as_float(xv[3] << 16), __uint_as_float(xv[3] & 0xffff0000u)};
                    const f32x4 a = xa * alpha + acc[ai][bj][m][0] * inv_s, b = xc * alpha + acc[ai][bj][m][1] * inv_s;
                    *(u32x4*)(v1b + off) = pack8(a, b); if (v1q) *(u32x2*)(v1q + off) = pack8_f8(a, b);
                    s += ((a[0] + a[1]) + (a[2] + a[3])) + ((b[0] + b[1]) + (b[2] + b[3]));
                    q += ((a[0] * a[0] + a[1] * a[1]) + (a[2] * a[2] + a[3] * a[3])) + ((b[0] * b[0] + b[1] * b[1]) + (b[2] * b[2] + b[3] * b[3]));
                }
                s += __shfl_xor(s, 16); s += __shfl_xor(s, 32); q += __shfl_xor(q, 16); q += __shfl_xor(q, 32);
                if (fq == 0 && stats) { atomicAdd(stats + 2 * row, s); atomicAdd(stats + 2 * row + 1, q); }
            }
    }
};
struct EpiGateUp {
    static constexpr bool PERM = true, AFTER_DRAIN = false;
    bf16_t* actf; unsigned char* actq; const float* stats; const float* cs; const float* bs; float inv_s;
    __device__ __forceinline__ void operator()(const f32x4 (&acc)[2][2][4][2], const Unit& u, int wr, int wc, int fr, int fq) const {
        const int row0 = u.pm * BM + wr * 64 + fr; const int ng = u.pn * BM + wc * 32 + 8 * fq, nu = ng + HALF, jc = u.pn * HALF + wc * 32 + 8 * fq;
        f32x4 csg[2], bsg[2], csu[2], bsu[2];
#pragma unroll
        for (int n = 0; n < 2; ++n) { csg[n] = *(const f32x4*)(cs + ng + 4 * n); bsg[n] = *(const f32x4*)(bs + ng + 4 * n); csu[n] = *(const f32x4*)(cs + nu + 4 * n); bsu[n] = *(const f32x4*)(bs + nu + 4 * n); }
#pragma unroll
        for (int ai = 0; ai < 2; ++ai)
#pragma unroll
            for (int m = 0; m < 4; ++m) {
                const int row = row0 + ai * HALF + m * 16;
                typedef float f2_t __attribute__((ext_vector_type(2)));
                const f2_t st = *(const f2_t*)(stats + 2 * row);
                const float mean = st[0] * (1.f / 1024.f), var = st[1] * (1.f / 1024.f) - mean * mean, rstd = __builtin_amdgcn_rsqf(fmaxf(var, 0.f) + 1e-5f);
                const float a1 = inv_s * rstd, a0 = -mean * rstd;
                f32x4 o[2];
#pragma unroll
                for (int n = 0; n < 2; ++n) {
                    const f32x4 g = acc[ai][0][m][n] * a1 + (csg[n] * a0 + bsg[n]), up = acc[ai][1][m][n] * a1 + (csu[n] * a0 + bsu[n]);
#pragma unroll
                    for (int e = 0; e < 4; ++e) o[n][e] = g[e] * __builtin_amdgcn_rcpf(1.f + __builtin_amdgcn_exp2f(g[e] * -1.4426950408889634f)) * up[e];
                }
                if (actq) *(u32x2*)(actq + (size_t)row * 2816 + jc) = pack8_f8(o[0], o[1]); else *(u32x4*)(actf + (size_t)row * 2816 + jc) = pack8(o[0], o[1]);
            }
    }
};
struct RowStatsX {
    unsigned long long* xbuf;
    unsigned* cnt;
    PG8_LAS unsigned char* tab;
    float eps;
    __device__ __forceinline__ void run(const f32x4 (&v)[2][2][4][2], const Unit& u, int wr, int wc, int fr, int fq, int wid, int lane) const {
        typedef float f32x2v __attribute__((ext_vector_type(2)));
        PG8_LAS f32x2v* P = (PG8_LAS f32x2v*)tab; PG8_LAS f32x2v* S = (PG8_LAS f32x2v*)(tab + 8192);
#pragma unroll
        for (int ai = 0; ai < 2; ++ai)
#pragma unroll
            for (int m = 0; m < 4; ++m) {
                float s = 0.f;
#pragma unroll
                for (int bj = 0; bj < 2; ++bj)
#pragma unroll
                    for (int n = 0; n < 2; ++n) { const f32x4 x = v[ai][bj][m][n]; s += (x[0] + x[1]) + (x[2] + x[3]); }
                s += __shfl_xor(s, 16); s += __shfl_xor(s, 32);
                const float mw = s * (1.0f / 64.0f); float q = 0.f;
#pragma unroll
                for (int bj = 0; bj < 2; ++bj)
#pragma unroll
                    for (int n = 0; n < 2; ++n) { const f32x4 d = v[ai][bj][m][n] - mw; q += (d[0] * d[0] + d[1] * d[1]) + (d[2] * d[2] + d[3] * d[3]); }
                q += __shfl_xor(q, 16); q += __shfl_xor(q, 32);
                if (fq == 0) P[(ai * HALF + wr * 64 + m * 16 + fr) * 4 + wc] = (f32x2v){mw, q};
            }
        asm volatile("s_waitcnt lgkmcnt(0)" ::: "memory"); __builtin_amdgcn_s_barrier(); asm volatile("" ::: "memory");
        const int row = wid * 32 + (lane & 31);
        if (lane < 32) {
            const f32x2v a = P[row * 4 + 0], b = P[row * 4 + 1], c = P[row * 4 + 2], d = P[row * 4 + 3];
            const float mt = (a.x + b.x + c.x + d.x) * 0.25f;
            const float da = a.x - mt, db = b.x - mt, dc = c.x - mt, dd = d.x - mt;
            const float m2 = (a.y + b.y) + (c.y + d.y) + 64.0f * ((da * da + db * db) + (dc * dc + dd * dd));
            __hip_atomic_store(xbuf + ((size_t)(u.pm * BM + row) * 4 + u.pn), ((unsigned long long)__float_as_uint(m2) << 32) | __float_as_uint(mt), __ATOMIC_RELAXED, __HIP_MEMORY_SCOPE_AGENT);
        }
        asm volatile("s_waitcnt vmcnt(0)" ::: "memory");
        if (lane == 0) __hip_atomic_fetch_add(cnt + 64 * u.pm, 1u, __ATOMIC_RELAXED, __HIP_MEMORY_SCOPE_AGENT);
        if (wid == 0) {
            unsigned sp = 0;
            while ((unsigned)__builtin_amdgcn_readfirstlane((int)__hip_atomic_load(cnt + 64 * u.pm, __ATOMIC_RELAXED, __HIP_MEMORY_SCOPE_AGENT)) < 32u) { __builtin_amdgcn_s_sleep(2); if (++sp > (1u << 22)) break; }
            __builtin_amdgcn_fence(__ATOMIC_ACQUIRE, "agent");
        }
        asm volatile("s_waitcnt vmcnt(0) lgkmcnt(0)" ::: "memory"); __builtin_amdgcn_s_barrier(); asm volatile("" ::: "memory");
        if (lane < 32) {
            const unsigned long long* slot = xbuf + (size_t)(u.pm * BM + row) * 4; float mt[4], m2[4]; float ms = 0.f;
#pragma unroll
            for (int t = 0; t < 4; ++t) { const unsigned long long w = __hip_atomic_load(slot + t, __ATOMIC_RELAXED, __HIP_MEMORY_SCOPE_AGENT); mt[t] = __uint_as_float((unsigned)w); m2[t] = __uint_as_float((unsigned)(w >> 32)); ms += mt[t]; }
            const float mean = ms * 0.25f; float q = 0.f;
#pragma unroll
            for (int t = 0; t < 4; ++t) { const float dm = mt[t] - mean; q += m2[t] + 256.0f * dm * dm; }
            S[row] = (f32x2v){mean, __builtin_amdgcn_rsqf(q * (1.0f / 1024.0f) + eps)};
        }
        asm volatile("s_waitcnt lgkmcnt(0)" ::: "memory"); __builtin_amdgcn_s_barrier(); asm volatile("" ::: "memory");
    }
};
struct EpiDownLn {
    static constexpr bool PERM = true, AFTER_DRAIN = false;
    const bf16_t* v1b; float* out; const float* stats; const float* g1; const float* b1; const float* g2; const float* b2; float alpha, inv_s; RowStatsX rx;
    __device__ __forceinline__ void operator()(const f32x4 (&acc_)[2][2][4][2], const Unit& u, int wr, int wc, int fr, int fq) const {
        typedef float f32x2v __attribute__((ext_vector_type(2)));
        f32x4 (&acc)[2][2][4][2] = const_cast<f32x4 (&)[2][2][4][2]>(acc_);
        const int row0 = u.pm * BM + wr * 64 + fr; const int wid = wr * 4 + wc, lane = fq * 16 + fr;
#pragma unroll
        for (int bj = 0; bj < 2; ++bj) {
            const int col0 = u.pn * BM + bj * HALF + wc * 32 + 8 * fq;
            const f32x4 ga = *(const f32x4*)(g1 + col0), gb = *(const f32x4*)(g1 + col0 + 4), ba = *(const f32x4*)(b1 + col0), bb = *(const f32x4*)(b1 + col0 + 4);
#pragma unroll
            for (int ai = 0; ai < 2; ++ai)
#pragma unroll
                for (int m = 0; m < 4; ++m) {
                    const int row = row0 + ai * HALF + m * 16;
                    const f32x2v st = *(const f32x2v*)(stats + 2 * row);
                    const float mean = st[0] * (1.f / 1024.f), var = st[1] * (1.f / 1024.f) - mean * mean, rstd = __builtin_amdgcn_rsqf(fmaxf(var, 0.f) + 1e-5f);
                    const u32x4 vv = *(const u32x4*)(v1b + (size_t)row * 1024 + col0);
                    const f32x4 va = {__uint_as_float(vv[0] << 16), __uint_as_float(vv[0] & 0xffff0000u), __uint_as_float(vv[1] << 16), __uint_as_float(vv[1] & 0xffff0000u)};
                    const f32x4 vb = {__uint_as_float(vv[2] << 16), __uint_as_float(vv[2] & 0xffff0000u), __uint_as_float(vv[3] << 16), __uint_as_float(vv[3] & 0xffff0000u)};
                    acc[ai][bj][m][0] = ((va - mean) * rstd * ga + ba) * alpha + acc[ai][bj][m][0] * inv_s;
                    acc[ai][bj][m][1] = ((vb - mean) * rstd * gb + bb) * alpha + acc[ai][bj][m][1] * inv_s;
                    asm volatile("" : "+v"(acc[ai][bj][m][0]), "+v"(acc[ai][bj][m][1]));
                    if (m & 1) asm volatile("" ::: "memory");
                }
        }
        rx.run(acc, u, wr, wc, fr, fq, wid, lane);
        const PG8_LAS f32x2v* S = (const PG8_LAS f32x2v*)(rx.tab + 8192);
#pragma unroll
        for (int bj = 0; bj < 2; ++bj) {
            const int col0 = u.pn * BM + bj * HALF + wc * 32 + 8 * fq;
            const f32x4 ga = *(const f32x4*)(g2 + col0), gb = *(const f32x4*)(g2 + col0 + 4), ba = *(const f32x4*)(b2 + col0), bb = *(const f32x4*)(b2 + col0 + 4);
#pragma unroll
            for (int ai = 0; ai < 2; ++ai)
#pragma unroll
                for (int m = 0; m < 4; ++m) {
                    const int r = ai * HALF + wr * 64 + m * 16 + fr; const f32x2v sr = S[r]; float* po = out + (size_t)(u.pm * BM + r) * 1024 + col0;
                    *(f32x4*)po = (acc[ai][bj][m][0] - sr.x) * sr.y * ga + ba; *(f32x4*)(po + 4) = (acc[ai][bj][m][1] - sr.x) * sr.y * gb + bb;
                    if (m & 1) asm volatile("" ::: "memory");
                }
        }
        asm volatile("s_waitcnt lgkmcnt(0)" ::: "memory"); __builtin_amdgcn_s_barrier(); asm volatile("" ::: "memory");
    }
};
struct EpiDown {
    static constexpr bool PERM = true, AFTER_DRAIN = false;
    const bf16_t* v1b; bf16_t* v2b; const float* stats; const float* g1; const float* b1; float alpha, inv_s;
    __device__ __forceinline__ void operator()(const f32x4 (&acc)[2][2][4][2], const Unit& u, int wr, int wc, int fr, int fq) const {
        const int row0 = u.pm * BM + wr * 64 + fr;
#pragma unroll
        for (int bj = 0; bj < 2; ++bj) {
            const int col0 = u.pn * BM + bj * HALF + wc * 32 + 8 * fq;
            const f32x4 ga = *(const f32x4*)(g1 + col0), gb = *(const f32x4*)(g1 + col0 + 4), ba = *(const f32x4*)(b1 + col0), bb = *(const f32x4*)(b1 + col0 + 4);
#pragma unroll
            for (int ai = 0; ai < 2; ++ai)
#pragma unroll
                for (int m = 0; m < 4; ++m) {
                    const int row = row0 + ai * HALF + m * 16;
                    const float sm = stats[2 * row], sq = stats[2 * row + 1];
                    const float mean = sm * (1.f / 1024.f), var = sq * (1.f / 1024.f) - mean * mean, rstd = rsqrtf(fmaxf(var, 0.f) + 1e-5f);
                    const u32x4 vv = *(const u32x4*)(v1b + (size_t)row * 1024 + col0);
                    const f32x4 va = {__uint_as_float(vv[0] << 16), __uint_as_float(vv[0] & 0xffff0000u), __uint_as_float(vv[1] << 16), __uint_as_float(vv[1] & 0xffff0000u)};
                    const f32x4 vb = {__uint_as_float(vv[2] << 16), __uint_as_float(vv[2] & 0xffff0000u), __uint_as_float(vv[3] << 16), __uint_as_float(vv[3] & 0xffff0000u)};
                    const f32x4 ha = (va - mean) * rstd * ga + ba, hb = (vb - mean) * rstd * gb + bb;
                    *(u32x4*)(v2b + (size_t)row * 1024 + col0) = pack8(ha * alpha + acc[ai][bj][m][0] * inv_s, hb * alpha + acc[ai][bj][m][1] * inv_s);
                }
        }
    }
};

typedef int i32x8 __attribute__((ext_vector_type(8))); typedef int i32x4 __attribute__((ext_vector_type(4)));
__device__ __forceinline__ i32x8 cat8(bf16x8 a, bf16x8 b) { return __builtin_shufflevector(__builtin_bit_cast(i32x4, a), __builtin_bit_cast(i32x4, b), 0, 1, 2, 3, 4, 5, 6, 7); }
template <class Epi, class Sched, bool ALIGN_EPI = false, bool SP2 = false, bool F8 = false>
__device__ __forceinline__ void gemm_phase(PG8_LAS unsigned char* lds, const Gemm g, const Sched& S, const Epi& E) {
    int tid_ = threadIdx.x; asm volatile("" : "+v"(tid_));
    const int tid = tid_, wid = __builtin_amdgcn_readfirstlane(tid >> 6), lane = tid & 63, wr = wid >> 2, wc = wid & 3, fr = lane & 15, fq = lane >> 4;
    const int RB = F8 ? g.K : 2 * g.K  , nt = RB / 128;
    int sc7f = 0x7F7F7F7F; asm volatile("" : "+v"(sc7f));
    unsigned voffA[2], voffB[2];
#pragma unroll
    for (int i = 0; i < 2; ++i) { int R, C; stage_rc(tid * 16 + i * 8192, R, C); const int Rb = Epi::PERM ? ((R & ~31) + perm32(R & 31)) : R;
        voffA[i] = (unsigned)(R * RB + C * 2); voffB[i] = (unsigned)(Rb * RB + C * 2); }
    const size_t kstep = (size_t)(BK * 2);
    const size_t hstep = (size_t)HALF * RB;
    const size_t tstep = 2 * hstep;
    const unsigned ldsw = (unsigned)wid * 1024u;
    const int aoff = lds_byte(wr * 64 + fr, fq * 8), boff = lds_byte(wc * 32 + fr, fq * 8);
#define PG8_SA(b, h) (((b) * 2 + (h)) * HTB)
#define PG8_SB(b, h) ((4 + (b) * 2 + (h)) * HTB)
#define PG8_STAGE(bufoff, gbase, voff) do { _Pragma("unroll") for (int _i = 0; _i < 2; ++_i) \
        __builtin_amdgcn_global_load_lds((const unsigned*)((const char*)(gbase) + (voff)[_i]), (PG8_LAS unsigned*)(lds + (bufoff) + ldsw + _i * 8192), 16, 0, 0); } while (0)
#define PG8_LDA(dst, b, h) do { _Pragma("unroll") for (int m = 0; m < 4; ++m) _Pragma("unroll") for (int k = 0; k < 2; ++k) dst[m][k] = *(const PG8_LAS bf16x8*)(lds + PG8_SA(b, h) + aoff + m * 2048 + k * 1024); } while (0)
#define PG8_LDB(dst, b, h) do { _Pragma("unroll") for (int n = 0; n < 2; ++n) _Pragma("unroll") for (int k = 0; k < 2; ++k) dst[n][k] = *(const PG8_LAS bf16x8*)(lds + PG8_SB(b, h) + boff + n * 2048 + k * 1024); } while (0)
#define PG8_MMA(ai, bj, At, Bt) do { if constexpr (F8) __builtin_amdgcn_sched_barrier(0); __builtin_amdgcn_s_setprio(1); \
        if constexpr (F8) { _Pragma("unroll") for (int m = 0; m < 4; ++m) _Pragma("unroll") for (int n = 0; n < 2; ++n) \
            asm volatile("v_mfma_scale_f32_16x16x128_f8f6f4 %0, %1, %2, %0, %3, %3 op_sel_hi:[0,0,0]" : "+v"(acc[ai][bj][m][n]) : "v"(cat8(Bt[n][0], Bt[n][1])), "v"(cat8(At[m][0], At[m][1])), "v"(sc7f)); } \
        else { _Pragma("unroll") for (int m = 0; m < 4; ++m) _Pragma("unroll") for (int n = 0; n < 2; ++n) _Pragma("unroll") for (int k = 0; k < 2; ++k) \
            acc[ai][bj][m][n] = __builtin_amdgcn_mfma_f32_16x16x32_bf16(Bt[n][k], At[m][k], acc[ai][bj][m][n], 0, 0, 0); } \
        __builtin_amdgcn_s_setprio(0); if constexpr (F8) __builtin_amdgcn_sched_barrier(0); } while (0)
#define PG8_WAIT_V(n) asm volatile("s_waitcnt vmcnt(" #n ")" ::: "memory")
#define PG8_WAIT_L(n) asm volatile("s_waitcnt lgkmcnt(" #n ")" ::: "memory")
#define PG8_BAR __builtin_amdgcn_s_barrier()
#define PG8_SCHED __builtin_amdgcn_sched_barrier(0)
    Unit cur, nxt; int ui = 0;
    if (!S.next(0, cur)) return;
    f32x4 acc[2][2][4][2];
#pragma unroll
    for (int a = 0; a < 2; ++a)
#pragma unroll
        for (int b = 0; b < 2; ++b)
#pragma unroll
            for (int m = 0; m < 4; ++m)
#pragma unroll
                for (int n = 0; n < 2; ++n) acc[a][b][m][n] = (f32x4){0.f, 0.f, 0.f, 0.f};
    bf16x8 At[4][2], B0[2][2], B1[2][2];
    const char* cA = (const char*)g.A + (size_t)cur.pm * tstep; const char* cB = (const char*)g.Bt + (size_t)cur.pn * tstep;
    S.a_ready(cur);
    if constexpr (SP2) {
        PG8_STAGE(PG8_SB(0, 0), cB, voffB); PG8_STAGE(PG8_SB(0, 1), cB + hstep, voffB); PG8_STAGE(PG8_SA(0, 0), cA, voffA); PG8_STAGE(PG8_SA(0, 1), cA + hstep, voffA);
        if (wr == 1) PG8_BAR;
        PG8_WAIT_V(2); PG8_BAR;
        PG8_STAGE(PG8_SB(1, 0), cB + kstep, voffB); PG8_STAGE(PG8_SA(1, 0), cA + kstep, voffA); PG8_STAGE(PG8_SB(1, 1), cB + hstep + kstep, voffB);
        PG8_WAIT_V(6); PG8_BAR;
    } else {
        PG8_STAGE(PG8_SB(0, 0), cB, voffB); PG8_STAGE(PG8_SA(0, 0), cA, voffA); PG8_STAGE(PG8_SB(0, 1), cB + hstep, voffB); PG8_STAGE(PG8_SA(0, 1), cA + hstep, voffA);
        if (wr == 1) PG8_BAR;
        PG8_WAIT_V(4); PG8_BAR;
        PG8_STAGE(PG8_SB(1, 0), cB + kstep, voffB); PG8_STAGE(PG8_SA(1, 0), cA + kstep, voffA); PG8_STAGE(PG8_SB(1, 1), cB + hstep + kstep, voffB);
        PG8_WAIT_V(6); PG8_BAR;
    }
    for (;;) {
        const bool has_next = S.next(ui + 1, nxt);
        const char* nA = has_next ? (const char*)g.A + (size_t)nxt.pm * tstep : cA; const char* nB = has_next ? (const char*)g.Bt + (size_t)nxt.pn * tstep : cB;
        for (int t = 0; t < nt; t += 2) {
            const bool last = (t == nt - 2);
            const char* a1 = cA + (size_t)(t + 1) * kstep;
            const char* a2 = last ? nA : cA + (size_t)(t + 2) * kstep; const char* b2 = last ? nB : cB + (size_t)(t + 2) * kstep;
            const char* a3 = a2 + kstep; const char* b3 = b2 + kstep;
            if (last && has_next) S.a_ready(nxt);
            if constexpr (SP2) {
            PG8_LDB(B0, 0, 0); PG8_LDB(B1, 0, 1); PG8_SCHED; PG8_LDA(At, 0, 0); PG8_STAGE(PG8_SA(1, 1), a1 + hstep, voffA);
            PG8_WAIT_V(8); PG8_WAIT_L(0); PG8_BAR; PG8_MMA(0, 0, At, B0); PG8_MMA(0, 1, At, B1); PG8_BAR; PG8_SCHED;
            PG8_LDA(At, 0, 1); PG8_STAGE(PG8_SB(0, 0), b2, voffB); PG8_STAGE(PG8_SB(0, 1), b2 + hstep, voffB); PG8_STAGE(PG8_SA(0, 0), a2, voffA);
            PG8_WAIT_V(8); PG8_WAIT_L(0); PG8_BAR; PG8_MMA(1, 0, At, B0); PG8_MMA(1, 1, At, B1); PG8_BAR; PG8_SCHED;
            PG8_LDB(B0, 1, 0); PG8_LDB(B1, 1, 1); PG8_SCHED; PG8_LDA(At, 1, 0); PG8_STAGE(PG8_SA(0, 1), a2 + hstep, voffA);
            PG8_WAIT_V(8); PG8_WAIT_L(0); PG8_BAR; PG8_MMA(0, 0, At, B0); PG8_MMA(0, 1, At, B1); PG8_BAR; PG8_SCHED;
            PG8_LDA(At, 1, 1); PG8_STAGE(PG8_SB(1, 0), b3, voffB); PG8_STAGE(PG8_SB(1, 1), b3 + hstep, voffB); PG8_STAGE(PG8_SA(1, 0), a3, voffA);
            PG8_WAIT_V(8); PG8_WAIT_L(0); PG8_BAR; PG8_MMA(1, 0, At, B0); PG8_MMA(1, 1, At, B1); PG8_BAR; PG8_SCHED;
            } else {
            PG8_LDB(B0, 0, 0); PG8_SCHED; PG8_LDA(At, 0, 0); PG8_STAGE(PG8_SA(1, 1), a1 + hstep, voffA);
            PG8_WAIT_L(8); PG8_BAR; PG8_WAIT_L(0); PG8_MMA(0, 0, At, B0); PG8_BAR; PG8_SCHED;
            PG8_LDB(B1, 0, 1); PG8_STAGE(PG8_SB(0, 0), b2, voffB);
            PG8_BAR; PG8_WAIT_L(0); PG8_MMA(0, 1, At, B1); PG8_BAR;
            PG8_LDA(At, 0, 1); PG8_STAGE(PG8_SA(0, 0), a2, voffA);
            PG8_BAR; PG8_WAIT_L(0); PG8_MMA(1, 0, At, B0); PG8_BAR; PG8_SCHED;
            PG8_STAGE(PG8_SB(0, 1), b2 + hstep, voffB);
            PG8_WAIT_V(6); PG8_BAR; PG8_MMA(1, 1, At, B1); PG8_BAR;
            PG8_LDB(B0, 1, 0); PG8_SCHED; PG8_LDA(At, 1, 0); PG8_STAGE(PG8_SA(0, 1), a2 + hstep, voffA);
            PG8_WAIT_L(8); PG8_BAR; PG8_WAIT_L(0); PG8_MMA(0, 0, At, B0); PG8_BAR; PG8_SCHED;
            PG8_LDB(B1, 1, 1); PG8_STAGE(PG8_SB(1, 0), b3, voffB);
            PG8_BAR; PG8_WAIT_L(0); PG8_MMA(0, 1, At, B1); PG8_BAR;
            PG8_LDA(At, 1, 1); PG8_STAGE(PG8_SA(1, 0), a3, voffA);
            PG8_BAR; PG8_WAIT_L(0); PG8_MMA(1, 0, At, B0); PG8_BAR; PG8_SCHED;
            PG8_STAGE(PG8_SB(1, 1), b3 + hstep, voffB);
            PG8_WAIT_V(6); PG8_BAR; PG8_MMA(1, 1, At, B1); PG8_BAR;
            }
        }
        if constexpr (ALIGN_EPI) { if (wr == 0) PG8_BAR; }
        if constexpr (F8) asm volatile("s_nop 15\n\ts_nop 7" ::: "memory");
        if constexpr (!Epi::AFTER_DRAIN) { E(acc, cur, wr, wc, fr, fq); S.done(cur); }
        if (!has_next) break;
#pragma unroll
        for (int a = 0; a < 2; ++a)
#pragma unroll
            for (int b = 0; b < 2; ++b)
#pragma unroll
                for (int m = 0; m < 4; ++m)
#pragma unroll
                    for (int n = 0; n < 2; ++n) acc[a][b][m][n] = (f32x4){0.f, 0.f, 0.f, 0.f};
        cur = nxt; cA = nA; cB = nB; ++ui;
        if constexpr (ALIGN_EPI) { if (wr == 1) PG8_BAR; }
    }
    PG8_WAIT_V(0);
    if constexpr (!ALIGN_EPI) { if (wr == 0) PG8_BAR; }
    PG8_BAR;
    if constexpr (Epi::AFTER_DRAIN) { E.fused(acc, cur, wr, wc, fr, fq, lds, wid, lane); S.done(cur); }
#undef PG8_SA
#undef PG8_SB
#undef PG8_STAGE
#undef PG8_LDA
#undef PG8_LDB
#undef PG8_MMA
#undef PG8_WAIT_V
#undef PG8_WAIT_L
#undef PG8_BAR
#undef PG8_SCHED
}
}
#define GAS __attribute__((address_space(1)))
#define LAS __attribute__((address_space(3)))
typedef unsigned short bf16;
typedef unsigned v4u __attribute__((ext_vector_type(4)));
typedef float f32x4 __attribute__((ext_vector_type(4)));
typedef short bf16x8 __attribute__((ext_vector_type(8)));
typedef GAS unsigned gu32;
typedef GAS unsigned long long gu64;
#define RLX_AGENT __ATOMIC_RELAXED, __HIP_MEMORY_SCOPE_AGENT
#define LDS_WAIT() asm volatile("s_waitcnt lgkmcnt(0)" ::: "memory")
#define VM_WAIT() asm volatile("s_waitcnt vmcnt(0)" ::: "memory")
__device__ __forceinline__ unsigned long long rt() { return __builtin_amdgcn_s_memrealtime(); }
__device__ __forceinline__ unsigned f2bf(float f) { unsigned u = __builtin_bit_cast(unsigned, f); return (u + 0x7fffu + ((u >> 16) & 1u)) >> 16; }
__device__ __forceinline__ unsigned pk2(float lo, float hi) { return f2bf(lo) | (f2bf(hi) << 16); }

#define XB_TMO      128
#define XB_XCNT(j)  (256  + 64 * (j))
#define XB_XSUB(j)  (1280 + 64 * (j))
#define XB_XGEN(j)  (2304 + 64 * (j))
#define XB_TOP      3328
#define XB_TOPGEN   3392
#define XCD_BAR_WORDS 3456
#define XB_SPIN_CAP (1u << 18)

__device__ __forceinline__ unsigned xb_ld(unsigned* p)              { return __hip_atomic_load(p, __ATOMIC_RELAXED, __HIP_MEMORY_SCOPE_AGENT); }
__device__ __forceinline__ unsigned xb_add(unsigned* p, unsigned v) { return __hip_atomic_fetch_add(p, v, __ATOMIC_RELAXED, __HIP_MEMORY_SCOPE_AGENT); }
__device__ __forceinline__ unsigned xb_xcc_id() { return (unsigned)__builtin_amdgcn_s_getreg((3 << 11) | 20) & 0xFu; }
#define XB_SPIN(cond, bar) do { unsigned _sp = 0; while (cond) { __builtin_amdgcn_s_sleep(1); \
    if ((++_sp & 255u) == 0u) { if (xb_ld(&(bar)[XB_TMO])) break; if (_sp > XB_SPIN_CAP) { atomicAdd(&(bar)[XB_TMO], 1u); break; } } } } while (0)

struct XcdBarrier {
    unsigned* bar; unsigned x;
    volatile LAS unsigned* st;
};

__device__ __forceinline__ XcdBarrier xcd_barrier_post(unsigned* bar, volatile LAS unsigned* st) {
    XcdBarrier b; b.bar = bar; b.x = xb_xcc_id(); b.st = st;
    if (threadIdx.x == 0) (void)xb_add(&bar[XB_XCNT(b.x)], 1u);
    return b;
}
__device__ __forceinline__ void xcd_barrier_complete(unsigned* bar, unsigned x, unsigned& nloc, unsigned& nx) {
    const unsigned G = gridDim.x * gridDim.y * gridDim.z;
    unsigned sum, cnt, mine, sp = 0u;
    for (;;) {
        sum = 0u; cnt = 0u; mine = 0u;
#pragma unroll
        for (unsigned j = 0; j < 16; ++j) { const unsigned c = xb_ld(&bar[XB_XCNT(j)]); sum += c; cnt += (c > 0u) ? 1u : 0u; mine = (j == x) ? c : mine; }
        if (sum == G) break;
        __builtin_amdgcn_s_sleep(1);
        if ((++sp & 255u) == 0u) { if (xb_ld(&bar[XB_TMO])) break; if (sp > XB_SPIN_CAP) { atomicAdd(&bar[XB_TMO], 1u); break; } }
    }
    nloc = mine > 0u ? mine : 1u; nx = cnt > 0u ? cnt : 1u;
}

__device__ __forceinline__ void xcd_barrier(const XcdBarrier& b) {
    asm volatile("s_waitcnt vmcnt(0)" ::: "memory");
    __syncthreads();
    if (threadIdx.x == 0) {
        unsigned* bar = b.bar;
        __builtin_amdgcn_s_waitcnt(0);
        unsigned nloc = b.st[0], nx = b.st[1];
        if (nloc == 0u) { xcd_barrier_complete(bar, b.x, nloc, nx); b.st[0] = nloc; b.st[1] = nx; }
        const unsigned old = xb_add(&bar[XB_XSUB(b.x)], 1u);
        const unsigned gen = old / nloc;
        if (old + 1u == (gen + 1u) * nloc) {
            __builtin_amdgcn_fence(__ATOMIC_RELEASE, "agent");
            asm volatile("s_waitcnt vmcnt(0)" ::: "memory");
            const unsigned og = xb_add(&bar[XB_TOP], 1u);
            const unsigned tg = og / nx;
            if (og + 1u == (tg + 1u) * nx) xb_add(&bar[XB_TOPGEN], 1u);
            else XB_SPIN(xb_ld(&bar[XB_TOPGEN]) == tg, bar);
            __builtin_amdgcn_fence(__ATOMIC_ACQUIRE, "agent");
            xb_add(&bar[XB_XGEN(b.x)], 1u);
            asm volatile("s_waitcnt vmcnt(0)" ::: "memory");
        } else {
            XB_SPIN(xb_ld(&bar[XB_XGEN(b.x)]) == gen, bar);
            __builtin_amdgcn_fence(__ATOMIC_ACQUIRE, "agent");
            asm volatile("s_waitcnt vmcnt(0)" ::: "memory");
        }
    }
    __syncthreads();
}
constexpr int NWAVES = 8, NT = 512;
constexpr float S_GU = 32.f, S_DN = 64.f, S_OUT = 32.f, S_IN = 32.f;
constexpr int RING_BYTES = 131072, LDSCTL_OFF = RING_BYTES, MISC_OFF = LDSCTL_OFF + 320, LDS_BYTES = 147456;
constexpr int CW_TMO = 0, CW_BAR = 4096;
__device__ __forceinline__ float bf2f(bf16 v) { return __uint_as_float(((unsigned)v) << 16); }
__device__ __forceinline__ float bfr(float f) { return __uint_as_float(f2bf(f) << 16); }
__device__ __forceinline__ float wave_sum(float v) {
#pragma unroll
    for (int o = 1; o < 64; o <<= 1) v += __shfl_xor(v, o);
    return v;
}
template <bool F8>
__device__ __forceinline__ void tr64(const float* __restrict__ W, int Nsrc, int K, void* WT, int n0, int k0, int srccol, const float* __restrict__ kscale, float S, const float* __restrict__ kbias, float* csum, float* bsum, int lane) {
    const float* wp = W + (size_t)k0 * Nsrc + (srccol >= 0 ? srccol : 0); float cs = 0.f, bs = 0.f; const float rS = 1.f / S;
#pragma unroll 1
    for (int ch = 0; ch < 4; ++ch) {
        float v[16];
#pragma unroll
        for (int i = 0; i < 16; ++i) v[i] = srccol >= 0 ? wp[(size_t)(ch * 16 + i) * Nsrc] : 0.f;
        if (bsum) {
#pragma unroll
            for (int i = 0; i < 16; ++i) bs = fmaf(kbias[k0 + ch * 16 + i], v[i], bs); }
        if (kscale) {
#pragma unroll
            for (int i = 0; i < 16; ++i) v[i] *= kscale[k0 + ch * 16 + i]; }
        if constexpr (F8) {
            v4u o;
#pragma unroll
            for (int d = 0; d < 4; ++d) { int p = __builtin_amdgcn_cvt_pk_fp8_f32(v[4 * d] * S, v[4 * d + 1] * S, 0, false); p = __builtin_amdgcn_cvt_pk_fp8_f32(v[4 * d + 2] * S, v[4 * d + 3] * S, p, true); o[d] = (unsigned)p;
                if (csum) cs += ((__builtin_amdgcn_cvt_f32_fp8(p, 0) + __builtin_amdgcn_cvt_f32_fp8(p, 1)) + (__builtin_amdgcn_cvt_f32_fp8(p, 2) + __builtin_amdgcn_cvt_f32_fp8(p, 3))) * rS; }
            *(GAS v4u*)((unsigned char*)WT + (size_t)(n0 + lane) * K + k0 + ch * 16) = o;
        } else {
            v4u o0, o1;
#pragma unroll
            for (int d = 0; d < 4; ++d) { o0[d] = pk2(v[2 * d], v[2 * d + 1]); o1[d] = pk2(v[8 + 2 * d], v[8 + 2 * d + 1]); }
            GAS v4u* dst = (GAS v4u*)((bf16*)WT + (size_t)(n0 + lane) * K + k0 + ch * 16); dst[0] = o0; dst[1] = o1;
        }
    }
    if (csum) atomicAdd(csum + n0 + lane, cs);
    if (bsum) atomicAdd(bsum + n0 + lane, bs);
}


namespace att {
typedef short bf16x8 __attribute__((ext_vector_type(8)));
typedef short s16x4 __attribute__((ext_vector_type(4)));
typedef short v4i16_t __attribute__((ext_vector_type(4)));
typedef float f32x16 __attribute__((ext_vector_type(16)));
typedef unsigned u32x4 __attribute__((ext_vector_type(4)));
typedef unsigned u32x2 __attribute__((ext_vector_type(2)));
constexpr float C2 = 0.125f * 1.4426950408889634f;
constexpr float NEG_INF = -INFINITY;
__device__ __forceinline__ int crow(int r, int hi) { return (r & 3) + 8 * (r >> 2) + 4 * hi; }
__device__ __forceinline__ s16x4 vtr(const LAS unsigned char* p) { return __builtin_bit_cast(s16x4, __builtin_amdgcn_ds_read_tr16_b64_v4i16((LAS v4i16_t*)p)); }
__device__ __forceinline__ unsigned cvtpk(float lo, float hi) { typedef float f2_t __attribute__((ext_vector_type(2))); typedef __bf16 b2_t __attribute__((ext_vector_type(2))); f2_t v = {lo, hi}; b2_t b = __builtin_convertvector(v, b2_t); return __builtin_bit_cast(unsigned, b); }
__device__ __forceinline__ float ex2(float x) { return __builtin_amdgcn_exp2f(x); }

__device__ __forceinline__ void qkt(f32x16& p0, f32x16& p1, const LAS unsigned char* Ks, const bf16x8* qf, int r32, int hi) {
    const LAS unsigned char* kb = Ks + hi * 1024 + r32 * 16;
#pragma unroll
    for (int dh = 0; dh < 2; ++dh) {
        const bf16x8 b0 = *(const LAS bf16x8*)(kb + (2 * dh) * 2048), b1 = *(const LAS bf16x8*)(kb + (2 * dh) * 2048 + 512);
        const bf16x8 b2 = *(const LAS bf16x8*)(kb + (2 * dh + 1) * 2048), b3 = *(const LAS bf16x8*)(kb + (2 * dh + 1) * 2048 + 512);
        __builtin_amdgcn_s_setprio(1);
        p0 = __builtin_amdgcn_mfma_f32_32x32x16_bf16(b0, qf[2 * dh], p0, 0, 0, 0); p1 = __builtin_amdgcn_mfma_f32_32x32x16_bf16(b1, qf[2 * dh], p1, 0, 0, 0);
        p0 = __builtin_amdgcn_mfma_f32_32x32x16_bf16(b2, qf[2 * dh + 1], p0, 0, 0, 0); p1 = __builtin_amdgcn_mfma_f32_32x32x16_bf16(b3, qf[2 * dh + 1], p1, 0, 0, 0);
        __builtin_amdgcn_s_setprio(0);
        if (dh == 0) __builtin_amdgcn_sched_barrier(0);
    }
}
__device__ __forceinline__ float max3f(float a, float b, float c) { float r; asm("v_max3_f32 %0, %1, %2, %3" : "=v"(r) : "v"(a), "v"(b), "v"(c)); return r; }
__device__ __forceinline__ void cinit_bits(f32x16& c, unsigned w, int hi, float negm) {
    const unsigned w2 = w >> (4 * hi), nb = __float_as_uint(negm);
#pragma unroll
    for (int r = 0; r < 16; ++r) { const unsigned mm = (unsigned)__builtin_amdgcn_sbfe((int)w2, crow(r, 0), 1); c[r] = __uint_as_float((nb & mm) | (0xFF800000u & ~mm)); }
}
__device__ __forceinline__ void cinit_splat(f32x16& c, float v) {
#pragma unroll
    for (int r = 0; r < 16; ++r) c[r] = v;
}
__device__ __forceinline__ void pv(f32x16* o, const LAS unsigned char* Vs, int lane, int hi, const u32x4 (&pw)[4]) {
    const LAS unsigned char* vb = Vs + ((lane >> 4) & 1) * 32 + (lane & 3) * 8 + (4 * hi + ((lane & 15) >> 2)) * 64;
#pragma unroll
    for (int d0 = 0; d0 < 2; ++d0) {
        s16x4 lo[4], hh[4];
#pragma unroll
        for (int ks = 0; ks < 4; ++ks) { lo[ks] = vtr(vb + d0 * 4096 + ks * 1024); hh[ks] = vtr(vb + d0 * 4096 + ks * 1024 + 512); }
        asm volatile("s_waitcnt lgkmcnt(0)" ::: "memory"); __builtin_amdgcn_sched_barrier(0);
        __builtin_amdgcn_s_setprio(1);
#pragma unroll
        for (int ks = 0; ks < 4; ++ks) { const bf16x8 vf = {lo[ks][0], lo[ks][1], lo[ks][2], lo[ks][3], hh[ks][0], hh[ks][1], hh[ks][2], hh[ks][3]};
            o[d0] = __builtin_amdgcn_mfma_f32_32x32x16_bf16(__builtin_bit_cast(bf16x8, pw[ks]), vf, o[d0], 0, 0, 0); }
        __builtin_amdgcn_s_setprio(0);
    }
}
__device__ __forceinline__ void softmax_step(f32x16& p0, f32x16& p1, float& m, float& l, f32x16* o, LAS float* wsf, int r32, int hi, u32x4 (&pw)[4]) {
    float rm = fmaxf(p0[0], p1[0]);
#pragma unroll
    for (int r = 1; r < 16; ++r) rm = fmaxf(rm, fmaxf(p0[r], p1[r]));
    rm = fmaxf(rm, __shfl_xor(rm, 32));
    if (__any(rm > m)) {
        const float mn = fmaxf(m, rm), f = ex2(m - mn);
        l *= f; m = mn;
        if (hi == 0) wsf[r32] = f;
#pragma unroll
        for (int r = 0; r < 16; ++r) { const float fr = wsf[crow(r, hi)]; o[0][r] *= fr; o[1][r] *= fr; }
    }
    float s = 0.f;
#pragma unroll
    for (int r = 0; r < 16; ++r) { p0[r] = ex2(p0[r] - m); p1[r] = ex2(p1[r] - m); s += p0[r] + p1[r]; }
    l += s;
    pw[0] = u32x4{cvtpk(p0[0], p0[1]), cvtpk(p0[2], p0[3]), cvtpk(p0[4], p0[5]), cvtpk(p0[6], p0[7])};
    pw[1] = u32x4{cvtpk(p0[8], p0[9]), cvtpk(p0[10], p0[11]), cvtpk(p0[12], p0[13]), cvtpk(p0[14], p0[15])};
    pw[2] = u32x4{cvtpk(p1[0], p1[1]), cvtpk(p1[2], p1[3]), cvtpk(p1[4], p1[5]), cvtpk(p1[6], p1[7])};
    pw[3] = u32x4{cvtpk(p1[8], p1[9]), cvtpk(p1[10], p1[11]), cvtpk(p1[12], p1[13]), cvtpk(p1[14], p1[15])};
}
__device__ __forceinline__ void mask_bits(f32x16& p, unsigned w, int hi) {
    const unsigned w2 = w >> (4 * hi);
#pragma unroll
    for (int r = 0; r < 16; ++r) p[r] = ((w2 >> crow(r, 0)) & 1u) ? p[r] : NEG_INF;
}
constexpr float THRL = 8.f;
__device__ __forceinline__ void partialSM(f32x16& p0, f32x16& p1, float& m_reg, float& alpha, bool& seen) {
    float a = max3f(p0[0], p0[1], p1[0]), b = max3f(p0[2], p0[3], p1[1]); a = max3f(a, p1[2], p1[3]);
#pragma unroll
    for (int r = 4; r < 16; r += 4) { a = max3f(a, p0[r], p0[r + 1]); b = max3f(b, p0[r + 2], p0[r + 3]); a = max3f(a, p1[r], p1[r + 1]); b = max3f(b, p1[r + 2], p1[r + 3]); }
    float pmax = max3f(a, b, b);
    { auto rr = __builtin_amdgcn_permlane32_swap(__float_as_uint(pmax), __float_as_uint(pmax), false, false); pmax = max3f(__uint_as_float(rr[0]), __uint_as_float(rr[1]), __uint_as_float(rr[1])); }
    const bool fin = pmax > NEG_INF, init = fin && !seen, up = seen && pmax > THRL;
    alpha = 1.f;
    if (__builtin_expect(__any(init || up), 0)) { const float dl = (init || up) ? pmax : 0.f; alpha = up ? ex2(-dl) : 1.f; m_reg += dl;
#pragma unroll
        for (int r = 0; r < 16; ++r) { p0[r] -= dl; p1[r] -= dl; } }
    seen = seen || fin;
#pragma unroll
    for (int r = 0; r < 16; ++r) p0[r] = ex2(p0[r]);
}
__device__ __forceinline__ void finishSM(f32x16& p0, f32x16& p1, float alpha, float& l_reg, u32x4 (&pw)[4]) {
#pragma unroll
    for (int r = 0; r < 16; ++r) p1[r] = ex2(p1[r]);
    float ps = 0.f;
#pragma unroll
    for (int r = 0; r < 16; ++r) ps += p0[r] + p1[r];
    l_reg = l_reg * alpha + ps;
    pw[0] = u32x4{cvtpk(p0[0], p0[1]), cvtpk(p0[2], p0[3]), cvtpk(p0[4], p0[5]), cvtpk(p0[6], p0[7])};
    pw[1] = u32x4{cvtpk(p0[8], p0[9]), cvtpk(p0[10], p0[11]), cvtpk(p0[12], p0[13]), cvtpk(p0[14], p0[15])};
    pw[2] = u32x4{cvtpk(p1[0], p1[1]), cvtpk(p1[2], p1[3]), cvtpk(p1[4], p1[5]), cvtpk(p1[6], p1[7])};
    pw[3] = u32x4{cvtpk(p1[8], p1[9]), cvtpk(p1[10], p1[11]), cvtpk(p1[12], p1[13]), cvtpk(p1[14], p1[15])};
}
__device__ __forceinline__ void rescale_o(f32x16* o, float alpha, LAS float* wsf, int r32, int hi) {
    if (__any(alpha < 1.f)) { if (hi == 0) wsf[r32] = alpha;
#pragma unroll
        for (int r = 0; r < 16; ++r) { const float fr = wsf[crow(r, hi)]; o[0][r] *= fr; o[1][r] *= fr; } }
}
#define SBAR_() __builtin_amdgcn_sched_barrier(0)
template <class Stg, class MaskF>
__device__ __forceinline__ void flash_loop(int t0, int nt, Stg& sg, const MaskF& mk, const bf16x8* qf, LAS unsigned char* kb, LAS unsigned char* vb, int bstride,
                                           float& m_reg, float& l_reg, f32x16* o, LAS float* wsf, int lane, int r32, int hi, bool preloaded = false) {
    f32x16 pA0, pA1, pB0, pB1; float alA = 1.f, alB = 1.f; u32x4 pw[4]; bool seen = false;
    if (!preloaded) sg.load(t0);
    sg.store(0); __syncthreads();
    if (nt > 1) sg.load(t0 + 1); else sg.load_after();
    mk(pA0, pA1, t0, -m_reg); qkt(pA0, pA1, kb, qf, r32, hi); mk.post(pA0, pA1, t0); partialSM(pA0, pA1, m_reg, alA, seen);
    if (nt > 1) sg.store(1);
    __syncthreads();
#define FL_STEP(C0, C1, ALC, P0, P1, ALP, J) do { const int cb_ = ((J) & 1) * bstride, pb_ = (((J) - 1) & 1) * bstride; \
        if ((J) + 1 < nt) sg.load(t0 + (J) + 1); else sg.load_after(); \
        mk(C0, C1, t0 + (J), -m_reg); SBAR_(); qkt(C0, C1, kb + cb_, qf, r32, hi); \
        finishSM(P0, P1, ALP, l_reg, pw); SBAR_(); \
        pv(o, vb + pb_, lane, hi, pw); mk.post(C0, C1, t0 + (J)); partialSM(C0, C1, m_reg, ALC, seen); \
        __syncthreads(); \
        if ((J) + 1 < nt) sg.store(((J) + 1) & 1); \
        rescale_o(o, ALC, wsf, r32, hi); \
        __syncthreads(); } while (0)
    int j = 1;
    for (; j + 1 < nt; j += 2) { FL_STEP(pB0, pB1, alB, pA0, pA1, alA, j); FL_STEP(pA0, pA1, alA, pB0, pB1, alB, j + 1); }
    if (j < nt) { FL_STEP(pB0, pB1, alB, pA0, pA1, alA, j); ++j; }
    if (nt & 1) { finishSM(pA0, pA1, alA, l_reg, pw); SBAR_(); pv(o, vb, lane, hi, pw); }
    else { finishSM(pB0, pB1, alB, l_reg, pw); SBAR_(); pv(o, vb + bstride, lane, hi, pw); }
#undef FL_STEP
    __syncthreads();
}
template <class Stg, class MaskF>
__device__ __forceinline__ void flash_loop_r(int t0, int nt, Stg& sg, const MaskF& mk, const bf16x8* qf, LAS unsigned char* kb, int kstride, LAS unsigned char* vb, int vstride,
                                             float& m_reg, float& l_reg, f32x16* o, LAS float* wsf, int lane, int r32, int hi, bool preloaded = false) {
    f32x16 pA0, pA1, pB0, pB1; float alA = 1.f, alB = 1.f; u32x4 pw[4]; bool seen = false;
    if (!preloaded) sg.load(t0);
    sg.store(0, 0); __syncthreads();
    if (nt > 1) sg.load(t0 + 1); else sg.load_after();
    mk(pA0, pA1, t0, -m_reg); qkt(pA0, pA1, kb, qf, r32, hi); mk.post(pA0, pA1, t0); partialSM(pA0, pA1, m_reg, alA, seen);
    if (nt > 1) sg.store(1, 1);
    __syncthreads();
    int vprev = 0, vcur = 1, vnext = 2;
#define FR_STEP(C0, C1, ALC, P0, P1, ALP, J) do { \
        if ((J) + 1 < nt) sg.load(t0 + (J) + 1); else sg.load_after(); \
        mk(C0, C1, t0 + (J), -m_reg); SBAR_(); qkt(C0, C1, kb + ((J) & 1) * kstride, qf, r32, hi); \
        finishSM(P0, P1, ALP, l_reg, pw); SBAR_(); \
        pv(o, vb + vprev * vstride, lane, hi, pw); mk.post(C0, C1, t0 + (J)); partialSM(C0, C1, m_reg, ALC, seen); \
        rescale_o(o, ALC, wsf, r32, hi); \
        if ((J) + 1 < nt) sg.store(((J) + 1) & 1, vnext); \
        __syncthreads(); \
        { const int t_ = vprev; vprev = vcur; vcur = vnext; vnext = t_; } } while (0)
    int j = 1;
    for (; j + 1 < nt; j += 2) { FR_STEP(pB0, pB1, alB, pA0, pA1, alA, j); FR_STEP(pA0, pA1, alA, pB0, pB1, alB, j + 1); }
    if (j < nt) { FR_STEP(pB0, pB1, alB, pA0, pA1, alA, j); ++j; }
    if (nt & 1) { finishSM(pA0, pA1, alA, l_reg, pw); SBAR_(); pv(o, vb + vprev * vstride, lane, hi, pw); }
    else { finishSM(pB0, pB1, alB, l_reg, pw); SBAR_(); pv(o, vb + vprev * vstride, lane, hi, pw); }
#undef FR_STEP
    __syncthreads();
}
template <class Stg, class MaskF>
__device__ __forceinline__ void flash_loop_b(int t0, int nt, Stg& sg, const MaskF& mk, const bf16x8* qf, LAS unsigned char* kb, LAS unsigned char* vb, int bstride,
                                             float& m_reg, float& l_reg, f32x16* o, LAS float* wsf, int lane, int r32, int hi, bool preloaded = false) {
    f32x16 c0, c1; u32x4 pw[4]; float alpha = 1.f; bool seen = false;
    if (!preloaded) sg.load(t0);
    sg.store(0); __syncthreads();
    if (nt > 1) sg.load(t0 + 1); else sg.load_after();
    mk(c0, c1, t0, -m_reg); qkt(c0, c1, kb, qf, r32, hi); mk.post(c0, c1, t0);
    partialSM(c0, c1, m_reg, alpha, seen); finishSM(c0, c1, alpha, l_reg, pw);
    if (nt > 1) sg.store(1);
    __syncthreads();
    for (int j = 1; j < nt; ++j) {
        const int cb_ = (j & 1) * bstride, pb_ = ((j - 1) & 1) * bstride;
        if (j + 1 < nt) sg.load(t0 + j + 1); else sg.load_after();
        mk(c0, c1, t0 + j, -m_reg); SBAR_(); qkt(c0, c1, kb + cb_, qf, r32, hi);
        pv(o, vb + pb_, lane, hi, pw);
        mk.post(c0, c1, t0 + j);
        partialSM(c0, c1, m_reg, alpha, seen); finishSM(c0, c1, alpha, l_reg, pw);
        __syncthreads();
        if (j + 1 < nt) sg.store((j + 1) & 1);
        rescale_o(o, alpha, wsf, r32, hi);
        __syncthreads();
    }
    pv(o, vb + ((nt - 1) & 1) * bstride, lane, hi, pw);
    __syncthreads();
}
__device__ __forceinline__ float stage_o(const f32x16* o, float ltot, LAS float* wsf, LAS float* stg, int lane, int r32, int hi) {
    if (hi == 0) wsf[r32] = 1.f / fmaxf(ltot, 1e-30f);
#pragma unroll
    for (int r = 0; r < 16; ++r) { const int q = crow(r, hi); const float rl = wsf[q]; stg[q * 64 + r32] = o[0][r] * rl; stg[q * 64 + 32 + r32] = o[1][r] * rl; }
    const LAS f32x4* rowp = (const LAS f32x4*)(stg + (lane >> 1) * 64 + (lane & 1) * 32); float ss = 0.f;
#pragma unroll
    for (int i = 0; i < 8; ++i) { const f32x4 v = rowp[i]; ss += (v[0] * v[0] + v[1] * v[1]) + (v[2] * v[2] + v[3] * v[3]); }
    ss += __shfl_xor(ss, 1);
    return ss;
}
__device__ __forceinline__ void store_o(const LAS float* stg, float rinv, const float* __restrict__ gain, bf16* __restrict__ dst, int lane) {
    const LAS f32x4* rowp = (const LAS f32x4*)(stg + (lane >> 1) * 64 + (lane & 1) * 32); const f32x4* gp = (const f32x4*)(gain + (lane & 1) * 32);
#if MIXED_F8
    u32x4* dp = (u32x4*)((unsigned char*)dst + (lane & 1) * 32);
#pragma unroll
    for (int i = 0; i < 2; ++i) { u32x4 o;
#pragma unroll
        for (int d = 0; d < 4; ++d) { const f32x4 a = rowp[4 * i + d] * rinv * gp[4 * i + d];
            int p = __builtin_amdgcn_cvt_pk_fp8_f32(a[0], a[1], 0, false); p = __builtin_amdgcn_cvt_pk_fp8_f32(a[2], a[3], p, true); o[d] = (unsigned)p; }
        dp[i] = o; }
#else
    u32x4* dp = (u32x4*)(dst + (lane & 1) * 32);
#pragma unroll
    for (int i = 0; i < 4; ++i) { const f32x4 a = rowp[2 * i] * rinv * gp[2 * i], b2 = rowp[2 * i + 1] * rinv * gp[2 * i + 1];
        dp[i] = u32x4{cvtpk(a[0], a[1]), cvtpk(a[2], a[3]), cvtpk(b2[0], b2[1]), cvtpk(b2[2], b2[3])}; }
#endif
}

constexpr int NB = 256, CAP = 64;
constexpr int L_IQ = 0, L_NRM = 16384, L_KV = 0, L_HIST = 32768, HSTR = 257  , L_MASK = 65792, L_CAND = 73984, L_QI = 90368, L_WSF = 98304, L_ROWSQ = 100352, L_STG = 32768;
typedef u32x2 DsaCand;
__device__ __forceinline__ int idx_bin(float v, float lo, float invw, bool filt) { const float f = (v - lo) * invw; int b = (int)f; b = b > NB - 1 ? NB - 1 : b; return (f >= 0.f) ? b : (filt ? -1 : 0); }
__device__ __forceinline__ void idx_tile(float (&idx)[16], const bf16x8 a0, const bf16x8 a1, const LAS unsigned char* iqs, const float (&w)[8], int lane) {
#pragma unroll
    for (int r = 0; r < 16; ++r) idx[r] = 0.f;
    const LAS bf16x8* fq = (const LAS bf16x8*)(iqs + lane * 16);
    bf16x8 b0 = fq[0], b1 = fq[64], n0 = fq[128], n1 = fq[192];
    f32x16 c = __builtin_amdgcn_mfma_f32_32x32x16_bf16(a0, b0, f32x16{}, 0, 0, 0);
    c = __builtin_amdgcn_mfma_f32_32x32x16_bf16(a1, b1, c, 0, 0, 0);
#pragma unroll
    for (int h = 0; h < 8; ++h) {
        f32x16 cn = c;
        if (h < 7) { b0 = n0; b1 = n1;
            if (h < 6) { n0 = fq[((h + 2) * 2 + 0) * 64]; n1 = fq[((h + 2) * 2 + 1) * 64]; }
            cn = __builtin_amdgcn_mfma_f32_32x32x16_bf16(a0, b0, f32x16{}, 0, 0, 0);
            cn = __builtin_amdgcn_mfma_f32_32x32x16_bf16(a1, b1, cn, 0, 0, 0); }
#pragma unroll
        for (int r = 0; r < 16; ++r) idx[r] = fmaf(w[h], fmaxf(c[r], 0.f), idx[r]);
        c = cn;
        __builtin_amdgcn_sched_barrier(0);
    }
#pragma unroll
    for (int r = 0; r < 16; ++r) idx[r] *= IDX_SCALE;
}
__device__ __forceinline__ void dsa_unit(LAS unsigned char* L, const bf16* __restrict__ act, const float* __restrict__ mix_gain, bf16* __restrict__ mixed, DsaCand* __restrict__ gcand, float* __restrict__ gidx, int b, int qt) {
    int tid = threadIdx.x; asm volatile("" : "+v"(tid));
    const int lane = tid & 63, r32 = lane & 31, hi = lane >> 5; const int w = __builtin_amdgcn_readfirstlane(tid >> 6);
    LAS unsigned* hist = (LAS unsigned*)(L + L_HIST); LAS unsigned* mask = (LAS unsigned*)(L + L_MASK); LAS DsaCand* cand = (LAS DsaCand*)(L + L_CAND);
    LAS unsigned* q_cnt = (LAS unsigned*)(L + L_QI); LAS int* q_B = (LAS int*)(L + L_QI + 128); LAS int* q_need = (LAS int*)(L + L_QI + 256);
    LAS float* wsf = (LAS float*)(L + L_WSF) + w * 64; LAS float* rowsq = (LAS float*)(L + L_ROWSQ);
    const int tq = qt * 32 + r32; const size_t rowq = (size_t)b * SEQ + tq; const bf16* ab = act + (size_t)b * SEQ * ACT_COLS;
    bf16x8 qf[4]; u32x4 kpre, vpre;
    const bf16* kg0 = ab + (size_t)lane * ACT_COLS + C_DK + 8 * w;
    const bf16* vg0 = ab + (size_t)(16 * (w & 3) + (lane >> 2)) * ACT_COLS + C_DV + 32 * (w >> 2) + 8 * (lane & 3);
    TIC(11); TIC(20);
    {
        if (w == 0) { __builtin_amdgcn_fence(__ATOMIC_ACQUIRE, "agent"); asm volatile("s_waitcnt vmcnt(0)" ::: "memory"); }
        const bf16* ar = act + rowq * ACT_COLS;
        const bf16x8 i0 = *(const bf16x8*)(ar + C_IQ + w * 32 + 8 * hi), i1 = *(const bf16x8*)(ar + C_IQ + w * 32 + 16 + 8 * hi);
        const u32x4 wv = *(const u32x4*)(ar + C_IW);
        for (int i = tid; i < (L_CAND - L_HIST) / 16; i += NT) ((LAS u32x4*)(L + L_HIST))[i] = u32x4{0u, 0u, 0u, 0u};
        if (tid < 128) ((LAS unsigned*)(L + L_QI))[tid] = (tid >= 32 && tid < 64) ? 0xFFFFFFFFu : 0u;
        __syncthreads();
        float wq[8];
        const LAS unsigned char* iqs = L + L_IQ; LAS float* nrm = (LAS float*)(L + L_NRM);
        {
            *(LAS bf16x8*)(L + L_IQ + ((w * 2 + 0) * 64 + lane) * 16) = i0; *(LAS bf16x8*)(L + L_IQ + ((w * 2 + 1) * 64 + lane) * 16) = i1;
            float n2 = 0.f;
#pragma unroll
            for (int j = 0; j < 8; ++j) { const float a = __uint_as_float(((unsigned)(unsigned short)i0[j]) << 16), c = __uint_as_float(((unsigned)(unsigned short)i1[j]) << 16); n2 += a * a + c * c; }
            n2 += __shfl_xor(n2, 32);
            if (hi == 0) nrm[w * 32 + r32] = n2;
        }
        {
#pragma unroll
          for (int e = 0; e < 4; ++e) { wq[2 * e] = __uint_as_float(wv[e] << 16); wq[2 * e + 1] = __uint_as_float(wv[e] & 0xffff0000u); } }
        __syncthreads();
        TOC(20);
        float lo = 0.f, invw = 0.f; bool filtF = true;
        if (qt >= 8) {
            float sk2;
            { const bf16x8 k0 = *(const bf16x8*)(ar + C_IK + 8 * hi), k1 = *(const bf16x8*)(ar + C_IK + 16 + 8 * hi); float s = 0.f;
#pragma unroll
              for (int j = 0; j < 8; ++j) { const float a = __uint_as_float(((unsigned)(unsigned short)k0[j]) << 16), c = __uint_as_float(((unsigned)(unsigned short)k1[j]) << 16); s += a * a + c * c; }
              sk2 = wave_sum(s) * (1.f / 1024.f); }
            float sm = 0.f, sv = 0.f;
#pragma unroll
            for (int h = 0; h < 8; ++h) { const float n2 = nrm[h * 32 + r32]; sm += wq[h] * sqrtf(n2); sv += wq[h] * wq[h] * n2; }
            const float sk = sqrtf(sk2), mu = IDX_SCALE * sk * 0.3989423f * sm, sig = fmaxf(IDX_SCALE * sk * sqrtf(0.3408f * sv), 1e-20f);
            const float tail = fminf(1.f, 700.f / (float)(tq + 1));
            const float zq = tail < 0.95f ? -__logf(tail / (1.f - tail)) * (1.f / 1.702f) : -6.f;
            LAS unsigned* q_fail = (LAS unsigned*)(L + L_QI + 384);
            for (int attempt = 0; attempt < 2; ++attempt) {
                const bool filt = attempt == 0; filtF = filt;
                lo = mu + (filt ? zq : -6.f) * sig; invw = (float)NB / ((mu + 6.f * sig) - lo);
                if (attempt == 1) { for (int i = tid; i < (L_MASK - L_HIST) / 16; i += NT) ((LAS u32x4*)(L + L_HIST))[i] = u32x4{0u, 0u, 0u, 0u}; __syncthreads(); }
                TIC(21);
                for (int repH = 0; repH < ((PROBE_DUP == 28) ? 2 : 1); ++repH) {
                    const float lo_h = (PROBE_DUP == 28 && repH == 0) ? 3.0e38f : lo;
                    const bf16* ikp = ab + (size_t)r32 * ACT_COLS + C_IK + 8 * hi;
                    bf16x8 a0 = *(const bf16x8*)(ikp + (size_t)w * 32 * ACT_COLS), a1 = *(const bf16x8*)(ikp + (size_t)w * 32 * ACT_COLS + 16);
                    for (int kt = w; kt <= qt; kt += 8) {
                        const bf16x8 c0 = a0, c1 = a1;
                        if (kt + 8 <= qt) { a0 = *(const bf16x8*)(ikp + (size_t)(kt + 8) * 32 * ACT_COLS); a1 = *(const bf16x8*)(ikp + (size_t)(kt + 8) * 32 * ACT_COLS + 16); }
                        float idx[16]; idx_tile(idx, c0, c1, iqs, wq, lane);
                        if (filt) { f32x4* gp = (f32x4*)(gidx + ((size_t)kt * 64 + lane) * 16);
#pragma unroll
                            for (int i = 0; i < 4; ++i) gp[i] = f32x4{idx[4 * i], idx[4 * i + 1], idx[4 * i + 2], idx[4 * i + 3]}; }
                        const int lim = tq - kt * 32 - 4 * hi;
#pragma unroll
                        for (int r = 0; r < 16; ++r) { const int bn = idx_bin(idx[r], lo_h, invw, filt);
                            if (crow(r, 0) <= lim && bn >= 0) { __hip_atomic_fetch_add(hist + r32 * HSTR + bn, 1u, __ATOMIC_RELAXED, __HIP_MEMORY_SCOPE_WORKGROUP);
#if PROBE_DUP == 26
                                __hip_atomic_fetch_add((LAS unsigned*)(L + 17408) + tid * 7 + (bn % 7), 1u, __ATOMIC_RELAXED, __HIP_MEMORY_SCOPE_WORKGROUP);
#endif
#if PROBE_DUP == 27
                                { LAS unsigned* pp = (LAS unsigned*)(L + 17408) + tid * 7 + (bn % 7); *pp = *pp + 1u; }
#endif
                            } }
                    }
                }
                asm volatile("s_waitcnt vmcnt(0)" ::: "memory");
                __syncthreads();
                TOC(21); TIC(22);
                {
                    const int grp = lane >> 4, sl = lane & 15, q = w * 4 + grp; const LAS unsigned* hrow = hist + q * HSTR + 16 * sl;
                    int c[16];
#pragma unroll
                    for (int i = 0; i < 16; ++i) c[i] = (int)hrow[i];
                    int cl = 0;
#pragma unroll
                    for (int i = 0; i < 16; ++i) cl += c[i];
                    int S = cl;
#pragma unroll
                    for (int o = 1; o < 16; o <<= 1) { const int v = __shfl_down(S, o, 16); if (sl + o < 16) S += v; }
                    const unsigned long long bal = __ballot(S >= IDX_TOPK);
                    const unsigned gb = (unsigned)(bal >> (16 * grp)) & 0xFFFFu;
                    if (gb == 0u) { if (sl == 0) q_fail[0] = 1u; }
                    else {
                        const int Lh = 31 - __clz((int)gb);
                        int above = S - cl, Bq = -1, ca = 0;
#pragma unroll
                        for (int i = 15; i >= 0; --i) { if (Bq < 0) { if (above + c[i] >= IDX_TOPK) { Bq = 16 * sl + i; ca = above; } else above += c[i]; } }
                        if (sl == Lh) { q_B[q] = Bq; q_need[q] = IDX_TOPK - ca; }
                    }
                }
                __syncthreads();
                TOC(22);
                const bool failed = q_fail[0] != 0u;
                if (!failed || attempt == 1) break;
                __syncthreads();
                if (tid == 0) q_fail[0] = 0u;
            }
        }
        TIC(23);
        const int Bq = q_B[r32];
        if (qt >= 8) {
            const f32x4* gp0 = (const f32x4*)(gidx + (size_t)lane * 16);
            f32x4 v0 = gp0[(size_t)w * 256], v1 = gp0[(size_t)w * 256 + 1], v2 = gp0[(size_t)w * 256 + 2], v3 = gp0[(size_t)w * 256 + 3];
            for (int kt = w; kt <= qt; kt += 8) {
                const float idx[16] = {v0[0], v0[1], v0[2], v0[3], v1[0], v1[1], v1[2], v1[3], v2[0], v2[1], v2[2], v2[3], v3[0], v3[1], v3[2], v3[3]};
                if (kt + 8 <= qt) { const f32x4* gn = gp0 + (size_t)(kt + 8) * 256; v0 = gn[0]; v1 = gn[1]; v2 = gn[2]; v3 = gn[3]; }
                unsigned word = 0u; const int lim = tq - kt * 32 - 4 * hi;
#pragma unroll
                for (int r = 0; r < 16; ++r) {
                    if (crow(r, 0) <= lim) { const int bn = idx_bin(idx[r], lo, invw, filtF);
                        if (bn > Bq) word |= 1u << crow(r, 0);
                        else if (bn == Bq) { const unsigned slot = __hip_atomic_fetch_add(q_cnt + r32, 1u, __ATOMIC_RELAXED, __HIP_MEMORY_SCOPE_WORKGROUP); const DsaCand cnd = {__float_as_uint(idx[r]), (unsigned)(kt * 32 + crow(r, hi))};
                            if (slot < (unsigned)CAP) cand[r32 * CAP + slot] = cnd;
                            gcand[(size_t)r32 * SEQ + slot] = cnd; } } }
                if (word) __hip_atomic_fetch_or(mask + r32 * 64 + kt, word << (4 * hi), __ATOMIC_RELAXED, __HIP_MEMORY_SCOPE_WORKGROUP);
            }
        } else {
            for (int kt = w; kt <= qt; kt += 8) { const int lim = tq - kt * 32 - 4 * hi; unsigned word = 0u;
#pragma unroll
                for (int r = 0; r < 16; ++r) if (crow(r, 0) <= lim) word |= 1u << crow(r, 0);
                if (word) __hip_atomic_fetch_or(mask + r32 * 64 + kt, word << (4 * hi), __ATOMIC_RELAXED, __HIP_MEMORY_SCOPE_WORKGROUP); }
        }
        asm volatile("s_waitcnt vmcnt(0)" ::: "memory");
        __syncthreads();
        TOC(23); TIC(24);
        { const bf16* qp = ab + (size_t)tq * ACT_COLS + C_DQ + w * 64 + 8 * hi;
#pragma unroll
          for (int d0 = 0; d0 < 4; ++d0) qf[d0] = *(const bf16x8*)(qp + d0 * 16);
          kpre = *(const u32x4*)kg0; vpre = *(const u32x4*)vg0; }
#pragma unroll 1
        for (int qq = 0; qq < ((PROBE_DUP == 29) ? 8 : 4); ++qq) {
            const int q = w * 4 + (qq & 3); const int nc = (int)q_cnt[q], need = q_need[q];
            if (nc <= CAP) {
                DsaCand me = {0u, 0u}; if (lane < nc) me = cand[q * CAP + lane];
                const float mv = __uint_as_float(me[0]); int rk = 0;
                for (int j = 0; j < nc; ++j) { const float ov = __uint_as_float((unsigned)__builtin_amdgcn_readlane((int)me[0], j)); const unsigned ok = (unsigned)__builtin_amdgcn_readlane((int)me[1], j);
                    rk += (ov > mv || (ov == mv && ok < me[1])) ? 1 : 0; }
                if (lane < nc && rk < need) __hip_atomic_fetch_or(mask + q * 64 + (me[1] >> 5), 1u << (me[1] & 31u), __ATOMIC_RELAXED, __HIP_MEMORY_SCOPE_WORKGROUP);
            } else {
                const unsigned long long* gc = (const unsigned long long*)(gcand + (size_t)q * SEQ);
                for (int i0 = 0; i0 < nc; i0 += 64) { const int i = i0 + lane;
                    if (i < nc) { const unsigned long long me = __hip_atomic_load(gc + i, __ATOMIC_RELAXED, __HIP_MEMORY_SCOPE_AGENT); const float mv = __uint_as_float((unsigned)me); const unsigned mk = (unsigned)(me >> 32); int rk = 0;
                        for (int j = 0; j < nc; ++j) { const unsigned long long ot = __hip_atomic_load(gc + j, __ATOMIC_RELAXED, __HIP_MEMORY_SCOPE_AGENT); const float ov = __uint_as_float((unsigned)ot); const unsigned ok = (unsigned)(ot >> 32);
                            rk += (ov > mv || (ov == mv && ok < mk)) ? 1 : 0; }
                        if (rk < need) __hip_atomic_fetch_or(mask + q * 64 + (mk >> 5), 1u << (mk & 31u), __ATOMIC_RELAXED, __HIP_MEMORY_SCOPE_WORKGROUP); } }
            }
        }
        __syncthreads();
    }
    TOC(24); TOC(11);
    TIC(12);
    const int ntile = (qt >> 1) + 1;
    struct DsaStg { const bf16* kg; const bf16* vg; LAS unsigned char* kdst; u32x4 kreg, vreg;
        __device__ __forceinline__ void load(int t) { kreg = *(const u32x4*)(kg + (size_t)t * 64 * ACT_COLS); vreg = *(const u32x4*)(vg + (size_t)t * 64 * ACT_COLS); }
        __device__ __forceinline__ void store(int ks, int vs) { *(LAS u32x4*)(kdst + ks * 8192) = kreg; *(LAS u32x4*)(kdst + 16384 + vs * 8192) = vreg; }
        __device__ __forceinline__ void load_after() {} };
    struct DsaMask { const LAS unsigned* mrow; int hi;
        __device__ __forceinline__ void operator()(f32x16& c0, f32x16& c1, int t, float negm) const { cinit_splat(c0, negm); cinit_splat(c1, negm); }
        __device__ __forceinline__ void post(f32x16& p0, f32x16& p1, int t) const { const u32x2 mw = *(const LAS u32x2*)(mrow + 2 * t); mask_bits(p0, mw[0], hi); mask_bits(p1, mw[1], hi); } };
    DsaStg sg; sg.kg = kg0; sg.vg = vg0; sg.kreg = kpre; sg.vreg = vpre;
    sg.kdst = L + L_KV + w * 1024 + lane * 16;
    DsaMask mk{mask + r32 * 64, hi};
    float m = 0.f, l = 0.f; f32x16 o[2]; o[0] = f32x16{}; o[1] = f32x16{};
    flash_loop_r(0, ntile, sg, mk, qf, L + L_KV, 8192, L + L_KV + 16384, 8192, m, l, o, wsf, lane, r32, hi, true);
    const float ltot = l + __shfl_xor(l, 32);
    LAS float* stg = (LAS float*)(L + L_STG) + w * 2048;
    const float ss = stage_o(o, ltot, wsf, stg, lane, r32, hi);
    if ((lane & 1) == 0) rowsq[w * 32 + (lane >> 1)] = ss;
    __syncthreads();
    float tot = 0.f;
#pragma unroll
    for (int h = 0; h < 8; ++h) tot += rowsq[h * 32 + (lane >> 1)];
    const float rinv = rsqrtf(tot * (1.f / 512.f) + LN_EPS);
    store_o(stg, rinv, mix_gain + w * 64, MIXED_F8 ? (bf16*)((unsigned char*)mixed + ((size_t)b * SEQ + qt * 32 + (lane >> 1)) * D_MODEL + w * 64) : mixed + ((size_t)b * SEQ + qt * 32 + (lane >> 1)) * D_MODEL + w * 64, lane);
    __syncthreads();
    TOC(12);
}
}


namespace cmp {
using att::bf16x8; using att::f32x16; using att::crow; using att::cvtpk;
__device__ __forceinline__ void compress_unit(LAS unsigned char* L, const bf16* __restrict__ act, const bf16* __restrict__ w1t, const bf16* __restrict__ w2t, const float* __restrict__ bias1,
                                              bf16* __restrict__ kcb, float* __restrict__ kcf, int u) {
    const int tid = threadIdx.x, lane = tid & 63, r32 = lane & 31, hi = lane >> 5; const int w = __builtin_amdgcn_readfirstlane(tid >> 6);
    const int cb = u & 3, g = (u >> 2) & 1, b = (u >> 3) & 15, kv = u >> 7;
    const int c = cb * 32 + r32, cc = c < N_C ? c : N_C - 1;
    LAS float* part = (LAS float*)L;
    {
        const bf16* arow = act + ((size_t)b * SEQ + cc * CMP_STRIDE) * ACT_COLS + (kv ? C_VCM : C_KCM) + g * 64 + 8 * hi;
        const bf16* wrow = w1t + ((size_t)kv * CMP_HIDDEN + r32) * 2048 + 8 * hi;
        f32x16 acc[4]; acc[0] = f32x16{}; acc[1] = f32x16{}; acc[2] = f32x16{}; acc[3] = f32x16{};
#pragma unroll 4
        for (int i = 0; i < 16; ++i) { const int s = 16 * w + i;
            const bf16x8 bfr_ = *(const bf16x8*)(arow + (size_t)(s >> 2) * ACT_COLS + 16 * (s & 3));
#pragma unroll
            for (int nb = 0; nb < 4; ++nb) { const bf16x8 af = *(const bf16x8*)(wrow + (size_t)nb * 32 * 2048 + 16 * s); acc[nb] = __builtin_amdgcn_mfma_f32_32x32x16_bf16(af, bfr_, acc[nb], 0, 0, 0); } }
#pragma unroll
        for (int nb = 0; nb < 4; ++nb)
#pragma unroll
            for (int r = 0; r < 16; ++r) part[((w * 4 + nb) * 16 + r) * 64 + lane] = acc[nb][r];
    }
    __syncthreads();
    f32x16 acc2[2]; acc2[0] = f32x16{}; acc2[1] = f32x16{};
    {
        const int nb = w >> 1, s2 = w & 1; float x[8];
#pragma unroll
        for (int j = 0; j < 8; ++j) { const int r = 8 * s2 + j; float a = 0.f;
#pragma unroll
            for (int p = 0; p < 8; ++p) a += part[((p * 4 + nb) * 16 + r) * 64 + lane];
            a += bias1[kv * CMP_HIDDEN + 32 * nb + crow(r, hi)];
            const float uu = 0.7978845608028654f * (a + 0.044715f * a * a * a); x[j] = 0.5f * a * (1.f + tanhf(uu)); }
        const att::u32x4 xb = {cvtpk(x[0], x[1]), cvtpk(x[2], x[3]), cvtpk(x[4], x[5]), cvtpk(x[6], x[7])};
#pragma unroll
        for (int db = 0; db < 2; ++db) { const bf16* wp = w2t + ((size_t)kv * 64 + 32 * db + r32) * CMP_HIDDEN + 32 * nb + 16 * s2 + 4 * hi;
            const att::u32x2 lo = *(const att::u32x2*)wp, hh = *(const att::u32x2*)(wp + 8);
            const att::u32x4 af = {lo[0], lo[1], hh[0], hh[1]};
            acc2[db] = __builtin_amdgcn_mfma_f32_32x32x16_bf16(__builtin_bit_cast(bf16x8, af), __builtin_bit_cast(bf16x8, xb), acc2[db], 0, 0, 0); }
    }
    __syncthreads();
#pragma unroll
    for (int db = 0; db < 2; ++db)
#pragma unroll
        for (int r = 0; r < 16; ++r) part[((w * 2 + db) * 16 + r) * 64 + lane] = acc2[db][r];
    __syncthreads();
#pragma unroll
    for (int i = 0; i < 4; ++i) { const int e = tid + i * NT;
        const int ln = e & 63, r = (e >> 6) & 15, db = e >> 10; float a = 0.f;
#pragma unroll
        for (int p = 0; p < 8; ++p) a += part[((p * 2 + db) * 16 + r) * 64 + ln];
        const int c2 = cb * 32 + (ln & 31), d = 32 * db + crow(r, ln >> 5);
        const float v = c2 < N_C ? a : 0.f;
        kcb[(((size_t)kv * BATCH + b) * 128 + c2) * 128 + g * 64 + d] = (bf16)f2bf(v);
        if (kcf && c2 < N_C) kcf[(size_t)kv * BATCH * N_C * 128 + ((size_t)(b * N_C + c2) * 2 + g) * 64 + d] = bfr(v); }
    __syncthreads();
}
}

namespace att {
constexpr int N_SLAB = 65536, N_OUT = 65536, N_WSF = 135168, N_ROWSQ = 137216, N_SEL = 138240, N_IMPF = 139264;
struct KvStage { u32x4 k[2], v[2]; };
__device__ __forceinline__ void kv_load(KvStage& st, const bf16* __restrict__ kbase, const bf16* __restrict__ vbase, int pitch, int key0, int w, int lane) {
    const bf16* kp = kbase + (size_t)(key0 + lane) * pitch + 8 * w; const bf16* vp = vbase + (size_t)(key0 + 16 * (w & 3) + (lane >> 2)) * pitch + 32 * (w >> 2) + 8 * (lane & 3);
    st.k[0] = *(const u32x4*)kp; st.k[1] = *(const u32x4*)(kp + 64); st.v[0] = *(const u32x4*)vp; st.v[1] = *(const u32x4*)(vp + 64);
}
__device__ __forceinline__ void kv_store(const KvStage& st, LAS unsigned char* slot, int w, int lane) {
    LAS unsigned char* d = slot + w * 1024 + lane * 16;
    *(LAS u32x4*)d = st.k[0]; *(LAS u32x4*)(d + 8192) = st.k[1]; *(LAS u32x4*)(d + 16384) = st.v[0]; *(LAS u32x4*)(d + 24576) = st.v[1];
}
__device__ __forceinline__ void pack_p(u32x4 (&pw)[4], const f32x16& p0, const f32x16& p1) {
    pw[0] = u32x4{cvtpk(p0[0], p0[1]), cvtpk(p0[2], p0[3]), cvtpk(p0[4], p0[5]), cvtpk(p0[6], p0[7])};
    pw[1] = u32x4{cvtpk(p0[8], p0[9]), cvtpk(p0[10], p0[11]), cvtpk(p0[12], p0[13]), cvtpk(p0[14], p0[15])};
    pw[2] = u32x4{cvtpk(p1[0], p1[1]), cvtpk(p1[2], p1[3]), cvtpk(p1[4], p1[5]), cvtpk(p1[6], p1[7])};
    pw[3] = u32x4{cvtpk(p1[8], p1[9]), cvtpk(p1[10], p1[11]), cvtpk(p1[12], p1[13]), cvtpk(p1[14], p1[15])};
}
template <bool FIRST> __device__ __forceinline__ void accum_out(LAS float* OUTw, const f32x16* o, float fac, LAS float* wsf, int r32, int hi) {
    if (hi == 0) wsf[r32] = fac;
#pragma unroll
    for (int r = 0; r < 16; ++r) { const int q = crow(r, hi); const float f = wsf[q];
        if (FIRST) { OUTw[q * 64 + r32] = f * o[0][r]; OUTw[q * 64 + 32 + r32] = f * o[1][r]; }
        else { OUTw[q * 64 + r32] += f * o[0][r]; OUTw[q * 64 + 32 + r32] += f * o[1][r]; } }
}
__device__ __forceinline__ void nsa_unit(LAS unsigned char* L, const bf16* __restrict__ act, const bf16* __restrict__ kcb, const float* __restrict__ mix_gain, bf16* __restrict__ mixed, int b, int qt,
                                         bool pre_valid  , volatile LAS unsigned* nextp  , bool& prefetched) {
    int tid = threadIdx.x; asm volatile("" : "+v"(tid));
    const int lane = tid & 63, r32 = lane & 31, hi = lane >> 5; const int w = __builtin_amdgcn_readfirstlane(tid >> 6); const int g = w >> 2;
    LAS float* slab = (LAS float*)(L + N_SLAB); LAS float* OUTw = (LAS float*)(L + N_OUT) + w * 2048; LAS float* wsf = (LAS float*)(L + N_WSF) + w * 64;
    LAS float* rowsq = (LAS float*)(L + N_ROWSQ); LAS unsigned* selmask = (LAS unsigned*)(L + N_SEL); LAS float* impf = (LAS float*)(L + N_IMPF);
    const int tq = qt * 32 + r32; const size_t rowq = (size_t)b * SEQ + tq; const bf16* ab = act + (size_t)b * SEQ * ACT_COLS;
    bf16x8 qf[4];
    { const bf16* qp = act + rowq * ACT_COLS + C_NQ + w * 64 + 8 * hi;
#pragma unroll
      for (int d0 = 0; d0 < 4; ++d0) qf[d0] = *(const bf16x8*)(qp + d0 * 16); }
    const bf16* gp = act + rowq * ACT_COLS + C_NG + w * 3;
    const float gate0 = bf2f(gp[0]);
    LAS unsigned char* slot0 = L; LAS unsigned char* slot1 = L + 32768;
    f32x16 o[2];
    struct NsaStg { const bf16* kbase; const bf16* vbase; const bf16* kafter; const bf16* vafter; int key_after; LAS unsigned char* slot0; int w, lane; KvStage st;
        __device__ __forceinline__ void load(int t) { kv_load(st, kbase, vbase, ACT_COLS, t * 64, w, lane); }
        __device__ __forceinline__ void store(int bsel) { kv_store(st, slot0 + bsel * 32768, w, lane); }
        __device__ __forceinline__ void load_after() { if (kafter) kv_load(st, kafter, vafter, ACT_COLS, key_after, w, lane); } };
    NsaStg sg; sg.slot0 = slot0; sg.w = w; sg.lane = lane;
    TIC(13);
    {
        const bf16* kc = kcb + (size_t)b * 128 * 128; const bf16* vc = kcb + (size_t)(BATCH + b) * 128 * 128;
        if (!pre_valid) { KvStage a0, a1; kv_load(a0, kc, vc, 128, 0, w, lane); kv_load(a1, kc, vc, 128, 64, w, lane); kv_store(a0, slot0, w, lane); kv_store(a1, slot1, w, lane); }
        __syncthreads();
        kv_load(sg.st, ab + C_KSL, ab + C_VSL, ACT_COLS, 0, w, lane);
        f32x16 p[4];
        p[0] = f32x16{}; p[1] = f32x16{}; p[2] = f32x16{}; p[3] = f32x16{};
        qkt(p[0], p[1], slot0 + g * 8192, qf, r32, hi); qkt(p[2], p[3], slot1 + g * 8192, qf, r32, hi);
        const int n_adm = tq >= 31 ? min((tq - 31) / 16 + 1, N_C) : 0;
        float rm = NEG_INF;
#pragma unroll
        for (int u = 0; u < 4; ++u)
#pragma unroll
            for (int r = 0; r < 16; ++r) { const int c = 32 * u + crow(r, hi); p[u][r] = c < n_adm ? p[u][r] : NEG_INF; rm = fmaxf(rm, p[u][r]); }
        rm = fmaxf(rm, __shfl_xor(rm, 32));
        const float mc = rm > NEG_INF ? rm : 0.f; float s = 0.f;
#pragma unroll
        for (int u = 0; u < 4; ++u)
#pragma unroll
            for (int r = 0; r < 16; ++r) { p[u][r] = ex2(p[u][r] - mc); s += p[u][r]; }
        s += __shfl_xor(s, 32);
        const float inv = 1.f / fmaxf(s, 1e-30f);
#pragma unroll
        for (int u = 0; u < 4; ++u)
#pragma unroll
            for (int r = 0; r < 16; ++r) p[u][r] *= inv;
        float xl[16];
#pragma unroll
        for (int u = 0; u < 4; ++u)
#pragma unroll
            for (int k = 0; k < 4; ++k) xl[u * 4 + k] = __shfl_xor(p[u][4 * k + 3], 32);
#pragma unroll
        for (int u = 0; u < 4; ++u)
#pragma unroll
            for (int k = 0; k < 4; ++k) {
                const float A = (p[u][4 * k] + p[u][4 * k + 1]) + (p[u][4 * k + 2] + p[u][4 * k + 3]);
                const float xprev = (u * 4 + k) > 0 ? xl[(u * 4 + k) > 0 ? u * 4 + k - 1 : 0] : 0.f;
                const float val = A + (hi ? xl[u * 4 + k] : xprev);
                slab[(w * 32 + r32) * 32 + 8 * u + 2 * k + hi] = val;
            }
        u32x4 pw[4]; o[0] = f32x16{}; o[1] = f32x16{};
        pack_p(pw, p[0], p[1]); pv(o, slot0 + 16384 + g * 8192, lane, hi, pw);
        pack_p(pw, p[2], p[3]); pv(o, slot1 + 16384 + g * 8192, lane, hi, pw);
        __syncthreads();
#pragma unroll
        for (int i = 0; i < 4; ++i) { const int e = tid + i * NT, j = e & 31, q = (e >> 5) & 31, gg = e >> 10;
            float v = ((slab[((gg * 4 + 0) * 32 + q) * 32 + j] + slab[((gg * 4 + 1) * 32 + q) * 32 + j]) + slab[((gg * 4 + 2) * 32 + q) * 32 + j]) + slab[((gg * 4 + 3) * 32 + q) * 32 + j];
            const int cur = (qt * 32 + q) >> 6;
            if (j == 0 || j == cur || j == cur - 1) v = 1.0e4f;
            if (j > cur) v = -1.0f;
            impf[e] = v; }
        __syncthreads();
#pragma unroll
        for (int i = 0; i < 4; ++i) { const int gq = i * 16 + (tid >> 5), j = tid & 31; const float v = impf[gq * 32 + j]; int rk = 0;
#pragma unroll
            for (int i2 = 0; i2 < 32; ++i2) { const float vi = impf[gq * 32 + i2]; rk += (vi > v || (vi == v && i2 < j)) ? 1 : 0; }
            const unsigned long long bal = __ballot(rk < SLC_COUNT);
            if ((tid & 31) == 0) selmask[gq] = (lane < 32) ? (unsigned)bal : (unsigned)(bal >> 32); }
        __syncthreads();
        accum_out<true>(OUTw, o, gate0, wsf, r32, hi);
    }
    TOC(13); TIC(14);
    const int T0 = (qt * 32 - 511) > 0 ? ((qt * 32 - 511) >> 6) : 0, T1 = qt >> 1;
    {
        struct SlcMask { unsigned sel; int tq, hi, last;
            __device__ __forceinline__ void operator()(f32x16& c0, f32x16& c1, int t, float negm) const { cinit_splat(c0, negm); cinit_splat(c1, negm); }
            __device__ __forceinline__ void post(f32x16& p0, f32x16& p1, int t) const { const bool on = (sel >> t) & 1u;
                if (t == last) { const int lim = on ? tq - t * 64 - 4 * hi : -1;
#pragma unroll
                    for (int r = 0; r < 16; ++r) { p0[r] = (crow(r, 0) <= lim) ? p0[r] : NEG_INF; p1[r] = (crow(r, 0) + 32 <= lim) ? p1[r] : NEG_INF; }
                } else {
#pragma unroll
                    for (int r = 0; r < 16; ++r) { p0[r] = on ? p0[r] : NEG_INF; p1[r] = on ? p1[r] : NEG_INF; }
                } } };
        const int ntile = (qt >> 1) + 1;
        sg.kbase = ab + C_KSL; sg.vbase = ab + C_VSL; sg.kafter = ab + C_KWN; sg.vafter = ab + C_VWN; sg.key_after = T0 * 64;
        SlcMask mk{selmask[g * 32 + r32], tq, hi, ntile - 1}; const float gate1 = bf2f(gp[1]);
        float m = 0.f, l = 0.f; o[0] = f32x16{}; o[1] = f32x16{};
        flash_loop_b(0, ntile, sg, mk, qf, slot0 + g * 8192, slot0 + 16384 + g * 8192, 32768, m, l, o, wsf, lane, r32, hi, true);
        const float ltot = l + __shfl_xor(l, 32);
        accum_out<false>(OUTw, o, gate1 / fmaxf(ltot, 1e-30f), wsf, r32, hi);
    }
    TOC(14); TIC(15);
    {
        struct WinMask { int tq, hi, qt;
            __device__ __forceinline__ void operator()(f32x16& c0, f32x16& c1, int t, float negm) const { cinit_splat(c0, negm); cinit_splat(c1, negm); }
            __device__ __forceinline__ void post(f32x16& p0, f32x16& p1, int t) const {
                if (t * 64 < qt * 32 - 480 || t * 64 + 63 > qt * 32) { const int lim = tq - t * 64 - 4 * hi;
#pragma unroll
                    for (int r = 0; r < 16; ++r) {
                        p0[r] = ((unsigned)(lim - crow(r, 0)) < (unsigned)WINDOW) ? p0[r] : NEG_INF; p1[r] = ((unsigned)(lim - crow(r, 0) - 32) < (unsigned)WINDOW) ? p1[r] : NEG_INF; }
                } } };
        sg.kbase = ab + C_KWN; sg.vbase = ab + C_VWN; sg.kafter = nullptr; sg.vafter = nullptr;
        WinMask mk{tq, hi, qt}; const float gate2 = bf2f(gp[2]);
        float m = 0.f, l = 0.f; o[0] = f32x16{}; o[1] = f32x16{};
        flash_loop_b(T0, T1 - T0 + 1, sg, mk, qf, slot0 + g * 8192, slot0 + 16384 + g * 8192, 32768, m, l, o, wsf, lane, r32, hi, true);
        const float ltot = l + __shfl_xor(l, 32);
        accum_out<false>(OUTw, o, gate2 / fmaxf(ltot, 1e-30f), wsf, r32, hi);
    }
    KvStage pre0, pre1;
    {
        const unsigned rn = (unsigned)__builtin_amdgcn_readfirstlane((int)*nextp); const int next_b = (rn < 2048u && (rn & 255u) >= 128u) ? (int)(2u * (rn >> 8) + (rn & 1u)) : -1;
        prefetched = next_b >= 0;
        if (next_b >= 0) { const bf16* kcn = kcb + (size_t)next_b * 128 * 128; const bf16* vcn = kcb + (size_t)(BATCH + next_b) * 128 * 128;
            kv_load(pre0, kcn, vcn, 128, 0, w, lane); kv_load(pre1, kcn, vcn, 128, 64, w, lane); }
    }
    TOC(15); TIC(16);
    float ss = 0.f;
    { const LAS f32x4* rowp = (const LAS f32x4*)(OUTw + (lane >> 1) * 64 + (lane & 1) * 32);
#pragma unroll
      for (int i = 0; i < 8; ++i) { const f32x4 v = rowp[i]; ss += (v[0] * v[0] + v[1] * v[1]) + (v[2] * v[2] + v[3] * v[3]); }
      ss += __shfl_xor(ss, 1); }
    if ((lane & 1) == 0) rowsq[w * 32 + (lane >> 1)] = ss;
    if (prefetched) { kv_store(pre0, slot0, w, lane); kv_store(pre1, slot1, w, lane); }
    __syncthreads();
    float tot = 0.f;
#pragma unroll
    for (int h = 0; h < 8; ++h) tot += rowsq[h * 32 + (lane >> 1)];
    const float rinv = rsqrtf(tot * (1.f / 512.f) + LN_EPS);
    store_o(OUTw, rinv, mix_gain + 512 + w * 64, MIXED_F8 ? (bf16*)((unsigned char*)mixed + ((size_t)b * SEQ + qt * 32 + (lane >> 1)) * D_MODEL + 512 + w * 64) : mixed + ((size_t)b * SEQ + qt * 32 + (lane >> 1)) * D_MODEL + 512 + w * 64, lane);
    __syncthreads();
    TOC(16);
}
}
struct Args { const float* in[16]; float* out; unsigned char* ws; int ph_lo, ph_hi, li, pad; };
constexpr int N_PHASES = 8;
__global__ void __launch_bounds__(NT, 2) mk_fwd(Args args) {
    extern __shared__ __attribute__((aligned(16))) unsigned char lds_raw[];
    LAS unsigned char* lds = (LAS unsigned char*)lds_raw;
    volatile LAS unsigned* MISC = (volatile LAS unsigned*)(lds + MISC_OFF);
    const int tid = threadIdx.x, lane = tid & 63, wave = __builtin_amdgcn_readfirstlane(tid >> 6);
    const int G = gridDim.x; const int vcu = (G % 8 == 0) ? ((int)blockIdx.x % 8) * (G / 8) + (int)blockIdx.x / 8 : (int)blockIdx.x;
    unsigned char* ws = args.ws;
    gu32* ctl = (gu32*)(ws + WS_CTL);
    const float* x = args.in[0]; const int* pos = (const int*)args.in[1]; const float* w_in = args.in[2]; const float* b_in = args.in[3];
    const float* cmp_pos = args.in[4]; const float* cmp_w1 = args.in[5]; const float* cmp_w2 = args.in[6]; const float* mix_gain = args.in[7];
    const float* w_out = args.in[8]; const float* ln1_g = args.in[9]; const float* ln1_b = args.in[10]; const float* w_gate = args.in[11];
    const float* w_up = args.in[12]; const float* w_down = args.in[13]; const float* ln2_g = args.in[14]; const float* ln2_b = args.in[15];
    float* out = args.out;
    float* stats1 = (float*)(ws + CTL_STATS1); float* cs = (float*)(ws + CTL_CS); float* bs = cs + 5632;
    float* rope = (float*)(ws + WS_ROPE); float* biasP = (float*)(ws + WS_BIASP);
    bf16* Wt_in = (bf16*)(ws + WS_WIN); bf16* Wt_out = (bf16*)(ws + WS_WOUT); bf16* Wt_gu = (bf16*)(ws + WS_WGU); bf16* Wt_dn = (bf16*)(ws + WS_WDN);
    float* kcvc = (float*)(ws + WS_KC); bf16* kcb = (bf16*)(ws + WS_KCB); bf16* w1t = (bf16*)(ws + WS_W1T); bf16* w2t = (bf16*)(ws + WS_W2T); float* cb1 = (float*)(ws + CTL_CB1);
    bf16* act = (bf16*)(ws + WS_ACT); bf16* actf = (bf16*)(ws + WS_ACTF); bf16* xb = (bf16*)(ws + WS_XB); bf16* mixed = (bf16*)(ws + WS_MIXED); unsigned char* v1q = ws + WS_GCAND; unsigned char* actq = ws + WS_ACTF; unsigned char* xq = ws + WS_V1B; unsigned char* Wq_in = ws + WS_WINQ;
    bf16* v1b = (bf16*)(ws + WS_V1B); bf16* v2b = (bf16*)(ws + WS_MIXED);

    for (int u = tid; u < (LDS_BYTES - LDSCTL_OFF) / 4; u += NT) ((LAS unsigned*)(lds + LDSCTL_OFF))[u] = 0u;
    __syncthreads();
#if PROBE_T >= 0
    if (blockIdx.x == 0 && tid == 0) t_acc = 0ull;
#endif
    XcdBarrier bar = xcd_barrier_post((unsigned*)(ctl + CW_BAR) + args.li * XCD_BAR_WORDS, MISC + 8);
    const int lo = args.ph_lo, hi = args.ph_hi;
#ifndef PROBE_DUP
#define PROBE_DUP -1
#endif
#define NREP(k) ((PROBE_DUP == (k)) ? 2 : 1)
#define IN(k) (lo <= (k) && (k) < hi)
#define SEAM(k) do { if (IN(k) && IN((k) + 1)) { TIC(8); TIC(60 + (k)); xcd_barrier(bar); TOC(60 + (k)); TOC(8); } } while (0)

    TIC(0);
    if (IN(0)) for (int rep = 0; rep < NREP(0); ++rep) {
        float* cs_ = (rep == NREP(0) - 1) ? cs : nullptr;
        const int gw = vcu * NWAVES + wave, NGW = G * NWAVES;
        constexpr int I_IN = 16 * 36, I_OUT = 16 * 16, I_GU = 16 * 88, I_DN = 44 * 16, I_W1 = 2 * 64, I_W2 = 2 * 2, I_INQ = INPROJ_F8 ? 16 * 16 : 0, NITEMS = I_IN + I_OUT + I_GU + I_DN + I_W1 + I_W2 + I_INQ;
        TIC(30);
        for (int it = gw; it < NITEMS; it += NGW) {
            int r = it;
            if (r < I_GU) { const int kb = r / 88, nb = r % 88, n0 = 64 * nb, pn = n0 >> 8, within = n0 & 255; const bool isup = within >= 128;
                tr64<true>(isup ? w_up : w_gate, FFN, 1024, Wt_gu, n0, 64 * kb, pn * 128 + (within & 127) + lane, ln1_g, S_GU, ln1_b, cs_, cs_ ? bs : nullptr, lane); continue; } r -= I_GU;
            if (r < I_DN) { const int kb = r / 16, nb = r % 16; tr64<true>(w_down, 1024, FFN, Wt_dn, 64 * nb, 64 * kb, 64 * nb + lane, nullptr, S_DN, nullptr, nullptr, nullptr, lane); continue; } r -= I_DN;
            if (r < I_IN) { const int kb = r / 36, nb = r % 36; tr64<false>(w_in, IN_COLS, 1024, Wt_in, 64 * nb, 64 * kb, orig_col(64 * nb + lane), nullptr, 1.f, nullptr, nullptr, nullptr, lane); continue; } r -= I_IN;
            if (r < I_OUT) { const int kb = r / 16, nb = r % 16; if (MIXED_F8) tr64<true>(w_out, 1024, 1024, Wt_out, 64 * nb, 64 * kb, 64 * nb + lane, nullptr, S_OUT, nullptr, nullptr, nullptr, lane); else tr64<false>(w_out, 1024, 1024, Wt_out, 64 * nb, 64 * kb, 64 * nb + lane, nullptr, 1.f, nullptr, nullptr, nullptr, lane); continue; } r -= I_OUT;
            if (r < I_W1) { const int kv = r >> 6, kb = (r >> 1) & 31, nb = r & 1;
                tr64<false>(cmp_w1 + (size_t)kv * 2048 * 128, 128, 2048, w1t + (size_t)kv * 128 * 2048, 64 * nb, 64 * kb, 64 * nb + lane, nullptr, 1.f, cmp_pos + kv * 2048, nullptr, cs_ ? cb1 + kv * 128 : nullptr, lane); continue; } r -= I_W1;
            if (r < I_W2) { const int kv = r >> 1, kb = r & 1; tr64<false>(cmp_w2 + (size_t)kv * 128 * 64, 64, 128, w2t + (size_t)kv * 64 * 128, 0, 64 * kb, lane, nullptr, 1.f, nullptr, nullptr, nullptr, lane); continue; } r -= I_W2;
            { const int kb = r >> 4, nq = r & 15, tile = (nq >> 2) < 2 ? (nq >> 2) : (nq >> 2) + 4, n0 = tile * 256 + 64 * (nq & 3);
              tr64<true>(w_in, IN_COLS, 1024, Wq_in, n0, 64 * kb, orig_col(n0 + lane), nullptr, S_IN, nullptr, nullptr, nullptr, lane); }
        }
        TOC(30); TIC(31);
        for (int m0 = gw * 4; m0 < T; m0 += NGW * 4) {
            f32x4 v[4][2][2];
#pragma unroll
            for (int rr = 0; rr < 4; ++rr)
#pragma unroll
                for (int j = 0; j < 2; ++j) { const GAS f32x4* xr = (const GAS f32x4*)(x + (size_t)(m0 + rr) * 1024 + 512 * j) + 2 * lane; v[rr][j][0] = xr[0]; v[rr][j][1] = xr[1]; }
#pragma unroll
            for (int rr = 0; rr < 4; ++rr)
#pragma unroll
                for (int j = 0; j < 2; ++j) { v4u o; o.x = pk2(v[rr][j][0].x, v[rr][j][0].y); o.y = pk2(v[rr][j][0].z, v[rr][j][0].w); o.z = pk2(v[rr][j][1].x, v[rr][j][1].y); o.w = pk2(v[rr][j][1].z, v[rr][j][1].w);
                    *((GAS v4u*)(xb + (size_t)(m0 + rr) * 1024 + 512 * j) + lane) = o;
                    if (INPROJ_F8) { typedef unsigned u2_t __attribute__((ext_vector_type(2)));
                        int p0 = __builtin_amdgcn_cvt_pk_fp8_f32(v[rr][j][0].x, v[rr][j][0].y, 0, false); p0 = __builtin_amdgcn_cvt_pk_fp8_f32(v[rr][j][0].z, v[rr][j][0].w, p0, true);
                        int p1 = __builtin_amdgcn_cvt_pk_fp8_f32(v[rr][j][1].x, v[rr][j][1].y, 0, false); p1 = __builtin_amdgcn_cvt_pk_fp8_f32(v[rr][j][1].z, v[rr][j][1].w, p1, true);
                        *((GAS u2_t*)(xq + (size_t)(m0 + rr) * 1024 + 512 * j) + lane) = u2_t{(unsigned)p0, (unsigned)p1}; } }
        }
        TOC(31); TIC(32);
        for (int i = gw * 64 + lane; i < T * 8; i += NGW * 64) {
            const float inv[8] = {1.0f, 0.19392274474868576f, 0.03760603093086393f, 0.007292664737217109f, 0.001414213562373095f, 0.0002742481756762073f, 5.318295896944988e-05f, 1.031338537721246e-05f};
            const int t = i >> 3, j = i & 7; float sn, cn; sincosf((float)pos[t] * inv[j], &sn, &cn);
            rope[2 * i] = cn; rope[2 * i + 1] = sn;
        }
        for (int i = gw * 64 + lane; i < ACT_COLS; i += NGW * 64) { const int oc = orig_col(i); biasP[i] = oc >= 0 ? b_in[oc] : 0.f; }
        TOC(32);
    }
    TOC(0);
    SEAM(0);
    TIC(1);
    if (IN(1)) for (int rep = 0; rep < NREP(1); ++rep) {
        if constexpr (INPROJ_F8) {
            { pg8::Gemm g{xb, Wt_in, T, ACT_COLS, 1024}; pg8::SubOrderB S; S.init(T, G, (int)blockIdx.x);
              pg8::EpiInProj E{act, biasP, rope, att::C2, 1.f};
              pg8::gemm_phase<pg8::EpiInProj, pg8::SubOrderB, true, true>(lds, g, S, E); }
            { pg8::Gemm g{(const bf16*)xq, (const bf16*)Wq_in, T, ACT_COLS, 1024}; pg8::SubOrderQ S{G, (int)blockIdx.x};
              pg8::EpiInProj E{act, biasP, rope, att::C2, 1.f / S_IN};
              pg8::gemm_phase<pg8::EpiInProj, pg8::SubOrderQ, true, true, true>(lds, g, S, E); }
        } else {
            pg8::Gemm g{xb, Wt_in, T, ACT_COLS, 1024}; pg8::StaticOrder S; S.init(T, ACT_COLS, G, (int)blockIdx.x);
            pg8::EpiInProj E{act, biasP, rope, att::C2, 1.f};
            pg8::gemm_phase<pg8::EpiInProj, pg8::StaticOrder, true, true>(lds, g, S, E);
        }
    }
    TOC(1);
    SEAM(1);
#if PROBE_T == 50
    unsigned long long sp_t0 = __builtin_amdgcn_s_memrealtime();
#endif
    TIC(2);
    if (IN(2)) for (int rep = 0; rep < NREP(2); ++rep) {
        gu32* cmp_cnt = ctl + 8192;
        TIC(10);
        for (int u = vcu; u < 256; u += G) { cmp::compress_unit(lds, act, w1t, w2t, cb1, kcb, nullptr, u);
            asm volatile("s_waitcnt vmcnt(0)" ::: "memory"); __syncthreads();
            if (tid == 0 && rep == NREP(2) - 1) { __builtin_amdgcn_fence(__ATOMIC_RELEASE, "agent"); asm volatile("s_waitcnt vmcnt(0)" ::: "memory"); __hip_atomic_fetch_add(cmp_cnt, 1u, RLX_AGENT); } }
        TOC(10);
        att::DsaCand* gcand = (att::DsaCand*)(ws + WS_GCAND) + (size_t)blockIdx.x * 32 * SEQ;
        float* gidx = (float*)(ws + WS_V1B) + (size_t)blockIdx.x * 65536;
        gu32* qhead = ctl + 8320;
        unsigned curq = bar.x & 7u;
#define DRAW_UNIT(dst) do { unsigned u_ = 0xFFFFFFFFu; for (int t_ = 0; t_ < 8; ++t_) { const unsigned r_ = __hip_atomic_fetch_add(qhead + 64 * curq, 1u, RLX_AGENT); if (r_ < 256u) { u_ = curq * 256u + r_; break; } curq = (curq + 1u) & 7u; } (dst) = u_; } while (0)
        if (tid == 0) DRAW_UNIT(MISC[12]);
        __syncthreads();
        bool cmp_ok = false;
        for (int k = 0;;) {
            unsigned u = (unsigned)__builtin_amdgcn_readfirstlane((int)MISC[12 + (k & 1)]);
            if (u >= 2048u) break;
            if (tid == 0) DRAW_UNIT(MISC[12 + ((k + 1) & 1)]);
            if ((u & 255u) < 128u) { att::dsa_unit(lds, act, mix_gain, mixed, gcand, gidx, (int)(2u * (u >> 8) + (u & 1u)), 63 - (int)((u & 127u) >> 1)); ++k; continue; }
            if (!cmp_ok) {
                if (tid == 0) { unsigned sp = 0; while (__hip_atomic_load(cmp_cnt, RLX_AGENT) < 256u) { __builtin_amdgcn_s_sleep(2); if (++sp > (1u << 22)) break; }
                    __builtin_amdgcn_fence(__ATOMIC_ACQUIRE, "agent"); asm volatile("s_waitcnt vmcnt(0)" ::: "memory"); }
                __syncthreads(); cmp_ok = true; }
            bool pre_valid = false;
            for (;;) {
                bool pf = false; att::nsa_unit(lds, act, kcb, mix_gain, mixed, (int)(2u * (u >> 8) + (u & 1u)), 63 - (int)((u & 127u) >> 1), pre_valid, MISC + 12 + ((k + 1) & 1), pf);
                ++k;
                if (!pf) break;
                u = (unsigned)__builtin_amdgcn_readfirstlane((int)MISC[12 + (k & 1)]); pre_valid = true;
                if (tid == 0) DRAW_UNIT(MISC[12 + ((k + 1) & 1)]);
            }
        }
#undef DRAW_UNIT
    }
    TOC(2);
#if PROBE_T == 50
    if (tid == 0) { const unsigned long long d = __builtin_amdgcn_s_memrealtime() - sp_t0; atomicMax((unsigned long long*)(ctl + 8200), d); atomicMax((unsigned long long*)(ctl + 8202), 1000000000ull - d); }
#endif
    SEAM(3);
    TIC(4);
    if (IN(4)) for (int rep = 0; rep < NREP(4); ++rep) {
        pg8::Gemm g{mixed, Wt_out, T, 1024, 1024}; pg8::StaticOrder S; S.init(T, 1024, G, (int)blockIdx.x);
        pg8::EpiOutProj E{xb, v1b, v1q, (rep == NREP(4) - 1) ? stats1 : nullptr, ALPHA, MIXED_F8 ? 1.f / S_OUT : 1.f};
        if constexpr (MIXED_F8) pg8::gemm_phase<pg8::EpiOutProj, pg8::StaticOrder, true, true, true>(lds, g, S, E); else pg8::gemm_phase<pg8::EpiOutProj, pg8::StaticOrder, true, true>(lds, g, S, E);
    }
    TOC(4);
    SEAM(4);
    TIC(5);
    if (IN(5)) for (int rep = 0; rep < NREP(5); ++rep) {
        pg8::Gemm g{(const bf16*)v1q, Wt_gu, T, 2 * FFN, 1024}; pg8::StaticOrder S; S.init(T, 2 * FFN, G, (int)blockIdx.x);
        pg8::EpiGateUp E{actf, actq, stats1, cs, bs, 1.f / S_GU};
        pg8::gemm_phase<pg8::EpiGateUp, pg8::StaticOrder, true, true, true>(lds, g, S, E);
    }
    TOC(5);
#if PROBE_T == 40
    { xcd_barrier(bar); TIC(40);
      pg8::Gemm g{(const bf16*)v1q, Wt_gu, T, 2 * FFN, 1024}; pg8::StaticOrder S; S.init(T, 2 * FFN, G, (int)blockIdx.x);
      pg8::EpiNull E{(float*)(ws + WS_MIXED)};
      pg8::gemm_phase<pg8::EpiNull, pg8::StaticOrder, true, true, true>(lds, g, S, E); TOC(40); }
#endif
    SEAM(5);
    TIC(6);
    if (IN(6)) for (int rep = 0; rep < NREP(6); ++rep) {
        pg8::Gemm g{(const bf16*)actq, Wt_dn, T, 1024, FFN}; pg8::StaticOrder S; S.init(T, 1024, G, (int)blockIdx.x);
#ifdef NO_LN2_FUSE
        pg8::EpiDown E{v1b, v2b, stats1, ln1_g, ln1_b, ALPHA, 1.f / S_DN};
        pg8::gemm_phase<pg8::EpiDown, pg8::StaticOrder, true, true, true>(lds, g, S, E);
#else
        pg8::RowStatsX rx{(unsigned long long*)(ws + WS_XCH), (unsigned*)(ctl + 16384), lds + 135168, LN_EPS};
        pg8::EpiDownLn E{v1b, out, stats1, ln1_g, ln1_b, ln2_g, ln2_b, ALPHA, 1.f / S_DN, rx};
        pg8::gemm_phase<pg8::EpiDownLn, pg8::StaticOrder, true, true, true>(lds, g, S, E);
#endif
    }
    TOC(6);
#ifdef NO_LN2_FUSE
    SEAM(6);
#endif
    TIC(7);
#ifdef NO_LN2_FUSE
    if (IN(7)) for (int rep = 0; rep < NREP(7); ++rep) {
        const int gw = vcu * NWAVES + wave, NGW = G * NWAVES;
        for (int m = gw; m < T; m += NGW) {
            const GAS v4u* xr = (const GAS v4u*)(v2b + (size_t)m * 1024) + lane; GAS f32x4* xw = (GAS f32x4*)(out + (size_t)m * 1024) + 2 * lane; f32x4 v[4]; float s = 0.f;
#pragma unroll
            for (int j = 0; j < 2; ++j) { const v4u t = xr[64 * j];
                v[2 * j] = f32x4{__uint_as_float(t[0] << 16), __uint_as_float(t[0] & 0xffff0000u), __uint_as_float(t[1] << 16), __uint_as_float(t[1] & 0xffff0000u)};
                v[2 * j + 1] = f32x4{__uint_as_float(t[2] << 16), __uint_as_float(t[2] & 0xffff0000u), __uint_as_float(t[3] << 16), __uint_as_float(t[3] & 0xffff0000u)}; }
#pragma unroll
            for (int j = 0; j < 4; ++j) s += (v[j].x + v[j].y) + (v[j].z + v[j].w);
            const float mean = wave_sum(s) * (1.f / 1024.f); float s2 = 0.f;
#pragma unroll
            for (int j = 0; j < 4; ++j) { v[j] = v[j] - mean; s2 += (v[j].x * v[j].x + v[j].y * v[j].y) + (v[j].z * v[j].z + v[j].w * v[j].w); }
            const float rstd = rsqrtf(wave_sum(s2) * (1.f / 1024.f) + LN_EPS);
#pragma unroll
            for (int j = 0; j < 4; ++j) { const int ci = 2 * lane + (j & 1) + 128 * (j >> 1);
                const f32x4 gg = *((const f32x4*)ln2_g + ci), bb = *((const f32x4*)ln2_b + ci); xw[(j & 1) + 128 * (j >> 1)] = v[j] * rstd * gg + bb; }
        }
    }
#endif
    TOC(7);
#if PROBE_T == 50
    if (blockIdx.x == 0 && tid == 0) { const unsigned long long mx = __hip_atomic_load((unsigned long long*)(ctl + 8200), RLX_AGENT), mn = 1000000000ull - __hip_atomic_load((unsigned long long*)(ctl + 8202), RLX_AGENT); t_acc = mx - mn; }
#endif
#if PROBE_T >= 0
    if (blockIdx.x == 0 && tid == 0) { const unsigned long long t0 = __builtin_amdgcn_s_memrealtime(); while (__builtin_amdgcn_s_memrealtime() - t0 < t_acc) __builtin_amdgcn_s_sleep(8); }
#endif
#undef IN
#undef SEAM
}

extern "C" void kernel_launch(void* const* d_in, const int* in_sizes, int n_in, void* d_out, int out_size, void* d_ws, size_t ws_size, hipStream_t stream) {
    static int grid = 0;
    if (grid == 0) {
        if (n_in != 16 || in_sizes[0] != T * D_MODEL || out_size != T * D_MODEL || ws_size < WS_NEED) { fprintf(stderr, "kernel_launch: unexpected shapes / workspace (%d inputs, ws %zu); nothing launched\n", n_in, ws_size); grid = -1; return; }
        int dev = 0, cus = 0, per_cu = 0;
        if (hipGetDevice(&dev) != hipSuccess || hipDeviceGetAttribute(&cus, hipDeviceAttributeMultiprocessorCount, dev) != hipSuccess) { grid = -1; return; }
        if (hipFuncSetAttribute((const void*)mk_fwd, hipFuncAttributeMaxDynamicSharedMemorySize, LDS_BYTES) != hipSuccess) { fprintf(stderr, "kernel_launch: hipFuncSetAttribute failed\n"); grid = -1; return; }
        if (hipOccupancyMaxActiveBlocksPerMultiprocessor(&per_cu, (const void*)mk_fwd, NT, LDS_BYTES) != hipSuccess || per_cu < 1) { fprintf(stderr, "kernel_launch: occupancy query says %d blocks per CU; nothing launched\n", per_cu); (void)hipGetLastError(); grid = -1; return; }
        grid = cus;
    }
    if (grid < 0) return;
    if (hipMemsetAsync((char*)d_ws + WS_CTL, 0, CTL_ZERO_BYTES, stream) != hipSuccess) return;
    Args a{};
    for (int i = 0; i < 16; ++i) a.in[i] = (const float*)d_in[i];
    a.out = (float*)d_out; a.ws = (unsigned char*)d_ws;
#if MK_N_LAUNCHES == 1
    a.ph_lo = 0; a.ph_hi = N_PHASES; a.li = 0;
    hipLaunchKernelGGL(mk_fwd, dim3(grid), dim3(NT), LDS_BYTES, stream, a);
#else
    for (int p = 0; p < N_PHASES; ++p) { a.ph_lo = p; a.ph_hi = p + 1; a.li = 0; hipLaunchKernelGGL(mk_fwd, dim3(grid), dim3(NT), LDS_BYTES, stream, a); }
#endif
}
```

```cpp
#include <hip/hip_runtime.h>
#include <cstdio>
#include <cstdint>
#include <cmath>

#ifndef PROBE_DUP
#define PROBE_DUP -1
#endif
#ifndef PROBE_T
#define PROBE_T -1
#endif
#if PROBE_T >= 0
__device__ unsigned long long t_tic, t_acc;
#define TIC(k) do { if (PROBE_T == (k) && blockIdx.x == 0 && threadIdx.x == 0) { t_tic = __builtin_amdgcn_s_memrealtime(); } } while (0)
#define TOC(k) do { if (PROBE_T == (k) && blockIdx.x == 0 && threadIdx.x == 0) { t_acc += __builtin_amdgcn_s_memrealtime() - t_tic; } } while (0)
#else
#define TIC(k) do { } while (0)
#define TOC(k) do { } while (0)
#endif
#ifndef INPROJ_F8
#define INPROJ_F8 1
#endif
#ifndef MIXED_F8
#define MIXED_F8 1
#endif
#ifndef MK_N_LAUNCHES
#define MK_N_LAUNCHES 1
#endif

constexpr int D_MODEL = 1024, BATCH = 16, SEQ = 2048, T = BATCH * SEQ;
constexpr int IDX_TOPK = 256;
constexpr int CMP_BLOCK = 32, CMP_STRIDE = 16, CMP_HIDDEN = 128, N_C = (SEQ - CMP_BLOCK) / CMP_STRIDE + 1;
constexpr int SLC_BLOCK = 64, SLC_COUNT = 8, N_S = SEQ / SLC_BLOCK, WINDOW = 512;
constexpr int FFN = 2816;
constexpr int IN_COLS = 2240, ACT_COLS = 2304;
constexpr float ALPHA = 1.189207115002721f;
constexpr float LN_EPS = 1e-5f;
constexpr float ATT_SCALE = 0.125f;
constexpr float IDX_SCALE = 0.0625f;
constexpr int C_DQ = 0, C_DK = 512, C_DV = 576, C_IQ = 640, C_NQ = 896, C_KCM = 1408, C_VCM = 1536, C_KSL = 1664, C_VSL = 1792,
              C_KWN = 1920, C_VWN = 2048, C_IK = 2176, C_IW = 2208, C_NG = 2216;
__host__ __device__ __forceinline__ int orig_col(int pc) {
    if (pc < 896) return pc;
    if (pc < 1408) return 936 + (pc - 896);
    if (pc < 2176) return 1448 + (pc - 1408);
    if (pc < 2208) return 904 + (pc - 2176);
    if (pc < 2216) return 896 + (pc - 2208);
    if (pc < IN_COLS) return pc;
    return -1;
}
constexpr size_t MiB = 1u << 20;
constexpr size_t WS_CTL = 0, CTL_ZERO_BYTES = 1 * MiB;
constexpr size_t CTL_STATS1 = 256 * 1024;
constexpr size_t CTL_CS = 512 * 1024;
constexpr size_t CTL_CB1 = 600 * 1024;
constexpr size_t WS_ROPE = 1 * MiB;
constexpr size_t WS_BIASP = 3 * MiB;
constexpr size_t WS_WIN = 4 * MiB;
constexpr size_t WS_WOUT = 9 * MiB;
constexpr size_t WS_WGU = 11 * MiB;
constexpr size_t WS_WDN = 22 * MiB;
constexpr size_t WS_W1T = 28 * MiB;
constexpr size_t WS_W2T = 29 * MiB;
constexpr size_t WS_CB1 = 29 * MiB + 512 * 1024;
constexpr size_t WS_KCB = 30 * MiB;
constexpr size_t WS_WINQ = 37 * MiB;
constexpr size_t WS_XCH = 36 * MiB;
constexpr size_t WS_KC = 32 * MiB;
constexpr size_t WS_ACT = 48 * MiB;
constexpr size_t WS_ACTF = 48 * MiB;
constexpr size_t WS_XB = 192 * MiB;
constexpr size_t WS_MIXED = 256 * MiB;
constexpr size_t WS_V1B = 320 * MiB;
constexpr size_t WS_GCAND = 384 * MiB;
constexpr size_t WS_NEED = 512 * MiB;

namespace pg8 {
#define PG8_LAS __attribute__((address_space(3)))
typedef unsigned short bf16_t;
typedef short bf16x8 __attribute__((ext_vector_type(8)));
typedef float f32x4 __attribute__((ext_vector_type(4)));
typedef unsigned u32x4 __attribute__((ext_vector_type(4)));
constexpr int BM = 256, BK = 64, HALF = 128, HTB = HALF * BK * 2  , STAGE_BYTES = 8 * HTB, NXCD = 8, WGM = 8;

__host__ __device__ __forceinline__ int lds_byte(int r, int c) { const int st = (r >> 4) * 2 + (c >> 5), rr = r & 15, cc = c & 31, ob = rr * 64 + cc * 2; return st * 1024 + (ob ^ (((ob >> 9) & 1) << 5)); }
__host__ __device__ __forceinline__ void stage_rc(int b, int& R, int& C) { const int st = b / 1024, sb = b % 1024, swz = sb ^ (((sb >> 9) & 1) << 5); R = (st >> 1) * 16 + swz / 64; C = (st & 1) * 32 + (swz % 64) / 2; }
__host__ __device__ __forceinline__ int perm32(int rho) { const int n = rho >> 4, i = rho & 15; return 8 * (i >> 2) + 4 * n + (i & 3); }

struct Unit { int pm, pn; };
struct Gemm { const bf16_t* A; const bf16_t* Bt; int M, N, K; };

struct StaticOrder {
    int nM, nN, nwg, G, c;
    __host__ __device__ void init(int M, int N, int G_, int c_) { nM = M / BM; nN = N / BM; nwg = nM * nN; G = G_; c = c_; }
    __host__ __device__ bool next(int i, Unit& u, long Lx = -1) const {
        const long L = Lx >= 0 ? Lx : (long)i * G + c; if (L >= nwg) return false;
        int wgid = (int)L; { const int q = nwg / NXCD, r = nwg % NXCD, xcd = wgid % NXCD, off = wgid / NXCD; wgid = (xcd < r ? xcd * (q + 1) : r * (q + 1) + (xcd - r) * q) + off; }
        const int nig = WGM * nN, gid = wgid / nig, fm = gid * WGM, gsz = (nM - fm) < WGM ? (nM - fm) : WGM;
        u.pm = fm + ((wgid % nig) % gsz); u.pn = (wgid % nig) / gsz; return true;
    }
    __device__ __forceinline__ void a_ready(const Unit&) const {}
    __device__ __forceinline__ void done(const Unit&) const {}
};
__device__ __forceinline__ unsigned cvt_pk_bf16(float lo, float hi) { unsigned r; asm volatile("v_cvt_pk_bf16_f32 %0, %1, %2" : "=v"(r) : "v"(lo), "v"(hi)); return r; }
typedef float f32x2 __attribute__((ext_vector_type(2)));
__device__ __forceinline__ f32x4 shflx16(f32x4 v) { f32x4 r; r[0] = __shfl_xor(v[0], 16); r[1] = __shfl_xor(v[1], 16); r[2] = __shfl_xor(v[2], 16); r[3] = __shfl_xor(v[3], 16); return r; }
typedef unsigned u32x2 __attribute__((ext_vector_type(2)));
__device__ __forceinline__ u32x2 pack8_f8(f32x4 a, f32x4 b) {
    int p0 = __builtin_amdgcn_cvt_pk_fp8_f32(a[0], a[1], 0, false); p0 = __builtin_amdgcn_cvt_pk_fp8_f32(a[2], a[3], p0, true);
    int p1 = __builtin_amdgcn_cvt_pk_fp8_f32(b[0], b[1], 0, false); p1 = __builtin_amdgcn_cvt_pk_fp8_f32(b[2], b[3], p1, true);
    return u32x2{(unsigned)p0, (unsigned)p1}; }
__device__ __forceinline__ u32x4 pack8(f32x4 a, f32x4 b) { u32x4 w; w.x = cvt_pk_bf16(a[0], a[1]); w.y = cvt_pk_bf16(a[2], a[3]); w.z = cvt_pk_bf16(b[0], b[1]); w.w = cvt_pk_bf16(b[2], b[3]); return w; }
struct EpiNull {
    static constexpr bool PERM = true, AFTER_DRAIN = false;
    float* o;
    __device__ __forceinline__ void operator()(const f32x4 (&acc)[2][2][4][2], const Unit& u, int wr, int wc, int fr, int fq) const {
        f32x4 s = acc[0][0][0][0];
#pragma unroll
        for (int ai = 0; ai < 2; ++ai)
#pragma unroll
            for (int bj = 0; bj < 2; ++bj)
#pragma unroll
                for (int m = 0; m < 4; ++m)
#pragma unroll
                    for (int n = 0; n < 2; ++n) s += acc[ai][bj][m][n];
        *(f32x4*)(o + ((size_t)(u.pm * 8 + u.pn % 8) * 512 + threadIdx.x) * 4) = s;
    }
};
struct SubOrderB {
    StaticOrder s; int G, c;
    __device__ void init(int M, int G_, int c_) { s.init(M, 5 * BM, G_, 0); G = G_; c = c_; }
    __device__ bool next(int i, Unit& u) const { int L;
        if (G == 256) { if (c < 128) { if (i >= 4) return false; L = c + 128 * i; } else { if (i >= 1) return false; L = 512 + (c - 128); } }
        else { L = i * G + c; }
        if (!s.next(0, u, L)) return false; u.pn = u.pn < 4 ? u.pn + 2 : 8; return true; }
    __device__ __forceinline__ void a_ready(const Unit&) const {}
    __device__ __forceinline__ void done(const Unit&) const {}
};
struct SubOrderQ {
    int G, c;
    __device__ bool next(int i, Unit& u) const { long L;
        if (G == 256) { if (c < 128 || i >= 4) return false; L = (long)(c - 128) * 4 + i; }
        else { L = (long)i * G + c; if (L >= 512) return false; }
        const int idx = (int)(L & 3); u.pm = (int)(L >> 2); u.pn = idx < 2 ? idx : idx + 4; return true; }
    __device__ __forceinline__ void a_ready(const Unit&) const {}
    __device__ __forceinline__ void done(const Unit&) const {}
};
struct EpiInProj {
    static constexpr bool PERM = true, AFTER_DRAIN = false;
    bf16_t* act; const float* biasP; const float* rope; float qscale, inv_s;
    __device__ __forceinline__ void operator()(const f32x4 (&acc)[2][2][4][2], const Unit& u, int wr, int wc, int fr, int fq) const {
        const int row0 = u.pm * BM + wr * 64 + fr; const bool lo = (wc & 1) == 0;
#pragma unroll
        for (int bj = 0; bj < 2; ++bj) {
            const int cgb = u.pn * BM + bj * HALF + wc * 32, H = cgb >> 6, col0 = cgb + 8 * fq;
            const f32x4 b0 = *(const f32x4*)(biasP + col0), b1 = *(const f32x4*)(biasP + col0 + 4);
            const bool k64 = lo && ((0xCCFFC1FFull >> H) & 1ull), k32 = (H >= 10 && H <= 13) || (H == 34 && lo), ksig = (H == 34 && !lo);
            const float qs = (H < 8 || (H >= 14 && H < 22)) ? qscale : 1.f;
#pragma unroll
            for (int ai = 0; ai < 2; ++ai)
#pragma unroll
                for (int m = 0; m < 4; ++m) {
                    const int row = row0 + ai * HALF + m * 16;
                    f32x4 v0 = acc[ai][bj][m][0] * inv_s + b0, v1 = acc[ai][bj][m][1] * inv_s + b1;
                    if (k64) {
                        const f32x4 p0 = shflx16(v0), p1 = shflx16(v1);
                        if (fq < 2) {
                            const f32x4* rp = (const f32x4*)(rope + (size_t)row * 16); const f32x4 t0 = rp[0], t1 = rp[1], t2 = rp[2], t3 = rp[3];
                            const float sg = fq == 0 ? -1.f : 1.f;
                            v0[0] = v0[0] * t0[0] + sg * p0[0] * t0[1]; v0[1] = v0[1] * t0[2] + sg * p0[1] * t0[3];
                            v0[2] = v0[2] * t1[0] + sg * p0[2] * t1[1]; v0[3] = v0[3] * t1[2] + sg * p0[3] * t1[3];
                            v1[0] = v1[0] * t2[0] + sg * p1[0] * t2[1]; v1[1] = v1[1] * t2[2] + sg * p1[1] * t2[3];
                            v1[2] = v1[2] * t3[0] + sg * p1[2] * t3[1]; v1[3] = v1[3] * t3[2] + sg * p1[3] * t3[3];
                        }
                    } else if (k32) {
                        if (fq == 0) {
                            const f32x4* rp = (const f32x4*)(rope + (size_t)row * 16); const f32x4 t0 = rp[0], t1 = rp[1], t2 = rp[2], t3 = rp[3];
                            const f32x4 x1 = v0, x2 = v1;
                            v0[0] = x1[0] * t0[0] - x2[0] * t0[1]; v1[0] = x2[0] * t0[0] + x1[0] * t0[1];
                            v0[1] = x1[1] * t1[0] - x2[1] * t1[1]; v1[1] = x2[1] * t1[0] + x1[1] * t1[1];
                            v0[2] = x1[2] * t2[0] - x2[2] * t2[1]; v1[2] = x2[2] * t2[0] + x1[2] * t2[1];
                            v0[3] = x1[3] * t3[0] - x2[3] * t3[1]; v1[3] = x2[3] * t3[0] + x1[3] * t3[1];
                        }
                    } else if (ksig) {
                        if (fq >= 1) {
#pragma unroll
                            for (int e = 0; e < 4; ++e) { v0[e] = 1.f / (1.f + __expf(-v0[e])); v1[e] = 1.f / (1.f + __expf(-v1[e])); }
                        }
                    }
                    *(u32x4*)(act + (size_t)row * 2304 + col0) = pack8(v0 * qs, v1 * qs);
                }
        }
    }
};
struct EpiOutProj {
    static constexpr bool PERM = true, AFTER_DRAIN = false;
    const bf16_t* xb; bf16_t* v1b; unsigned char* v1q; float* stats; float alpha, inv_s;
    __device__ __forceinline__ void operator()(const f32x4 (&acc)[2][2][4][2], const Unit& u, int wr, int wc, int fr, int fq) const {
        const int row0 = u.pm * BM + wr * 64 + fr;
#pragma unroll
        for (int ai = 0; ai < 2; ++ai)
#pragma unroll
            for (int m = 0; m < 4; ++m) {
                const int row = row0 + ai * HALF + m * 16; float s = 0.f, q = 0.f;
#pragma unroll
                for (int bj = 0; bj < 2; ++bj) {
                    const size_t off = (size_t)row * 1024 + u.pn * BM + bj * HALF + wc * 32 + 8 * fq;
                    const u32x4 xv = *(const u32x4*)(xb + off);
                    const f32x4 xa = {__uint_as_float(xv[0] << 16), __uint_as_float(xv[0] & 0xffff0000u), __uint_as_float(xv[1] << 16), __uint_as_float(xv[1] & 0xffff0000u)};
                    const f32x4 xc = {__uint_as_float(xv[2] << 16), __uint_as_float(xv[2] & 0xffff0000u), __uint_as_float(xv[3] << 16), __uint_as_float(xv[3] & 0xffff0000u)};
                    const f32x4 a = xa * alpha + acc[ai][bj][m][0] * inv_s, b = xc * alpha + acc[ai][bj][m][1] * inv_s;
                    *(u32x4*)(v1b + off) = pack8(a, b); if (v1q) *(u32x2*)(v1q + off) = pack8_f8(a, b);
                    s += ((a[0] + a[1]) + (a[2] + a[3])) + ((b[0] + b[1]) + (b[2] + b[3]));
                    q += ((a[0] * a[0] + a[1] * a[1]) + (a[2] * a[2] + a[3] * a[3])) + ((b[0] * b[0] + b[1] * b[1]) + (b[2] * b[2] + b[3] * b[3]));
                }
                s += __shfl_xor(s, 16); s += __shfl_xor(s, 32); q += __shfl_xor(q, 16); q += __shfl_xor(q, 32);
                if (fq == 0 && stats) { atomicAdd(stats + 2 * row, s); atomicAdd(stats + 2 * row + 1, q); }
            }
    }
};
struct EpiGateUp {
    static constexpr bool PERM = true, AFTER_DRAIN = false;
    bf16_t* actf; unsigned char* actq; const float* stats; const float* cs; const float* bs; float inv_s;
    __device__ __forceinline__ void operator()(const f32x4 (&acc)[2][2][4][2], const Unit& u, int wr, int wc, int fr, int fq) const {
        const int row0 = u.pm * BM + wr * 64 + fr; const int ng = u.pn * BM + wc * 32 + 8 * fq, nu = ng + HALF, jc = u.pn * HALF + wc * 32 + 8 * fq;
        f32x4 csg[2], bsg[2], csu[2], bsu[2];
#pragma unroll
        for (int n = 0; n < 2; ++n) { csg[n] = *(const f32x4*)(cs + ng + 4 * n); bsg[n] = *(const f32x4*)(bs + ng + 4 * n); csu[n] = *(const f32x4*)(cs + nu + 4 * n); bsu[n] = *(const f32x4*)(bs + nu + 4 * n); }
#pragma unroll
        for (int ai = 0; ai < 2; ++ai)
#pragma unroll
            for (int m = 0; m < 4; ++m) {
                const int row = row0 + ai * HALF + m * 16;
                typedef float f2_t __attribute__((ext_vector_type(2)));
                const f2_t st = *(const f2_t*)(stats + 2 * row);
                const float mean = st[0] * (1.f / 1024.f), var = st[1] * (1.f / 1024.f) - mean * mean, rstd = __builtin_amdgcn_rsqf(fmaxf(var, 0.f) + 1e-5f);
                const float a1 = inv_s * rstd, a0 = -mean * rstd;
                f32x4 o[2];
#pragma unroll
                for (int n = 0; n < 2; ++n) {
                    const f32x4 g = acc[ai][0][m][n] * a1 + (csg[n] * a0 + bsg[n]), up = acc[ai][1][m][n] * a1 + (csu[n] * a0 + bsu[n]);
#pragma unroll
                    for (int e = 0; e < 4; ++e) o[n][e] = g[e] * __builtin_amdgcn_rcpf(1.f + __builtin_amdgcn_exp2f(g[e] * -1.4426950408889634f)) * up[e];
                }
                if (actq) *(u32x2*)(actq + (size_t)row * 2816 + jc) = pack8_f8(o[0], o[1]); else *(u32x4*)(actf + (size_t)row * 2816 + jc) = pack8(o[0], o[1]);
            }
    }
};
struct RowStatsX {
    unsigned long long* xbuf;
    unsigned* cnt;
    PG8_LAS unsigned char* tab;
    float eps;
    __device__ __forceinline__ void run(const f32x4 (&v)[2][2][4][2], const Unit& u, int wr, int wc, int fr, int fq, int wid, int lane) const {
        typedef float f32x2v __attribute__((ext_vector_type(2)));
        PG8_LAS f32x2v* P = (PG8_LAS f32x2v*)tab; PG8_LAS f32x2v* S = (PG8_LAS f32x2v*)(tab + 8192);
#pragma unroll
        for (int ai = 0; ai < 2; ++ai)
#pragma unroll
            for (int m = 0; m < 4; ++m) {
                float s = 0.f;
#pragma unroll
                for (int bj = 0; bj < 2; ++bj)
#pragma unroll
                    for (int n = 0; n < 2; ++n) { const f32x4 x = v[ai][bj][m][n]; s += (x[0] + x[1]) + (x[2] + x[3]); }
                s += __shfl_xor(s, 16); s += __shfl_xor(s, 32);
                const float mw = s * (1.0f / 64.0f); float q = 0.f;
#pragma unroll
                for (int bj = 0; bj < 2; ++bj)
#pragma unroll
                    for (int n = 0; n < 2; ++n) { const f32x4 d = v[ai][bj][m][n] - mw; q += (d[0] * d[0] + d[1] * d[1]) + (d[2] * d[2] + d[3] * d[3]); }
                q += __shfl_xor(q, 16); q += __shfl_xor(q, 32);
                if (fq == 0) P[(ai * HALF + wr * 64 + m * 16 + fr) * 4 + wc] = (f32x2v){mw, q};
            }
        asm volatile("s_waitcnt lgkmcnt(0)" ::: "memory"); __builtin_amdgcn_s_barrier(); asm volatile("" ::: "memory");
        const int row = wid * 32 + (lane & 31);
        if (lane < 32) {
            const f32x2v a = P[row * 4 + 0], b = P[row * 4 + 1], c = P[row * 4 + 2], d = P[row * 4 + 3];
            const float mt = (a.x + b.x + c.x + d.x) * 0.25f;
            const float da = a.x - mt, db = b.x - mt, dc = c.x - mt, dd = d.x - mt;
            const float m2 = (a.y + b.y) + (c.y + d.y) + 64.0f * ((da * da + db * db) + (dc * dc + dd * dd));
            __hip_atomic_store(xbuf + ((size_t)(u.pm * BM + row) * 4 + u.pn), ((unsigned long long)__float_as_uint(m2) << 32) | __float_as_uint(mt), __ATOMIC_RELAXED, __HIP_MEMORY_SCOPE_AGENT);
        }
        asm volatile("s_waitcnt vmcnt(0)" ::: "memory");
        if (lane == 0) __hip_atomic_fetch_add(cnt + 64 * u.pm, 1u, __ATOMIC_RELAXED, __HIP_MEMORY_SCOPE_AGENT);
        if (wid == 0) {
            unsigned sp = 0;
            while ((unsigned)__builtin_amdgcn_readfirstlane((int)__hip_atomic_load(cnt + 64 * u.pm, __ATOMIC_RELAXED, __HIP_MEMORY_SCOPE_AGENT)) < 32u) { __builtin_amdgcn_s_sleep(2); if (++sp > (1u << 22)) break; }
            __builtin_amdgcn_fence(__ATOMIC_ACQUIRE, "agent");
        }
        asm volatile("s_waitcnt vmcnt(0) lgkmcnt(0)" ::: "memory"); __builtin_amdgcn_s_barrier(); asm volatile("" ::: "memory");
        if (lane < 32) {
            const unsigned long long* slot = xbuf + (size_t)(u.pm * BM + row) * 4; float mt[4], m2[4]; float ms = 0.f;
#pragma unroll
            for (int t = 0; t < 4; ++t) { const unsigned long long w = __hip_atomic_load(slot + t, __ATOMIC_RELAXED, __HIP_MEMORY_SCOPE_AGENT); mt[t] = __uint_as_float((unsigned)w); m2[t] = __uint_as_float((unsigned)(w >> 32)); ms += mt[t]; }
            const float mean = ms * 0.25f; float q = 0.f;
#pragma unroll
            for (int t = 0; t < 4; ++t) { const float dm = mt[t] - mean; q += m2[t] + 256.0f * dm * dm; }
            S[row] = (f32x2v){mean, __builtin_amdgcn_rsqf(q * (1.0f / 1024.0f) + eps)};
        }
        asm volatile("s_waitcnt lgkmcnt(0)" ::: "memory"); __builtin_amdgcn_s_barrier(); asm volatile("" ::: "memory");
    }
};
struct EpiDownLn {
    static constexpr bool PERM = true, AFTER_DRAIN = false;
    const bf16_t* v1b; float* out; const float* stats; const float* g1; const float* b1; const float* g2; const float* b2; float alpha, inv_s; RowStatsX rx;
    __device__ __forceinline__ void operator()(const f32x4 (&acc_)[2][2][4][2], const Unit& u, int wr, int wc, int fr, int fq) const {
        typedef float f32x2v __attribute__((ext_vector_type(2)));
        f32x4 (&acc)[2][2][4][2] = const_cast<f32x4 (&)[2][2][4][2]>(acc_);
        const int row0 = u.pm * BM + wr * 64 + fr; const int wid = wr * 4 + wc, lane = fq * 16 + fr;
#pragma unroll
        for (int bj = 0; bj < 2; ++bj) {
            const int col0 = u.pn * BM + bj * HALF + wc * 32 + 8 * fq;
            const f32x4 ga = *(const f32x4*)(g1 + col0), gb = *(const f32x4*)(g1 + col0 + 4), ba = *(const f32x4*)(b1 + col0), bb = *(const f32x4*)(b1 + col0 + 4);
#pragma unroll
            for (int ai = 0; ai < 2; ++ai)
#pragma unroll
                for (int m = 0; m < 4; ++m) {
                    const int row = row0 + ai * HALF + m * 16;
                    const f32x2v st = *(const f32x2v*)(stats + 2 * row);
                    const float mean = st[0] * (1.f / 1024.f), var = st[1] * (1.f / 1024.f) - mean * mean, rstd = __builtin_amdgcn_rsqf(fmaxf(var, 0.f) + 1e-5f);
                    const u32x4 vv = *(const u32x4*)(v1b + (size_t)row * 1024 + col0);
                    const f32x4 va = {__uint_as_float(vv[0] << 16), __uint_as_float(vv[0] & 0xffff0000u), __uint_as_float(vv[1] << 16), __uint_as_float(vv[1] & 0xffff0000u)};
                    const f32x4 vb = {__uint_as_float(vv[2] << 16), __uint_as_float(vv[2] & 0xffff0000u), __uint_as_float(vv[3] << 16), __uint_as_float(vv[3] & 0xffff0000u)};
                    acc[ai][bj][m][0] = ((va - mean) * rstd * ga + ba) * alpha + acc[ai][bj][m][0] * inv_s;
                    acc[ai][bj][m][1] = ((vb - mean) * rstd * gb + bb) * alpha + acc[ai][bj][m][1] * inv_s;
                    asm volatile("" : "+v"(acc[ai][bj][m][0]), "+v"(acc[ai][bj][m][1]));
                    if (m & 1) asm volatile("" ::: "memory");
                }
        }
        rx.run(acc, u, wr, wc, fr, fq, wid, lane);
        const PG8_LAS f32x2v* S = (const PG8_LAS f32x2v*)(rx.tab + 8192);
#pragma unroll
        for (int bj = 0; bj < 2; ++bj) {
            const int col0 = u.pn * BM + bj * HALF + wc * 32 + 8 * fq;
            const f32x4 ga = *(const f32x4*)(g2 + col0), gb = *(const f32x4*)(g2 + col0 + 4), ba = *(const f32x4*)(b2 + col0), bb = *(const f32x4*)(b2 + col0 + 4);
#pragma unroll
            for (int ai = 0; ai < 2; ++ai)
#pragma unroll
                for (int m = 0; m < 4; ++m) {
                    const int r = ai * HALF + wr * 64 + m * 16 + fr; const f32x2v sr = S[r]; float* po = out + (size_t)(u.pm * BM + r) * 1024 + col0;
                    *(f32x4*)po = (acc[ai][bj][m][0] - sr.x) * sr.y * ga + ba; *(f32x4*)(po + 4) = (acc[ai][bj][m][1] - sr.x) * sr.y * gb + bb;
                    if (m & 1) asm volatile("" ::: "memory");
                }
        }
        asm volatile("s_waitcnt lgkmcnt(0)" ::: "memory"); __builtin_amdgcn_s_barrier(); asm volatile("" ::: "memory");
    }
};
struct EpiDown {
    static constexpr bool PERM = true, AFTER_DRAIN = false;
    const bf16_t* v1b; bf16_t* v2b; const float* stats; const float* g1; const float* b1; float alpha, inv_s;
    __device__ __forceinline__ void operator()(const f32x4 (&acc)[2][2][4][2], const Unit& u, int wr, int wc, int fr, int fq) const {
        const int row0 = u.pm * BM + wr * 64 + fr;
#pragma unroll
        for (int bj = 0; bj < 2; ++bj) {
            const int col0 = u.pn * BM + bj * HALF + wc * 32 + 8 * fq;
            const f32x4 ga = *(const f32x4*)(g1 + col0), gb = *(const f32x4*)(g1 + col0 + 4), ba = *(const f32x4*)(b1 + col0), bb = *(const f32x4*)(b1 + col0 + 4);
#pragma unroll
            for (int ai = 0; ai < 2; ++ai)
#pragma unroll
                for (int m = 0; m < 4; ++m) {
                    const int row = row0 + ai * HALF + m * 16;
                    const float sm = stats[2 * row], sq = stats[2 * row + 1];
                    const float mean = sm * (1.f / 1024.f), var = sq * (1.f / 1024.f) - mean * mean, rstd = rsqrtf(fmaxf(var, 0.f) + 1e-5f);
                    const u32x4 vv = *(const u32x4*)(v1b + (size_t)row * 1024 + col0);
                    const f32x4 va = {__uint_as_float(vv[0] << 16), __uint_as_float(vv[0] & 0xffff0000u), __uint_as_float(vv[1] << 16), __uint_as_float(vv[1] & 0xffff0000u)};
                    const f32x4 vb = {__uint_as_float(vv[2] << 16), __uint_as_float(vv[2] & 0xffff0000u), __uint_as_float(vv[3] << 16), __uint_as_float(vv[3] & 0xffff0000u)};
                    const f32x4 ha = (va - mean) * rstd * ga + ba, hb = (vb - mean) * rstd * gb + bb;
                    *(u32x4*)(v2b + (size_t)row * 1024 + col0) = pack8(ha * alpha + acc[ai][bj][m][0] * inv_s, hb * alpha + acc[ai][bj][m][1] * inv_s);
                }
        }
    }
};

typedef int i32x8 __attribute__((ext_vector_type(8))); typedef int i32x4 __attribute__((ext_vector_type(4)));
__device__ __forceinline__ i32x8 cat8(bf16x8 a, bf16x8 b) { return __builtin_shufflevector(__builtin_bit_cast(i32x4, a), __builtin_bit_cast(i32x4, b), 0, 1, 2, 3, 4, 5, 6, 7); }
template <class Epi, class Sched, bool ALIGN_EPI = false, bool SP2 = false, bool F8 = false>
__device__ __forceinline__ void gemm_phase(PG8_LAS unsigned char* lds, const Gemm g, const Sched& S, const Epi& E) {
    int tid_ = threadIdx.x; asm volatile("" : "+v"(tid_));
    const int tid = tid_, wid = __builtin_amdgcn_readfirstlane(tid >> 6), lane = tid & 63, wr = wid >> 2, wc = wid & 3, fr = lane & 15, fq = lane >> 4;
    const int RB = F8 ? g.K : 2 * g.K  , nt = RB / 128;
    int sc7f = 0x7F7F7F7F; asm volatile("" : "+v"(sc7f));
    unsigned voffA[2], voffB[2];
#pragma unroll
    for (int i = 0; i < 2; ++i) { int R, C; stage_rc(tid * 16 + i * 8192, R, C); const int Rb = Epi::PERM ? ((R & ~31) + perm32(R & 31)) : R;
        voffA[i] = (unsigned)(R * RB + C * 2); voffB[i] = (unsigned)(Rb * RB + C * 2); }
    const size_t kstep = (size_t)(BK * 2);
    const size_t hstep = (size_t)HALF * RB;
    const size_t tstep = 2 * hstep;
    const unsigned ldsw = (unsigned)wid * 1024u;
    const int aoff = lds_byte(wr * 64 + fr, fq * 8), boff = lds_byte(wc * 32 + fr, fq * 8);
#define PG8_SA(b, h) (((b) * 2 + (h)) * HTB)
#define PG8_SB(b, h) ((4 + (b) * 2 + (h)) * HTB)
#define PG8_STAGE(bufoff, gbase, voff) do { _Pragma("unroll") for (int _i = 0; _i < 2; ++_i) \
        __builtin_amdgcn_global_load_lds((const unsigned*)((const char*)(gbase) + (voff)[_i]), (PG8_LAS unsigned*)(lds + (bufoff) + ldsw + _i * 8192), 16, 0, 0); } while (0)
#define PG8_LDA(dst, b, h) do { _Pragma("unroll") for (int m = 0; m < 4; ++m) _Pragma("unroll") for (int k = 0; k < 2; ++k) dst[m][k] = *(const PG8_LAS bf16x8*)(lds + PG8_SA(b, h) + aoff + m * 2048 + k * 1024); } while (0)
#define PG8_LDB(dst, b, h) do { _Pragma("unroll") for (int n = 0; n < 2; ++n) _Pragma("unroll") for (int k = 0; k < 2; ++k) dst[n][k] = *(const PG8_LAS bf16x8*)(lds + PG8_SB(b, h) + boff + n * 2048 + k * 1024); } while (0)
#define PG8_MMA(ai, bj, At, Bt) do { if constexpr (F8) __builtin_amdgcn_sched_barrier(0); __builtin_amdgcn_s_setprio(1); \
        if constexpr (F8) { _Pragma("unroll") for (int m = 0; m < 4; ++m) _Pragma("unroll") for (int n = 0; n < 2; ++n) \
            asm volatile("v_mfma_scale_f32_16x16x128_f8f6f4 %0, %1, %2, %0, %3, %3 op_sel_hi:[0,0,0]" : "+v"(acc[ai][bj][m][n]) : "v"(cat8(Bt[n][0], Bt[n][1])), "v"(cat8(At[m][0], At[m][1])), "v"(sc7f)); } \
        else { _Pragma("unroll") for (int m = 0; m < 4; ++m) _Pragma("unroll") for (int n = 0; n < 2; ++n) _Pragma("unroll") for (int k = 0; k < 2; ++k) \
            acc[ai][bj][m][n] = __builtin_amdgcn_mfma_f32_16x16x32_bf16(Bt[n][k], At[m][k], acc[ai][bj][m][n], 0, 0, 0); } \
        __builtin_amdgcn_s_setprio(0); if constexpr (F8) __builtin_amdgcn_sched_barrier(0); } while (0)
#define PG8_WAIT_V(n) asm volatile("s_waitcnt vmcnt(" #n ")" ::: "memory")
#define PG8_WAIT_L(n) asm volatile("s_waitcnt lgkmcnt(" #n ")" ::: "memory")
#define PG8_BAR __builtin_amdgcn_s_barrier()
#define PG8_SCHED __builtin_amdgcn_sched_barrier(0)
    Unit cur, nxt; int ui = 0;
    if (!S.next(0, cur)) return;
    f32x4 acc[2][2][4][2];
#pragma unroll
    for (int a = 0; a < 2; ++a)
#pragma unroll
        for (int b = 0; b < 2; ++b)
#pragma unroll
            for (int m = 0; m < 4; ++m)
#pragma unroll
                for (int n = 0; n < 2; ++n) acc[a][b][m][n] = (f32x4){0.f, 0.f, 0.f, 0.f};
    bf16x8 At[4][2], B0[2][2], B1[2][2];
    const char* cA = (const char*)g.A + (size_t)cur.pm * tstep; const char* cB = (const char*)g.Bt + (size_t)cur.pn * tstep;
    S.a_ready(cur);
    if constexpr (SP2) {
        PG8_STAGE(PG8_SB(0, 0), cB, voffB); PG8_STAGE(PG8_SB(0, 1), cB + hstep, voffB); PG8_STAGE(PG8_SA(0, 0), cA, voffA); PG8_STAGE(PG8_SA(0, 1), cA + hstep, voffA);
        if (wr == 1) PG8_BAR;
        PG8_WAIT_V(2); PG8_BAR;
        PG8_STAGE(PG8_SB(1, 0), cB + kstep, voffB); PG8_STAGE(PG8_SA(1, 0), cA + kstep, voffA); PG8_STAGE(PG8_SB(1, 1), cB + hstep + kstep, voffB);
        PG8_WAIT_V(6); PG8_BAR;
    } else {
        PG8_STAGE(PG8_SB(0, 0), cB, voffB); PG8_STAGE(PG8_SA(0, 0), cA, voffA); PG8_STAGE(PG8_SB(0, 1), cB + hstep, voffB); PG8_STAGE(PG8_SA(0, 1), cA + hstep, voffA);
        if (wr == 1) PG8_BAR;
        PG8_WAIT_V(4); PG8_BAR;
        PG8_STAGE(PG8_SB(1, 0), cB + kstep, voffB); PG8_STAGE(PG8_SA(1, 0), cA + kstep, voffA); PG8_STAGE(PG8_SB(1, 1), cB + hstep + kstep, voffB);
        PG8_WAIT_V(6); PG8_BAR;
    }
    for (;;) {
        const bool has_next = S.next(ui + 1, nxt);
        const char* nA = has_next ? (const char*)g.A + (size_t)nxt.pm * tstep : cA; const char* nB = has_next ? (const char*)g.Bt + (size_t)nxt.pn * tstep : cB;
        for (int t = 0; t < nt; t += 2) {
            const bool last = (t == nt - 2);
            const char* a1 = cA + (size_t)(t + 1) * kstep;
            const char* a2 = last ? nA : cA + (size_t)(t + 2) * kstep; const char* b2 = last ? nB : cB + (size_t)(t + 2) * kstep;
            const char* a3 = a2 + kstep; const char* b3 = b2 + kstep;
            if (last && has_next) S.a_ready(nxt);
            if constexpr (SP2) {
            PG8_LDB(B0, 0, 0); PG8_LDB(B1, 0, 1); PG8_SCHED; PG8_LDA(At, 0, 0); PG8_STAGE(PG8_SA(1, 1), a1 + hstep, voffA);
            PG8_WAIT_V(8); PG8_WAIT_L(0); PG8_BAR; PG8_MMA(0, 0, At, B0); PG8_MMA(0, 1, At, B1); PG8_BAR; PG8_SCHED;
            PG8_LDA(At, 0, 1); PG8_STAGE(PG8_SB(0, 0), b2, voffB); PG8_STAGE(PG8_SB(0, 1), b2 + hstep, voffB); PG8_STAGE(PG8_SA(0, 0), a2, voffA);
            PG8_WAIT_V(8); PG8_WAIT_L(0); PG8_BAR; PG8_MMA(1, 0, At, B0); PG8_MMA(1, 1, At, B1); PG8_BAR; PG8_SCHED;
            PG8_LDB(B0, 1, 0); PG8_LDB(B1, 1, 1); PG8_SCHED; PG8_LDA(At, 1, 0); PG8_STAGE(PG8_SA(0, 1), a2 + hstep, voffA);
            PG8_WAIT_V(8); PG8_WAIT_L(0); PG8_BAR; PG8_MMA(0, 0, At, B0); PG8_MMA(0, 1, At, B1); PG8_BAR; PG8_SCHED;
            PG8_LDA(At, 1, 1); PG8_STAGE(PG8_SB(1, 0), b3, voffB); PG8_STAGE(PG8_SB(1, 1), b3 + hstep, voffB); PG8_STAGE(PG8_SA(1, 0), a3, voffA);
            PG8_WAIT_V(8); PG8_WAIT_L(0); PG8_BAR; PG8_MMA(1, 0, At, B0); PG8_MMA(1, 1, At, B1); PG8_BAR; PG8_SCHED;
            } else {
            PG8_LDB(B0, 0, 0); PG8_SCHED; PG8_LDA(At, 0, 0); PG8_STAGE(PG8_SA(1, 1), a1 + hstep, voffA);
            PG8_WAIT_L(8); PG8_BAR; PG8_WAIT_L(0); PG8_MMA(0, 0, At, B0); PG8_BAR; PG8_SCHED;
            PG8_LDB(B1, 0, 1); PG8_STAGE(PG8_SB(0, 0), b2, voffB);
            PG8_BAR; PG8_WAIT_L(0); PG8_MMA(0, 1, At, B1); PG8_BAR;
            PG8_LDA(At, 0, 1); PG8_STAGE(PG8_SA(0, 0), a2, voffA);
            PG8_BAR; PG8_WAIT_L(0); PG8_MMA(1, 0, At, B0); PG8_BAR; PG8_SCHED;
            PG8_STAGE(PG8_SB(0, 1), b2 + hstep, voffB);
            PG8_WAIT_V(6); PG8_BAR; PG8_MMA(1, 1, At, B1); PG8_BAR;
            PG8_LDB(B0, 1, 0); PG8_SCHED; PG8_LDA(At, 1, 0); PG8_STAGE(PG8_SA(0, 1), a2 + hstep, voffA);
            PG8_WAIT_L(8); PG8_BAR; PG8_WAIT_L(0); PG8_MMA(0, 0, At, B0); PG8_BAR; PG8_SCHED;
            PG8_LDB(B1, 1, 1); PG8_STAGE(PG8_SB(1, 0), b3, voffB);
            PG8_BAR; PG8_WAIT_L(0); PG8_MMA(0, 1, At, B1); PG8_BAR;
            PG8_LDA(At, 1, 1); PG8_STAGE(PG8_SA(1, 0), a3, voffA);
            PG8_BAR; PG8_WAIT_L(0); PG8_MMA(1, 0, At, B0); PG8_BAR; PG8_SCHED;
            PG8_STAGE(PG8_SB(1, 1), b3 + hstep, voffB);
            PG8_WAIT_V(6); PG8_BAR; PG8_MMA(1, 1, At, B1); PG8_BAR;
            }
        }
        if constexpr (ALIGN_EPI) { if (wr == 0) PG8_BAR; }
        if constexpr (F8) asm volatile("s_nop 15\n\ts_nop 7" ::: "memory");
        if constexpr (!Epi::AFTER_DRAIN) { E(acc, cur, wr, wc, fr, fq); S.done(cur); }
        if (!has_next) break;
#pragma unroll
        for (int a = 0; a < 2; ++a)
#pragma unroll
            for (int b = 0; b < 2; ++b)
#pragma unroll
                for (int m = 0; m < 4; ++m)
#pragma unroll
                    for (int n = 0; n < 2; ++n) acc[a][b][m][n] = (f32x4){0.f, 0.f, 0.f, 0.f};
        cur = nxt; cA = nA; cB = nB; ++ui;
        if constexpr (ALIGN_EPI) { if (wr == 1) PG8_BAR; }
    }
    PG8_WAIT_V(0);
    if constexpr (!ALIGN_EPI) { if (wr == 0) PG8_BAR; }
    PG8_BAR;
    if constexpr (Epi::AFTER_DRAIN) { E.fused(acc, cur, wr, wc, fr, fq, lds, wid, lane); S.done(cur); }
#undef PG8_SA
#undef PG8_SB
#undef PG8_STAGE
#undef PG8_LDA
#undef PG8_LDB
#undef PG8_MMA
#undef PG8_WAIT_V
#undef PG8_WAIT_L
#undef PG8_BAR
#undef PG8_SCHED
}
}
#define GAS __attribute__((address_space(1)))
#define LAS __attribute__((address_space(3)))
typedef unsigned short bf16;
typedef unsigned v4u __attribute__((ext_vector_type(4)));
typedef float f32x4 __attribute__((ext_vector_type(4)));
typedef short bf16x8 __attribute__((ext_vector_type(8)));
typedef GAS unsigned gu32;
typedef GAS unsigned long long gu64;
#define RLX_AGENT __ATOMIC_RELAXED, __HIP_MEMORY_SCOPE_AGENT
#define LDS_WAIT() asm volatile("s_waitcnt lgkmcnt(0)" ::: "memory")
#define VM_WAIT() asm volatile("s_waitcnt vmcnt(0)" ::: "memory")
__device__ __forceinline__ unsigned long long rt() { return __builtin_amdgcn_s_memrealtime(); }
__device__ __forceinline__ unsigned f2bf(float f) { unsigned u = __builtin_bit_cast(unsigned, f); return (u + 0x7fffu + ((u >> 16) & 1u)) >> 16; }
__device__ __forceinline__ unsigned pk2(float lo, float hi) { return f2bf(lo) | (f2bf(hi) << 16); }

#define XB_TMO      128
#define XB_XCNT(j)  (256  + 64 * (j))
#define XB_XSUB(j)  (1280 + 64 * (j))
#define XB_XGEN(j)  (2304 + 64 * (j))
#define XB_TOP      3328
#define XB_TOPGEN   3392
#define XCD_BAR_WORDS 3456
#define XB_SPIN_CAP (1u << 18)

__device__ __forceinline__ unsigned xb_ld(unsigned* p)              { return __hip_atomic_load(p, __ATOMIC_RELAXED, __HIP_MEMORY_SCOPE_AGENT); }
__device__ __forceinline__ unsigned xb_add(unsigned* p, unsigned v) { return __hip_atomic_fetch_add(p, v, __ATOMIC_RELAXED, __HIP_MEMORY_SCOPE_AGENT); }
__device__ __forceinline__ unsigned xb_xcc_id() { return (unsigned)__builtin_amdgcn_s_getreg((3 << 11) | 20) & 0xFu; }
#define XB_SPIN(cond, bar) do { unsigned _sp = 0; while (cond) { __builtin_amdgcn_s_sleep(1); \
    if ((++_sp & 255u) == 0u) { if (xb_ld(&(bar)[XB_TMO])) break; if (_sp > XB_SPIN_CAP) { atomicAdd(&(bar)[XB_TMO], 1u); break; } } } } while (0)

struct XcdBarrier {
    unsigned* bar; unsigned x;
    volatile LAS unsigned* st;
};

__device__ __forceinline__ XcdBarrier xcd_barrier_post(unsigned* bar, volatile LAS unsigned* st) {
    XcdBarrier b; b.bar = bar; b.x = xb_xcc_id(); b.st = st;
    if (threadIdx.x == 0) (void)xb_add(&bar[XB_XCNT(b.x)], 1u);
    return b;
}
__device__ __forceinline__ void xcd_barrier_complete(unsigned* bar, unsigned x, unsigned& nloc, unsigned& nx) {
    const unsigned G = gridDim.x * gridDim.y * gridDim.z;
    unsigned sum, cnt, mine, sp = 0u;
    for (;;) {
        sum = 0u; cnt = 0u; mine = 0u;
#pragma unroll
        for (unsigned j = 0; j < 16; ++j) { const unsigned c = xb_ld(&bar[XB_XCNT(j)]); sum += c; cnt += (c > 0u) ? 1u : 0u; mine = (j == x) ? c : mine; }
        if (sum == G) break;
        __builtin_amdgcn_s_sleep(1);
        if ((++sp & 255u) == 0u) { if (xb_ld(&bar[XB_TMO])) break; if (sp > XB_SPIN_CAP) { atomicAdd(&bar[XB_TMO], 1u); break; } }
    }
    nloc = mine > 0u ? mine : 1u; nx = cnt > 0u ? cnt : 1u;
}

__device__ __forceinline__ void xcd_barrier(const XcdBarrier& b) {
    asm volatile("s_waitcnt vmcnt(0)" ::: "memory");
    __syncthreads();
    if (threadIdx.x == 0) {
        unsigned* bar = b.bar;
        __builtin_amdgcn_s_waitcnt(0);
        unsigned nloc = b.st[0], nx = b.st[1];
        if (nloc == 0u) { xcd_barrier_complete(bar, b.x, nloc, nx); b.st[0] = nloc; b.st[1] = nx; }
        const unsigned old = xb_add(&bar[XB_XSUB(b.x)], 1u);
        const unsigned gen = old / nloc;
        if (old + 1u == (gen + 1u) * nloc) {
            __builtin_amdgcn_fence(__ATOMIC_RELEASE, "agent");
            asm volatile("s_waitcnt vmcnt(0)" ::: "memory");
            const unsigned og = xb_add(&bar[XB_TOP], 1u);
            const unsigned tg = og / nx;
            if (og + 1u == (tg + 1u) * nx) xb_add(&bar[XB_TOPGEN], 1u);
            else XB_SPIN(xb_ld(&bar[XB_TOPGEN]) == tg, bar);
            __builtin_amdgcn_fence(__ATOMIC_ACQUIRE, "agent");
            xb_add(&bar[XB_XGEN(b.x)], 1u);
            asm volatile("s_waitcnt vmcnt(0)" ::: "memory");
        } else {
            XB_SPIN(xb_ld(&bar[XB_XGEN(b.x)]) == gen, bar);
            __builtin_amdgcn_fence(__ATOMIC_ACQUIRE, "agent");
            asm volatile("s_waitcnt vmcnt(0)" ::: "memory");
        }
    }
    __syncthreads();
}
constexpr int NWAVES = 8, NT = 512;
constexpr float S_GU = 32.f, S_DN = 64.f, S_OUT = 32.f, S_IN = 32.f;
constexpr int RING_BYTES = 131072, LDSCTL_OFF = RING_BYTES, MISC_OFF = LDSCTL_OFF + 320, LDS_BYTES = 147456;
constexpr int CW_TMO = 0, CW_BAR = 4096;
__device__ __forceinline__ float bf2f(bf16 v) { return __uint_as_float(((unsigned)v) << 16); }
__device__ __forceinline__ float bfr(float f) { return __uint_as_float(f2bf(f) << 16); }
__device__ __forceinline__ float wave_sum(float v) {
#pragma unroll
    for (int o = 1; o < 64; o <<= 1) v += __shfl_xor(v, o);
    return v;
}
template <bool F8>
__device__ __forceinline__ void tr64(const float* __restrict__ W, int Nsrc, int K, void* WT, int n0, int k0, int srccol, const float* __restrict__ kscale, float S, const float* __restrict__ kbias, float* csum, float* bsum, int lane) {
    const float* wp = W + (size_t)k0 * Nsrc + (srccol >= 0 ? srccol : 0); float cs = 0.f, bs = 0.f; const float rS = 1.f / S;
#pragma unroll 1
    for (int ch = 0; ch < 4; ++ch) {
        float v[16];
#pragma unroll
        for (int i = 0; i < 16; ++i) v[i] = srccol >= 0 ? wp[(size_t)(ch * 16 + i) * Nsrc] : 0.f;
        if (bsum) {
#pragma unroll
            for (int i = 0; i < 16; ++i) bs = fmaf(kbias[k0 + ch * 16 + i], v[i], bs); }
        if (kscale) {
#pragma unroll
            for (int i = 0; i < 16; ++i) v[i] *= kscale[k0 + ch * 16 + i]; }
        if constexpr (F8) {
            v4u o;
#pragma unroll
            for (int d = 0; d < 4; ++d) { int p = __builtin_amdgcn_cvt_pk_fp8_f32(v[4 * d] * S, v[4 * d + 1] * S, 0, false); p = __builtin_amdgcn_cvt_pk_fp8_f32(v[4 * d + 2] * S, v[4 * d + 3] * S, p, true); o[d] = (unsigned)p;
                if (csum) cs += ((__builtin_amdgcn_cvt_f32_fp8(p, 0) + __builtin_amdgcn_cvt_f32_fp8(p, 1)) + (__builtin_amdgcn_cvt_f32_fp8(p, 2) + __builtin_amdgcn_cvt_f32_fp8(p, 3))) * rS; }
            *(GAS v4u*)((unsigned char*)WT + (size_t)(n0 + lane) * K + k0 + ch * 16) = o;
        } else {
            v4u o0, o1;
#pragma unroll
            for (int d = 0; d < 4; ++d) { o0[d] = pk2(v[2 * d], v[2 * d + 1]); o1[d] = pk2(v[8 + 2 * d], v[8 + 2 * d + 1]); }
            GAS v4u* dst = (GAS v4u*)((bf16*)WT + (size_t)(n0 + lane) * K + k0 + ch * 16); dst[0] = o0; dst[1] = o1;
        }
    }
    if (csum) atomicAdd(csum + n0 + lane, cs);
    if (bsum) atomicAdd(bsum + n0 + lane, bs);
}


namespace att {
typedef short bf16x8 __attribute__((ext_vector_type(8)));
typedef short s16x4 __attribute__((ext_vector_type(4)));
typedef short v4i16_t __attribute__((ext_vector_type(4)));
typedef float f32x16 __attribute__((ext_vector_type(16)));
typedef unsigned u32x4 __attribute__((ext_vector_type(4)));
typedef unsigned u32x2 __attribute__((ext_vector_type(2)));
constexpr float C2 = 0.125f * 1.4426950408889634f;
constexpr float NEG_INF = -INFINITY;
__device__ __forceinline__ int crow(int r, int hi) { return (r & 3) + 8 * (r >> 2) + 4 * hi; }
__device__ __forceinline__ s16x4 vtr(const LAS unsigned char* p) { return __builtin_bit_cast(s16x4, __builtin_amdgcn_ds_read_tr16_b64_v4i16((LAS v4i16_t*)p)); }
__device__ __forceinline__ unsigned cvtpk(float lo, float hi) { typedef float f2_t __attribute__((ext_vector_type(2))); typedef __bf16 b2_t __attribute__((ext_vector_type(2))); f2_t v = {lo, hi}; b2_t b = __builtin_convertvector(v, b2_t); return __builtin_bit_cast(unsigned, b); }
__device__ __forceinline__ float ex2(float x) { return __builtin_amdgcn_exp2f(x); }

__device__ __forceinline__ void qkt(f32x16& p0, f32x16& p1, const LAS unsigned char* Ks, const bf16x8* qf, int r32, int hi) {
    const LAS unsigned char* kb = Ks + hi * 1024 + r32 * 16;
#pragma unroll
    for (int dh = 0; dh < 2; ++dh) {
        const bf16x8 b0 = *(const LAS bf16x8*)(kb + (2 * dh) * 2048), b1 = *(const LAS bf16x8*)(kb + (2 * dh) * 2048 + 512);
        const bf16x8 b2 = *(const LAS bf16x8*)(kb + (2 * dh + 1) * 2048), b3 = *(const LAS bf16x8*)(kb + (2 * dh + 1) * 2048 + 512);
        __builtin_amdgcn_s_setprio(1);
        p0 = __builtin_amdgcn_mfma_f32_32x32x16_bf16(b0, qf[2 * dh], p0, 0, 0, 0); p1 = __builtin_amdgcn_mfma_f32_32x32x16_bf16(b1, qf[2 * dh], p1, 0, 0, 0);
        p0 = __builtin_amdgcn_mfma_f32_32x32x16_bf16(b2, qf[2 * dh + 1], p0, 0, 0, 0); p1 = __builtin_amdgcn_mfma_f32_32x32x16_bf16(b3, qf[2 * dh + 1], p1, 0, 0, 0);
        __builtin_amdgcn_s_setprio(0);
        if (dh == 0) __builtin_amdgcn_sched_barrier(0);
    }
}
__device__ __forceinline__ void qkt_c(f32x16& p0, f32x16& p1, const f32x16& cn, const LAS unsigned char* Ks, const bf16x8* qf, int r32, int hi) {
    const LAS unsigned char* kb = Ks + hi * 1024 + r32 * 16;
    {   const bf16x8 b0 = *(const LAS bf16x8*)(kb), b1 = *(const LAS bf16x8*)(kb + 512);
        const bf16x8 b2 = *(const LAS bf16x8*)(kb + 2048), b3 = *(const LAS bf16x8*)(kb + 2048 + 512);
        __builtin_amdgcn_s_setprio(1);
        p0 = __builtin_amdgcn_mfma_f32_32x32x16_bf16(b0, qf[0], cn, 0, 0, 0); p1 = __builtin_amdgcn_mfma_f32_32x32x16_bf16(b1, qf[0], cn, 0, 0, 0);
        p0 = __builtin_amdgcn_mfma_f32_32x32x16_bf16(b2, qf[1], p0, 0, 0, 0); p1 = __builtin_amdgcn_mfma_f32_32x32x16_bf16(b3, qf[1], p1, 0, 0, 0);
        __builtin_amdgcn_s_setprio(0);
        __builtin_amdgcn_sched_barrier(0); }
    {   const bf16x8 b0 = *(const LAS bf16x8*)(kb + 4096), b1 = *(const LAS bf16x8*)(kb + 4096 + 512);
        const bf16x8 b2 = *(const LAS bf16x8*)(kb + 6144), b3 = *(const LAS bf16x8*)(kb + 6144 + 512);
        __builtin_amdgcn_s_setprio(1);
        p0 = __builtin_amdgcn_mfma_f32_32x32x16_bf16(b0, qf[2], p0, 0, 0, 0); p1 = __builtin_amdgcn_mfma_f32_32x32x16_bf16(b1, qf[2], p1, 0, 0, 0);
        p0 = __builtin_amdgcn_mfma_f32_32x32x16_bf16(b2, qf[3], p0, 0, 0, 0); p1 = __builtin_amdgcn_mfma_f32_32x32x16_bf16(b3, qf[3], p1, 0, 0, 0);
        __builtin_amdgcn_s_setprio(0); }
}
__device__ __forceinline__ float max3f(float a, float b, float c) { float r; asm("v_max3_f32 %0, %1, %2, %3" : "=v"(r) : "v"(a), "v"(b), "v"(c)); return r; }
__device__ __forceinline__ void cinit_bits(f32x16& c, unsigned w, int hi, float negm) {
    const unsigned w2 = w >> (4 * hi), nb = __float_as_uint(negm);
#pragma unroll
    for (int r = 0; r < 16; ++r) { const unsigned mm = (unsigned)__builtin_amdgcn_sbfe((int)w2, crow(r, 0), 1); c[r] = __uint_as_float((nb & mm) | (0xFF800000u & ~mm)); }
}
__device__ __forceinline__ void cinit_splat(f32x16& c, float v) {
#pragma unroll
    for (int r = 0; r < 16; ++r) c[r] = v;
}
__device__ __forceinline__ void pv(f32x16* o, const LAS unsigned char* Vs, int lane, int hi, const u32x4 (&pw)[4]) {
    const LAS unsigned char* vb = Vs + ((lane >> 4) & 1) * 32 + (lane & 3) * 8 + (4 * hi + ((lane & 15) >> 2)) * 64;
#pragma unroll
    for (int d0 = 0; d0 < 2; ++d0) {
        s16x4 lo[4], hh[4];
#pragma unroll
        for (int ks = 0; ks < 4; ++ks) { lo[ks] = vtr(vb + d0 * 4096 + ks * 1024); hh[ks] = vtr(vb + d0 * 4096 + ks * 1024 + 512); }
        asm volatile("s_waitcnt lgkmcnt(0)" ::: "memory"); __builtin_amdgcn_sched_barrier(0);
        __builtin_amdgcn_s_setprio(1);
#pragma unroll
        for (int ks = 0; ks < 4; ++ks) { const bf16x8 vf = {lo[ks][0], lo[ks][1], lo[ks][2], lo[ks][3], hh[ks][0], hh[ks][1], hh[ks][2], hh[ks][3]};
            o[d0] = __builtin_amdgcn_mfma_f32_32x32x16_bf16(__builtin_bit_cast(bf16x8, pw[ks]), vf, o[d0], 0, 0, 0); }
        __builtin_amdgcn_s_setprio(0);
    }
}
__device__ __forceinline__ void softmax_step(f32x16& p0, f32x16& p1, float& m, float& l, f32x16* o, LAS float* wsf, int r32, int hi, u32x4 (&pw)[4]) {
    float rm = fmaxf(p0[0], p1[0]);
#pragma unroll
    for (int r = 1; r < 16; ++r) rm = fmaxf(rm, fmaxf(p0[r], p1[r]));
    rm = fmaxf(rm, __shfl_xor(rm, 32));
    if (__any(rm > m)) {
        const float mn = fmaxf(m, rm), f = ex2(m - mn);
        l *= f; m = mn;
        if (hi == 0) wsf[r32] = f;
#pragma unroll
        for (int r = 0; r < 16; ++r) { const float fr = wsf[crow(r, hi)]; o[0][r] *= fr; o[1][r] *= fr; }
    }
    float s = 0.f;
#pragma unroll
    for (int r = 0; r < 16; ++r) { p0[r] = ex2(p0[r] - m); p1[r] = ex2(p1[r] - m); s += p0[r] + p1[r]; }
    l += s;
    pw[0] = u32x4{cvtpk(p0[0], p0[1]), cvtpk(p0[2], p0[3]), cvtpk(p0[4], p0[5]), cvtpk(p0[6], p0[7])};
    pw[1] = u32x4{cvtpk(p0[8], p0[9]), cvtpk(p0[10], p0[11]), cvtpk(p0[12], p0[13]), cvtpk(p0[14], p0[15])};
    pw[2] = u32x4{cvtpk(p1[0], p1[1]), cvtpk(p1[2], p1[3]), cvtpk(p1[4], p1[5]), cvtpk(p1[6], p1[7])};
    pw[3] = u32x4{cvtpk(p1[8], p1[9]), cvtpk(p1[10], p1[11]), cvtpk(p1[12], p1[13]), cvtpk(p1[14], p1[15])};
}
__device__ __forceinline__ void mask_bits(f32x16& p, unsigned w, int hi) {
    const unsigned w2 = w >> (4 * hi);
#pragma unroll
    for (int r = 0; r < 16; ++r) p[r] = ((w2 >> crow(r, 0)) & 1u) ? p[r] : NEG_INF;
}
constexpr float THRL = 8.f;
__device__ __forceinline__ void partialSM(f32x16& p0, f32x16& p1, float& m_reg, float& alpha, bool& seen, f32x16& cneg) {
    float a = max3f(p0[0], p0[1], p1[0]), b = max3f(p0[2], p0[3], p1[1]); a = max3f(a, p1[2], p1[3]);
#pragma unroll
    for (int r = 4; r < 16; r += 4) { a = max3f(a, p0[r], p0[r + 1]); b = max3f(b, p0[r + 2], p0[r + 3]); a = max3f(a, p1[r], p1[r + 1]); b = max3f(b, p1[r + 2], p1[r + 3]); }
    float pmax = max3f(a, b, b);
    { auto rr = __builtin_amdgcn_permlane32_swap(__float_as_uint(pmax), __float_as_uint(pmax), false, false); pmax = max3f(__uint_as_float(rr[0]), __uint_as_float(rr[1]), __uint_as_float(rr[1])); }
    const bool fin = pmax > NEG_INF, init = fin && !seen, up = seen && pmax > THRL;
    alpha = 1.f;
    if (__builtin_expect(__any(init || up), 0)) { const float dl = (init || up) ? pmax : 0.f; alpha = up ? ex2(-dl) : 1.f; m_reg += dl; cinit_splat(cneg, -m_reg);
#pragma unroll
        for (int r = 0; r < 16; ++r) { p0[r] -= dl; p1[r] -= dl; } }
    seen = seen || fin;
#pragma unroll
    for (int r = 0; r < 16; ++r) p0[r] = ex2(p0[r]);
}
__device__ __forceinline__ void finishSM(f32x16& p0, f32x16& p1, float alpha, float& l_reg, u32x4 (&pw)[4]) {
#pragma unroll
    for (int r = 0; r < 16; ++r) p1[r] = ex2(p1[r]);
    float ps = 0.f;
#pragma unroll
    for (int r = 0; r < 16; ++r) ps += p0[r] + p1[r];
    l_reg = l_reg * alpha + ps;
    pw[0] = u32x4{cvtpk(p0[0], p0[1]), cvtpk(p0[2], p0[3]), cvtpk(p0[4], p0[5]), cvtpk(p0[6], p0[7])};
    pw[1] = u32x4{cvtpk(p0[8], p0[9]), cvtpk(p0[10], p0[11]), cvtpk(p0[12], p0[13]), cvtpk(p0[14], p0[15])};
    pw[2] = u32x4{cvtpk(p1[0], p1[1]), cvtpk(p1[2], p1[3]), cvtpk(p1[4], p1[5]), cvtpk(p1[6], p1[7])};
    pw[3] = u32x4{cvtpk(p1[8], p1[9]), cvtpk(p1[10], p1[11]), cvtpk(p1[12], p1[13]), cvtpk(p1[14], p1[15])};
}
__device__ __forceinline__ void rescale_o(f32x16* o, float alpha, LAS float* wsf, int r32, int hi) {
    if (__any(alpha < 1.f)) { if (hi == 0) wsf[r32] = alpha;
#pragma unroll
        for (int r = 0; r < 16; ++r) { const float fr = wsf[crow(r, hi)]; o[0][r] *= fr; o[1][r] *= fr; } }
}
#define SBAR_() __builtin_amdgcn_sched_barrier(0)
template <class Stg, class MaskF>
__device__ __forceinline__ void flash_loop(int t0, int nt, Stg& sg, const MaskF& mk, const bf16x8* qf, LAS unsigned char* kb, LAS unsigned char* vb, int bstride,
                                           float& m_reg, float& l_reg, f32x16* o, LAS float* wsf, int lane, int r32, int hi, bool preloaded = false) {
    f32x16 pA0, pA1, pB0, pB1, cneg; float alA = 1.f, alB = 1.f; u32x4 pw[4]; bool seen = false; cinit_splat(cneg, -m_reg);
    if (!preloaded) sg.load(t0);
    sg.store(0); __syncthreads();
    if (nt > 1) sg.load(t0 + 1); else sg.load_after();
    qkt_c(pA0, pA1, cneg, kb, qf, r32, hi); mk.post(pA0, pA1, t0); partialSM(pA0, pA1, m_reg, alA, seen, cneg);
    if (nt > 1) sg.store(1);
    __syncthreads();
#define FL_STEP(C0, C1, ALC, P0, P1, ALP, J) do { const int cb_ = ((J) & 1) * bstride, pb_ = (((J) - 1) & 1) * bstride; \
        if ((J) + 1 < nt) sg.load(t0 + (J) + 1); else sg.load_after(); \
        SBAR_(); qkt_c(C0, C1, cneg, kb + cb_, qf, r32, hi); \
        finishSM(P0, P1, ALP, l_reg, pw); SBAR_(); \
        pv(o, vb + pb_, lane, hi, pw); mk.post(C0, C1, t0 + (J)); partialSM(C0, C1, m_reg, ALC, seen, cneg); \
        __syncthreads(); \
        if ((J) + 1 < nt) sg.store(((J) + 1) & 1); \
        rescale_o(o, ALC, wsf, r32, hi); \
        __syncthreads(); } while (0)
    int j = 1;
    for (; j + 1 < nt; j += 2) { FL_STEP(pB0, pB1, alB, pA0, pA1, alA, j); FL_STEP(pA0, pA1, alA, pB0, pB1, alB, j + 1); }
    if (j < nt) { FL_STEP(pB0, pB1, alB, pA0, pA1, alA, j); ++j; }
    if (nt & 1) { finishSM(pA0, pA1, alA, l_reg, pw); SBAR_(); pv(o, vb, lane, hi, pw); }
    else { finishSM(pB0, pB1, alB, l_reg, pw); SBAR_(); pv(o, vb + bstride, lane, hi, pw); }
#undef FL_STEP
    __syncthreads();
}
template <class Stg, class MaskF>
__device__ __forceinline__ void flash_loop_r(int t0, int nt, Stg& sg, const MaskF& mk, const bf16x8* qf, LAS unsigned char* kb, int kstride, LAS unsigned char* vb, int vstride,
                                             float& m_reg, float& l_reg, f32x16* o, LAS float* wsf, int lane, int r32, int hi, bool preloaded = false) {
    f32x16 pA0, pA1, pB0, pB1, cneg; float alA = 1.f, alB = 1.f; u32x4 pw[4]; bool seen = false; cinit_splat(cneg, -m_reg);
    if (!preloaded) sg.load(t0);
    sg.store(0, 0); __syncthreads();
    if (nt > 1) sg.load(t0 + 1); else sg.load_after();
    qkt_c(pA0, pA1, cneg, kb, qf, r32, hi); mk.post(pA0, pA1, t0); partialSM(pA0, pA1, m_reg, alA, seen, cneg);
    if (nt > 1) sg.store(1, 1);
    __syncthreads();
    int vprev = 0, vcur = 1, vnext = 2;
#define FR_STEP(C0, C1, ALC, P0, P1, ALP, J) do { \
        if ((J) + 1 < nt) sg.load(t0 + (J) + 1); else sg.load_after(); \
        SBAR_(); qkt_c(C0, C1, cneg, kb + ((J) & 1) * kstride, qf, r32, hi); \
        finishSM(P0, P1, ALP, l_reg, pw); SBAR_(); \
        pv(o, vb + vprev * vstride, lane, hi, pw); mk.post(C0, C1, t0 + (J)); partialSM(C0, C1, m_reg, ALC, seen, cneg); \
        rescale_o(o, ALC, wsf, r32, hi); \
        if ((J) + 1 < nt) sg.store(((J) + 1) & 1, vnext); \
        __syncthreads(); \
        { const int t_ = vprev; vprev = vcur; vcur = vnext; vnext = t_; } } while (0)
    int j = 1;
    for (; j + 1 < nt; j += 2) { FR_STEP(pB0, pB1, alB, pA0, pA1, alA, j); FR_STEP(pA0, pA1, alA, pB0, pB1, alB, j + 1); }
    if (j < nt) { FR_STEP(pB0, pB1, alB, pA0, pA1, alA, j); ++j; }
    if (nt & 1) { finishSM(pA0, pA1, alA, l_reg, pw); SBAR_(); pv(o, vb + vprev * vstride, lane, hi, pw); }
    else { finishSM(pB0, pB1, alB, l_reg, pw); SBAR_(); pv(o, vb + vprev * vstride, lane, hi, pw); }
#undef FR_STEP
    __syncthreads();
}
template <class Stg, class MaskF>
__device__ __forceinline__ void flash_loop_b(int t0, int nt, Stg& sg, const MaskF& mk, const bf16x8* qf, LAS unsigned char* kb, LAS unsigned char* vb, int bstride,
                                             float& m_reg, float& l_reg, f32x16* o, LAS float* wsf, int lane, int r32, int hi, bool preloaded = false) {
    f32x16 c0, c1, cneg; u32x4 pw[4]; float alpha = 1.f; bool seen = false; cinit_splat(cneg, -m_reg);
    if (!preloaded) sg.load(t0);
    sg.store(0); __syncthreads();
    if (nt > 1) sg.load(t0 + 1); else sg.load_after();
    qkt_c(c0, c1, cneg, kb, qf, r32, hi); mk.post(c0, c1, t0);
    partialSM(c0, c1, m_reg, alpha, seen, cneg); finishSM(c0, c1, alpha, l_reg, pw);
    if (nt > 1) sg.store(1);
    __syncthreads();
    for (int j = 1; j < nt; ++j) {
        const int cb_ = (j & 1) * bstride, pb_ = ((j - 1) & 1) * bstride;
        if (j + 1 < nt) sg.load(t0 + j + 1); else sg.load_after();
        SBAR_(); qkt_c(c0, c1, cneg, kb + cb_, qf, r32, hi);
        pv(o, vb + pb_, lane, hi, pw);
        mk.post(c0, c1, t0 + j);
        partialSM(c0, c1, m_reg, alpha, seen, cneg); finishSM(c0, c1, alpha, l_reg, pw);
        __syncthreads();
        if (j + 1 < nt) sg.store((j + 1) & 1);
        rescale_o(o, alpha, wsf, r32, hi);
        __syncthreads();
    }
    pv(o, vb + ((nt - 1) & 1) * bstride, lane, hi, pw);
    __syncthreads();
}
__device__ __forceinline__ float stage_o(const f32x16* o, float ltot, LAS float* wsf, LAS float* stg, int lane, int r32, int hi) {
    if (hi == 0) wsf[r32] = 1.f / fmaxf(ltot, 1e-30f);
#pragma unroll
    for (int r = 0; r < 16; ++r) { const int q = crow(r, hi); const float rl = wsf[q]; stg[q * 64 + r32] = o[0][r] * rl; stg[q * 64 + 32 + r32] = o[1][r] * rl; }
    const LAS f32x4* rowp = (const LAS f32x4*)(stg + (lane >> 1) * 64 + (lane & 1) * 32); float ss = 0.f;
#pragma unroll
    for (int i = 0; i < 8; ++i) { const f32x4 v = rowp[i]; ss += (v[0] * v[0] + v[1] * v[1]) + (v[2] * v[2] + v[3] * v[3]); }
    ss += __shfl_xor(ss, 1);
    return ss;
}
__device__ __forceinline__ void store_o(const LAS float* stg, float rinv, const float* __restrict__ gain, bf16* __restrict__ dst, int lane) {
    const LAS f32x4* rowp = (const LAS f32x4*)(stg + (lane >> 1) * 64 + (lane & 1) * 32); const f32x4* gp = (const f32x4*)(gain + (lane & 1) * 32);
#if MIXED_F8
    u32x4* dp = (u32x4*)((unsigned char*)dst + (lane & 1) * 32);
#pragma unroll
    for (int i = 0; i < 2; ++i) { u32x4 o;
#pragma unroll
        for (int d = 0; d < 4; ++d) { const f32x4 a = rowp[4 * i + d] * rinv * gp[4 * i + d];
            int p = __builtin_amdgcn_cvt_pk_fp8_f32(a[0], a[1], 0, false); p = __builtin_amdgcn_cvt_pk_fp8_f32(a[2], a[3], p, true); o[d] = (unsigned)p; }
        dp[i] = o; }
#else
    u32x4* dp = (u32x4*)(dst + (lane & 1) * 32);
#pragma unroll
    for (int i = 0; i < 4; ++i) { const f32x4 a = rowp[2 * i] * rinv * gp[2 * i], b2 = rowp[2 * i + 1] * rinv * gp[2 * i + 1];
        dp[i] = u32x4{cvtpk(a[0], a[1]), cvtpk(a[2], a[3]), cvtpk(b2[0], b2[1]), cvtpk(b2[2], b2[3])}; }
#endif
}

constexpr int NB = 256, CAP = 64;
constexpr int L_IQ = 0, L_NRM = 16384, L_KV = 0, L_HIST = 32768, HSTR = 257  , L_MASK = 65792, L_CAND = 73984, L_QI = 90368, L_WSF = 98304, L_ROWSQ = 100352, L_STG = 32768;
typedef u32x2 DsaCand;
__device__ __forceinline__ int idx_bin(float v, float lo, float invw, bool filt) { const float f = (v - lo) * invw; int b = (int)f; b = b > NB - 1 ? NB - 1 : b; return (f >= 0.f) ? b : (filt ? -1 : 0); }
__device__ __forceinline__ void idx_tile(float (&idx)[16], const bf16x8 a0, const bf16x8 a1, const LAS unsigned char* iqs, const float (&w)[8], int lane) {
#pragma unroll
    for (int r = 0; r < 16; ++r) idx[r] = 0.f;
    const LAS bf16x8* fq = (const LAS bf16x8*)(iqs + lane * 16);
    bf16x8 b0 = fq[0], b1 = fq[64], n0 = fq[128], n1 = fq[192];
    f32x16 c = __builtin_amdgcn_mfma_f32_32x32x16_bf16(a0, b0, f32x16{}, 0, 0, 0);
    c = __builtin_amdgcn_mfma_f32_32x32x16_bf16(a1, b1, c, 0, 0, 0);
#pragma unroll
    for (int h = 0; h < 8; ++h) {
        f32x16 cn = c;
        if (h < 7) { b0 = n0; b1 = n1;
            if (h < 6) { n0 = fq[((h + 2) * 2 + 0) * 64]; n1 = fq[((h + 2) * 2 + 1) * 64]; }
            cn = __builtin_amdgcn_mfma_f32_32x32x16_bf16(a0, b0, f32x16{}, 0, 0, 0);
            cn = __builtin_amdgcn_mfma_f32_32x32x16_bf16(a1, b1, cn, 0, 0, 0); }
#pragma unroll
        for (int r = 0; r < 16; ++r) idx[r] = fmaf(w[h], fmaxf(c[r], 0.f), idx[r]);
        c = cn;
        __builtin_amdgcn_sched_barrier(0);
    }
#pragma unroll
    for (int r = 0; r < 16; ++r) idx[r] *= IDX_SCALE;
}
__device__ __forceinline__ void dsa_unit(LAS unsigned char* L, const bf16* __restrict__ act, const float* __restrict__ mix_gain, bf16* __restrict__ mixed, DsaCand* __restrict__ gcand, float* __restrict__ gidx, int b, int qt) {
    int tid = threadIdx.x; asm volatile("" : "+v"(tid));
    const int lane = tid & 63, r32 = lane & 31, hi = lane >> 5; const int w = __builtin_amdgcn_readfirstlane(tid >> 6);
    LAS unsigned* hist = (LAS unsigned*)(L + L_HIST); LAS unsigned* mask = (LAS unsigned*)(L + L_MASK); LAS DsaCand* cand = (LAS DsaCand*)(L + L_CAND);
    LAS unsigned* q_cnt = (LAS unsigned*)(L + L_QI); LAS int* q_B = (LAS int*)(L + L_QI + 128); LAS int* q_need = (LAS int*)(L + L_QI + 256);
    LAS float* wsf = (LAS float*)(L + L_WSF) + w * 64; LAS float* rowsq = (LAS float*)(L + L_ROWSQ);
    const int tq = qt * 32 + r32; const size_t rowq = (size_t)b * SEQ + tq; const bf16* ab = act + (size_t)b * SEQ * ACT_COLS;
    bf16x8 qf[4]; u32x4 kpre, vpre;
    const bf16* kg0 = ab + (size_t)lane * ACT_COLS + C_DK + 8 * w;
    const bf16* vg0 = ab + (size_t)(16 * (w & 3) + (lane >> 2)) * ACT_COLS + C_DV + 32 * (w >> 2) + 8 * (lane & 3);
    TIC(11); TIC(20);
    {
        if (w == 0) { __builtin_amdgcn_fence(__ATOMIC_ACQUIRE, "agent"); asm volatile("s_waitcnt vmcnt(0)" ::: "memory"); }
        const bf16* ar = act + rowq * ACT_COLS;
        const bf16x8 i0 = *(const bf16x8*)(ar + C_IQ + w * 32 + 8 * hi), i1 = *(const bf16x8*)(ar + C_IQ + w * 32 + 16 + 8 * hi);
        const u32x4 wv = *(const u32x4*)(ar + C_IW);
        for (int i = tid; i < (L_CAND - L_HIST) / 16; i += NT) ((LAS u32x4*)(L + L_HIST))[i] = u32x4{0u, 0u, 0u, 0u};
        if (tid < 128) ((LAS unsigned*)(L + L_QI))[tid] = (tid >= 32 && tid < 64) ? 0xFFFFFFFFu : 0u;
        __syncthreads();
        float wq[8];
        const LAS unsigned char* iqs = L + L_IQ; LAS float* nrm = (LAS float*)(L + L_NRM);
        {
            *(LAS bf16x8*)(L + L_IQ + ((w * 2 + 0) * 64 + lane) * 16) = i0; *(LAS bf16x8*)(L + L_IQ + ((w * 2 + 1) * 64 + lane) * 16) = i1;
            float n2 = 0.f;
#pragma unroll
            for (int j = 0; j < 8; ++j) { const float a = __uint_as_float(((unsigned)(unsigned short)i0[j]) << 16), c = __uint_as_float(((unsigned)(unsigned short)i1[j]) << 16); n2 += a * a + c * c; }
            n2 += __shfl_xor(n2, 32);
            if (hi == 0) nrm[w * 32 + r32] = n2;
        }
        {
#pragma unroll
          for (int e = 0; e < 4; ++e) { wq[2 * e] = __uint_as_float(wv[e] << 16); wq[2 * e + 1] = __uint_as_float(wv[e] & 0xffff0000u); } }
        __syncthreads();
        TOC(20);
        float lo = 0.f, invw = 0.f; bool filtF = true;
        if (qt >= 8) {
            float sk2;
            { const bf16x8 k0 = *(const bf16x8*)(ar + C_IK + 8 * hi), k1 = *(const bf16x8*)(ar + C_IK + 16 + 8 * hi); float s = 0.f;
#pragma unroll
              for (int j = 0; j < 8; ++j) { const float a = __uint_as_float(((unsigned)(unsigned short)k0[j]) << 16), c = __uint_as_float(((unsigned)(unsigned short)k1[j]) << 16); s += a * a + c * c; }
              sk2 = wave_sum(s) * (1.f / 1024.f); }
            float sm = 0.f, sv = 0.f;
#pragma unroll
            for (int h = 0; h < 8; ++h) { const float n2 = nrm[h * 32 + r32]; sm += wq[h] * sqrtf(n2); sv += wq[h] * wq[h] * n2; }
            const float sk = sqrtf(sk2), mu = IDX_SCALE * sk * 0.3989423f * sm, sig = fmaxf(IDX_SCALE * sk * sqrtf(0.3408f * sv), 1e-20f);
            const float tail = fminf(1.f, 700.f / (float)(tq + 1));
            const float zq = tail < 0.95f ? -__logf(tail / (1.f - tail)) * (1.f / 1.702f) : -6.f;
            LAS unsigned* q_fail = (LAS unsigned*)(L + L_QI + 384);
            for (int attempt = 0; attempt < 2; ++attempt) {
                const bool filt = attempt == 0; filtF = filt;
                lo = mu + (filt ? zq : -6.f) * sig; invw = (float)NB / ((mu + 6.f * sig) - lo);
                if (attempt == 1) { for (int i = tid; i < (L_MASK - L_HIST) / 16; i += NT) ((LAS u32x4*)(L + L_HIST))[i] = u32x4{0u, 0u, 0u, 0u}; __syncthreads(); }
                TIC(21);
                for (int repH = 0; repH < ((PROBE_DUP == 28) ? 2 : 1); ++repH) {
                    const float lo_h = (PROBE_DUP == 28 && repH == 0) ? 3.0e38f : lo;
                    const bf16* ikp = ab + (size_t)r32 * ACT_COLS + C_IK + 8 * hi;
                    bf16x8 a0 = *(const bf16x8*)(ikp + (size_t)w * 32 * ACT_COLS), a1 = *(const bf16x8*)(ikp + (size_t)w * 32 * ACT_COLS + 16);
                    for (int kt = w; kt <= qt; kt += 8) {
                        const bf16x8 c0 = a0, c1 = a1;
                        if (kt + 8 <= qt) { a0 = *(const bf16x8*)(ikp + (size_t)(kt + 8) * 32 * ACT_COLS); a1 = *(const bf16x8*)(ikp + (size_t)(kt + 8) * 32 * ACT_COLS + 16); }
                        float idx[16]; idx_tile(idx, c0, c1, iqs, wq, lane);
                        if (filt) { f32x4* gp = (f32x4*)(gidx + ((size_t)kt * 64 + lane) * 16);
#pragma unroll
                            for (int i = 0; i < 4; ++i) gp[i] = f32x4{idx[4 * i], idx[4 * i + 1], idx[4 * i + 2], idx[4 * i + 3]}; }
                        const int lim = tq - kt * 32 - 4 * hi;
#pragma unroll
                        for (int r = 0; r < 16; ++r) { const int bn = idx_bin(idx[r], lo_h, invw, filt);
                            if (crow(r, 0) <= lim && bn >= 0) { __hip_atomic_fetch_add(hist + r32 * HSTR + bn, 1u, __ATOMIC_RELAXED, __HIP_MEMORY_SCOPE_WORKGROUP);
#if PROBE_DUP == 26
                                __hip_atomic_fetch_add((LAS unsigned*)(L + 17408) + tid * 7 + (bn % 7), 1u, __ATOMIC_RELAXED, __HIP_MEMORY_SCOPE_WORKGROUP);
#endif
#if PROBE_DUP == 27
                                { LAS unsigned* pp = (LAS unsigned*)(L + 17408) + tid * 7 + (bn % 7); *pp = *pp + 1u; }
#endif
                            } }
                    }
                }
                asm volatile("s_waitcnt vmcnt(0)" ::: "memory");
                __syncthreads();
                TOC(21); TIC(22);
                {
                    const int grp = lane >> 4, sl = lane & 15, q = w * 4 + grp; const LAS unsigned* hrow = hist + q * HSTR + 16 * sl;
                    int c[16];
#pragma unroll
                    for (int i = 0; i < 16; ++i) c[i] = (int)hrow[i];
                    int cl = 0;
#pragma unroll
                    for (int i = 0; i < 16; ++i) cl += c[i];
                    int S = cl;
#pragma unroll
                    for (int o = 1; o < 16; o <<= 1) { const int v = __shfl_down(S, o, 16); if (sl + o < 16) S += v; }
                    const unsigned long long bal = __ballot(S >= IDX_TOPK);
                    const unsigned gb = (unsigned)(bal >> (16 * grp)) & 0xFFFFu;
                    if (gb == 0u) { if (sl == 0) q_fail[0] = 1u; }
                    else {
                        const int Lh = 31 - __clz((int)gb);
                        int above = S - cl, Bq = -1, ca = 0;
#pragma unroll
                        for (int i = 15; i >= 0; --i) { if (Bq < 0) { if (above + c[i] >= IDX_TOPK) { Bq = 16 * sl + i; ca = above; } else above += c[i]; } }
                        if (sl == Lh) { q_B[q] = Bq; q_need[q] = IDX_TOPK - ca; }
                    }
                }
                __syncthreads();
                TOC(22);
                const bool failed = q_fail[0] != 0u;
                if (!failed || attempt == 1) break;
                __syncthreads();
                if (tid == 0) q_fail[0] = 0u;
            }
        }
        TIC(23);
        const int Bq = q_B[r32];
        if (qt >= 8) {
            const f32x4* gp0 = (const f32x4*)(gidx + (size_t)lane * 16);
            f32x4 v0 = gp0[(size_t)w * 256], v1 = gp0[(size_t)w * 256 + 1], v2 = gp0[(size_t)w * 256 + 2], v3 = gp0[(size_t)w * 256 + 3];
            for (int kt = w; kt <= qt; kt += 8) {
                const float idx[16] = {v0[0], v0[1], v0[2], v0[3], v1[0], v1[1], v1[2], v1[3], v2[0], v2[1], v2[2], v2[3], v3[0], v3[1], v3[2], v3[3]};
                if (kt + 8 <= qt) { const f32x4* gn = gp0 + (size_t)(kt + 8) * 256; v0 = gn[0]; v1 = gn[1]; v2 = gn[2]; v3 = gn[3]; }
                unsigned word = 0u; const int lim = tq - kt * 32 - 4 * hi;
#pragma unroll
                for (int r = 0; r < 16; ++r) {
                    if (crow(r, 0) <= lim) { const int bn = idx_bin(idx[r], lo, invw, filtF);
                        if (bn > Bq) word |= 1u << crow(r, 0);
                        else if (bn == Bq) { const unsigned slot = __hip_atomic_fetch_add(q_cnt + r32, 1u, __ATOMIC_RELAXED, __HIP_MEMORY_SCOPE_WORKGROUP); const DsaCand cnd = {__float_as_uint(idx[r]), (unsigned)(kt * 32 + crow(r, hi))};
                            if (slot < (unsigned)CAP) cand[r32 * CAP + slot] = cnd;
                            gcand[(size_t)r32 * SEQ + slot] = cnd; } } }
                if (word) __hip_atomic_fetch_or(mask + r32 * 64 + kt, word << (4 * hi), __ATOMIC_RELAXED, __HIP_MEMORY_SCOPE_WORKGROUP);
            }
        } else {
            for (int kt = w; kt <= qt; kt += 8) { const int lim = tq - kt * 32 - 4 * hi; unsigned word = 0u;
#pragma unroll
                for (int r = 0; r < 16; ++r) if (crow(r, 0) <= lim) word |= 1u << crow(r, 0);
                if (word) __hip_atomic_fetch_or(mask + r32 * 64 + kt, word << (4 * hi), __ATOMIC_RELAXED, __HIP_MEMORY_SCOPE_WORKGROUP); }
        }
        asm volatile("s_waitcnt vmcnt(0)" ::: "memory");
        __syncthreads();
        TOC(23); TIC(24);
        { const bf16* qp = ab + (size_t)tq * ACT_COLS + C_DQ + w * 64 + 8 * hi;
#pragma unroll
          for (int d0 = 0; d0 < 4; ++d0) qf[d0] = *(const bf16x8*)(qp + d0 * 16);
          kpre = *(const u32x4*)kg0; vpre = *(const u32x4*)vg0; }
#pragma unroll 1
        for (int qq = 0; qq < ((PROBE_DUP == 29) ? 8 : 4); ++qq) {
            const int q = w * 4 + (qq & 3); const int nc = (int)q_cnt[q], need = q_need[q];
            if (nc <= CAP) {
                DsaCand me = {0u, 0u}; if (lane < nc) me = cand[q * CAP + lane];
                const float mv = __uint_as_float(me[0]); int rk = 0;
                for (int j = 0; j < nc; ++j) { const float ov = __uint_as_float((unsigned)__builtin_amdgcn_readlane((int)me[0], j)); const unsigned ok = (unsigned)__builtin_amdgcn_readlane((int)me[1], j);
                    rk += (ov > mv || (ov == mv && ok < me[1])) ? 1 : 0; }
                if (lane < nc && rk < need) __hip_atomic_fetch_or(mask + q * 64 + (me[1] >> 5), 1u << (me[1] & 31u), __ATOMIC_RELAXED, __HIP_MEMORY_SCOPE_WORKGROUP);
            } else {
                const unsigned long long* gc = (const unsigned long long*)(gcand + (size_t)q * SEQ);
                for (int i0 = 0; i0 < nc; i0 += 64) { const int i = i0 + lane;
                    if (i < nc) { const unsigned long long me = __hip_atomic_load(gc + i, __ATOMIC_RELAXED, __HIP_MEMORY_SCOPE_AGENT); const float mv = __uint_as_float((unsigned)me); const unsigned mk = (unsigned)(me >> 32); int rk = 0;
                        for (int j = 0; j < nc; ++j) { const unsigned long long ot = __hip_atomic_load(gc + j, __ATOMIC_RELAXED, __HIP_MEMORY_SCOPE_AGENT); const float ov = __uint_as_float((unsigned)ot); const unsigned ok = (unsigned)(ot >> 32);
                            rk += (ov > mv || (ov == mv && ok < mk)) ? 1 : 0; }
                        if (rk < need) __hip_atomic_fetch_or(mask + q * 64 + (mk >> 5), 1u << (mk & 31u), __ATOMIC_RELAXED, __HIP_MEMORY_SCOPE_WORKGROUP); } }
            }
        }
        __syncthreads();
    }
    TOC(24); TOC(11);
    TIC(12);
    const int ntile = (qt >> 1) + 1;
    struct DsaStg { const bf16* kg; const bf16* vg; LAS unsigned char* kdst; u32x4 kreg, vreg;
        __device__ __forceinline__ void load(int t) { kreg = *(const u32x4*)(kg + (size_t)t * 64 * ACT_COLS); vreg = *(const u32x4*)(vg + (size_t)t * 64 * ACT_COLS); }
        __device__ __forceinline__ void store(int ks, int vs) { *(LAS u32x4*)(kdst + ks * 8192) = kreg; *(LAS u32x4*)(kdst + 16384 + vs * 8192) = vreg; }
        __device__ __forceinline__ void load_after() {} };
    struct DsaMask { const LAS unsigned* mrow; int hi;
        __device__ __forceinline__ void operator()(f32x16& c0, f32x16& c1, int t, float negm) const { cinit_splat(c0, negm); cinit_splat(c1, negm); }
        __device__ __forceinline__ void post(f32x16& p0, f32x16& p1, int t) const { const u32x2 mw = *(const LAS u32x2*)(mrow + 2 * t); mask_bits(p0, mw[0], hi); mask_bits(p1, mw[1], hi); } };
    DsaStg sg; sg.kg = kg0; sg.vg = vg0; sg.kreg = kpre; sg.vreg = vpre;
    sg.kdst = L + L_KV + w * 1024 + lane * 16;
    DsaMask mk{mask + r32 * 64, hi};
    float m = 0.f, l = 0.f; f32x16 o[2]; o[0] = f32x16{}; o[1] = f32x16{};
    flash_loop_r(0, ntile, sg, mk, qf, L + L_KV, 8192, L + L_KV + 16384, 8192, m, l, o, wsf, lane, r32, hi, true);
    const float ltot = l + __shfl_xor(l, 32);
    LAS float* stg = (LAS float*)(L + L_STG) + w * 2048;
    const float ss = stage_o(o, ltot, wsf, stg, lane, r32, hi);
    if ((lane & 1) == 0) rowsq[w * 32 + (lane >> 1)] = ss;
    __syncthreads();
    float tot = 0.f;
#pragma unroll
    for (int h = 0; h < 8; ++h) tot += rowsq[h * 32 + (lane >> 1)];
    const float rinv = rsqrtf(tot * (1.f / 512.f) + LN_EPS);
    store_o(stg, rinv, mix_gain + w * 64, MIXED_F8 ? (bf16*)((unsigned char*)mixed + ((size_t)b * SEQ + qt * 32 + (lane >> 1)) * D_MODEL + w * 64) : mixed + ((size_t)b * SEQ + qt * 32 + (lane >> 1)) * D_MODEL + w * 64, lane);
    __syncthreads();
    TOC(12);
}
}


namespace cmp {
using att::bf16x8; using att::f32x16; using att::crow; using att::cvtpk;
__device__ __forceinline__ void compress_unit(LAS unsigned char* L, const bf16* __restrict__ act, const bf16* __restrict__ w1t, const bf16* __restrict__ w2t, const float* __restrict__ bias1,
                                              bf16* __restrict__ kcb, float* __restrict__ kcf, int u) {
    const int tid = threadIdx.x, lane = tid & 63, r32 = lane & 31, hi = lane >> 5; const int w = __builtin_amdgcn_readfirstlane(tid >> 6);
    const int cb = u & 3, g = (u >> 2) & 1, b = (u >> 3) & 15, kv = u >> 7;
    const int c = cb * 32 + r32, cc = c < N_C ? c : N_C - 1;
    LAS float* part = (LAS float*)L;
    {
        const bf16* arow = act + ((size_t)b * SEQ + cc * CMP_STRIDE) * ACT_COLS + (kv ? C_VCM : C_KCM) + g * 64 + 8 * hi;
        const bf16* wrow = w1t + ((size_t)kv * CMP_HIDDEN + r32) * 2048 + 8 * hi;
        f32x16 acc[4]; acc[0] = f32x16{}; acc[1] = f32x16{}; acc[2] = f32x16{}; acc[3] = f32x16{};
#pragma unroll 4
        for (int i = 0; i < 16; ++i) { const int s = 16 * w + i;
            const bf16x8 bfr_ = *(const bf16x8*)(arow + (size_t)(s >> 2) * ACT_COLS + 16 * (s & 3));
#pragma unroll
            for (int nb = 0; nb < 4; ++nb) { const bf16x8 af = *(const bf16x8*)(wrow + (size_t)nb * 32 * 2048 + 16 * s); acc[nb] = __builtin_amdgcn_mfma_f32_32x32x16_bf16(af, bfr_, acc[nb], 0, 0, 0); } }
#pragma unroll
        for (int nb = 0; nb < 4; ++nb)
#pragma unroll
            for (int r = 0; r < 16; ++r) part[((w * 4 + nb) * 16 + r) * 64 + lane] = acc[nb][r];
    }
    __syncthreads();
    f32x16 acc2[2]; acc2[0] = f32x16{}; acc2[1] = f32x16{};
    {
        const int nb = w >> 1, s2 = w & 1; float x[8];
#pragma unroll
        for (int j = 0; j < 8; ++j) { const int r = 8 * s2 + j; float a = 0.f;
#pragma unroll
            for (int p = 0; p < 8; ++p) a += part[((p * 4 + nb) * 16 + r) * 64 + lane];
            a += bias1[kv * CMP_HIDDEN + 32 * nb + crow(r, hi)];
            const float uu = 0.7978845608028654f * (a + 0.044715f * a * a * a); x[j] = 0.5f * a * (1.f + tanhf(uu)); }
        const att::u32x4 xb = {cvtpk(x[0], x[1]), cvtpk(x[2], x[3]), cvtpk(x[4], x[5]), cvtpk(x[6], x[7])};
#pragma unroll
        for (int db = 0; db < 2; ++db) { const bf16* wp = w2t + ((size_t)kv * 64 + 32 * db + r32) * CMP_HIDDEN + 32 * nb + 16 * s2 + 4 * hi;
            const att::u32x2 lo = *(const att::u32x2*)wp, hh = *(const att::u32x2*)(wp + 8);
            const att::u32x4 af = {lo[0], lo[1], hh[0], hh[1]};
            acc2[db] = __builtin_amdgcn_mfma_f32_32x32x16_bf16(__builtin_bit_cast(bf16x8, af), __builtin_bit_cast(bf16x8, xb), acc2[db], 0, 0, 0); }
    }
    __syncthreads();
#pragma unroll
    for (int db = 0; db < 2; ++db)
#pragma unroll
        for (int r = 0; r < 16; ++r) part[((w * 2 + db) * 16 + r) * 64 + lane] = acc2[db][r];
    __syncthreads();
#pragma unroll
    for (int i = 0; i < 4; ++i) { const int e = tid + i * NT;
        const int ln = e & 63, r = (e >> 6) & 15, db = e >> 10; float a = 0.f;
#pragma unroll
        for (int p = 0; p < 8; ++p) a += part[((p * 2 + db) * 16 + r) * 64 + ln];
        const int c2 = cb * 32 + (ln & 31), d = 32 * db + crow(r, ln >> 5);
        const float v = c2 < N_C ? a : 0.f;
        kcb[(((size_t)kv * BATCH + b) * 128 + c2) * 128 + g * 64 + d] = (bf16)f2bf(v);
        if (kcf && c2 < N_C) kcf[(size_t)kv * BATCH * N_C * 128 + ((size_t)(b * N_C + c2) * 2 + g) * 64 + d] = bfr(v); }
    __syncthreads();
}
}

namespace att {
constexpr int N_SLAB = 65536, N_OUT = 65536, N_WSF = 135168, N_ROWSQ = 137216, N_SEL = 138240, N_IMPF = 139264;
struct KvStage { u32x4 k[2], v[2]; };
__device__ __forceinline__ void kv_load(KvStage& st, const bf16* __restrict__ kbase, const bf16* __restrict__ vbase, int pitch, int key0, int w, int lane) {
    const bf16* kp = kbase + (size_t)(key0 + lane) * pitch + 8 * w; const bf16* vp = vbase + (size_t)(key0 + 16 * (w & 3) + (lane >> 2)) * pitch + 32 * (w >> 2) + 8 * (lane & 3);
    st.k[0] = *(const u32x4*)kp; st.k[1] = *(const u32x4*)(kp + 64); st.v[0] = *(const u32x4*)vp; st.v[1] = *(const u32x4*)(vp + 64);
}
__device__ __forceinline__ void kv_store(const KvStage& st, LAS unsigned char* slot, int w, int lane) {
    LAS unsigned char* d = slot + w * 1024 + lane * 16;
    *(LAS u32x4*)d = st.k[0]; *(LAS u32x4*)(d + 8192) = st.k[1]; *(LAS u32x4*)(d + 16384) = st.v[0]; *(LAS u32x4*)(d + 24576) = st.v[1];
}
__device__ __forceinline__ void pack_p(u32x4 (&pw)[4], const f32x16& p0, const f32x16& p1) {
    pw[0] = u32x4{cvtpk(p0[0], p0[1]), cvtpk(p0[2], p0[3]), cvtpk(p0[4], p0[5]), cvtpk(p0[6], p0[7])};
    pw[1] = u32x4{cvtpk(p0[8], p0[9]), cvtpk(p0[10], p0[11]), cvtpk(p0[12], p0[13]), cvtpk(p0[14], p0[15])};
    pw[2] = u32x4{cvtpk(p1[0], p1[1]), cvtpk(p1[2], p1[3]), cvtpk(p1[4], p1[5]), cvtpk(p1[6], p1[7])};
    pw[3] = u32x4{cvtpk(p1[8], p1[9]), cvtpk(p1[10], p1[11]), cvtpk(p1[12], p1[13]), cvtpk(p1[14], p1[15])};
}
template <bool FIRST> __device__ __forceinline__ void accum_out(LAS float* OUTw, const f32x16* o, float fac, LAS float* wsf, int r32, int hi) {
    if (hi == 0) wsf[r32] = fac;
#pragma unroll
    for (int r = 0; r < 16; ++r) { const int q = crow(r, hi); const float f = wsf[q];
        if (FIRST) { OUTw[q * 64 + r32] = f * o[0][r]; OUTw[q * 64 + 32 + r32] = f * o[1][r]; }
        else { OUTw[q * 64 + r32] += f * o[0][r]; OUTw[q * 64 + 32 + r32] += f * o[1][r]; } }
}
__device__ __forceinline__ void nsa_unit(LAS unsigned char* L, const bf16* __restrict__ act, const bf16* __restrict__ kcb, const float* __restrict__ mix_gain, bf16* __restrict__ mixed, int b, int qt,
                                         bool pre_valid  , volatile LAS unsigned* nextp  , bool& prefetched) {
    int tid = threadIdx.x; asm volatile("" : "+v"(tid));
    const int lane = tid & 63, r32 = lane & 31, hi = lane >> 5; const int w = __builtin_amdgcn_readfirstlane(tid >> 6); const int g = w >> 2;
    LAS float* slab = (LAS float*)(L + N_SLAB); LAS float* OUTw = (LAS float*)(L + N_OUT) + w * 2048; LAS float* wsf = (LAS float*)(L + N_WSF) + w * 64;
    LAS float* rowsq = (LAS float*)(L + N_ROWSQ); LAS unsigned* selmask = (LAS unsigned*)(L + N_SEL); LAS float* impf = (LAS float*)(L + N_IMPF);
    const int tq = qt * 32 + r32; const size_t rowq = (size_t)b * SEQ + tq; const bf16* ab = act + (size_t)b * SEQ * ACT_COLS;
    bf16x8 qf[4];
    { const bf16* qp = act + rowq * ACT_COLS + C_NQ + w * 64 + 8 * hi;
#pragma unroll
      for (int d0 = 0; d0 < 4; ++d0) qf[d0] = *(const bf16x8*)(qp + d0 * 16); }
    const bf16* gp = act + rowq * ACT_COLS + C_NG + w * 3;
    const float gate0 = bf2f(gp[0]);
    LAS unsigned char* slot0 = L; LAS unsigned char* slot1 = L + 32768;
    f32x16 o[2];
    struct NsaStg { const bf16* kbase; const bf16* vbase; const bf16* kafter; const bf16* vafter; int key_after; LAS unsigned char* slot0; int w, lane; KvStage st;
        __device__ __forceinline__ void load(int t) { kv_load(st, kbase, vbase, ACT_COLS, t * 64, w, lane); }
        __device__ __forceinline__ void store(int bsel) { kv_store(st, slot0 + bsel * 32768, w, lane); }
        __device__ __forceinline__ void load_after() { if (kafter) kv_load(st, kafter, vafter, ACT_COLS, key_after, w, lane); } };
    NsaStg sg; sg.slot0 = slot0; sg.w = w; sg.lane = lane;
    TIC(13);
    {
        const bf16* kc = kcb + (size_t)b * 128 * 128; const bf16* vc = kcb + (size_t)(BATCH + b) * 128 * 128;
        if (!pre_valid) { KvStage a0, a1; kv_load(a0, kc, vc, 128, 0, w, lane); kv_load(a1, kc, vc, 128, 64, w, lane); kv_store(a0, slot0, w, lane); kv_store(a1, slot1, w, lane); }
        __syncthreads();
        kv_load(sg.st, ab + C_KSL, ab + C_VSL, ACT_COLS, 0, w, lane);
        f32x16 p[4];
        p[0] = f32x16{}; p[1] = f32x16{}; p[2] = f32x16{}; p[3] = f32x16{};
        qkt(p[0], p[1], slot0 + g * 8192, qf, r32, hi); qkt(p[2], p[3], slot1 + g * 8192, qf, r32, hi);
        const int n_adm = tq >= 31 ? min((tq - 31) / 16 + 1, N_C) : 0;
        float rm = NEG_INF;
#pragma unroll
        for (int u = 0; u < 4; ++u)
#pragma unroll
            for (int r = 0; r < 16; ++r) { const int c = 32 * u + crow(r, hi); p[u][r] = c < n_adm ? p[u][r] : NEG_INF; rm = fmaxf(rm, p[u][r]); }
        rm = fmaxf(rm, __shfl_xor(rm, 32));
        const float mc = rm > NEG_INF ? rm : 0.f; float s = 0.f;
#pragma unroll
        for (int u = 0; u < 4; ++u)
#pragma unroll
            for (int r = 0; r < 16; ++r) { p[u][r] = ex2(p[u][r] - mc); s += p[u][r]; }
        s += __shfl_xor(s, 32);
        const float inv = 1.f / fmaxf(s, 1e-30f);
#pragma unroll
        for (int u = 0; u < 4; ++u)
#pragma unroll
            for (int r = 0; r < 16; ++r) p[u][r] *= inv;
        float xl[16];
#pragma unroll
        for (int u = 0; u < 4; ++u)
#pragma unroll
            for (int k = 0; k < 4; ++k) xl[u * 4 + k] = __shfl_xor(p[u][4 * k + 3], 32);
#pragma unroll
        for (int u = 0; u < 4; ++u)
#pragma unroll
            for (int k = 0; k < 4; ++k) {
                const float A = (p[u][4 * k] + p[u][4 * k + 1]) + (p[u][4 * k + 2] + p[u][4 * k + 3]);
                const float xprev = (u * 4 + k) > 0 ? xl[(u * 4 + k) > 0 ? u * 4 + k - 1 : 0] : 0.f;
                const float val = A + (hi ? xl[u * 4 + k] : xprev);
                slab[(w * 32 + r32) * 32 + 8 * u + 2 * k + hi] = val;
            }
        u32x4 pw[4]; o[0] = f32x16{}; o[1] = f32x16{};
        pack_p(pw, p[0], p[1]); pv(o, slot0 + 16384 + g * 8192, lane, hi, pw);
        pack_p(pw, p[2], p[3]); pv(o, slot1 + 16384 + g * 8192, lane, hi, pw);
        __syncthreads();
#pragma unroll
        for (int i = 0; i < 4; ++i) { const int e = tid + i * NT, j = e & 31, q = (e >> 5) & 31, gg = e >> 10;
            float v = ((slab[((gg * 4 + 0) * 32 + q) * 32 + j] + slab[((gg * 4 + 1) * 32 + q) * 32 + j]) + slab[((gg * 4 + 2) * 32 + q) * 32 + j]) + slab[((gg * 4 + 3) * 32 + q) * 32 + j];
            const int cur = (qt * 32 + q) >> 6;
            if (j == 0 || j == cur || j == cur - 1) v = 1.0e4f;
            if (j > cur) v = -1.0f;
            impf[e] = v; }
        __syncthreads();
#pragma unroll
        for (int i = 0; i < 4; ++i) { const int gq = i * 16 + (tid >> 5), j = tid & 31; const float v = impf[gq * 32 + j]; int rk = 0;
#pragma unroll
            for (int i2 = 0; i2 < 32; ++i2) { const float vi = impf[gq * 32 + i2]; rk += (vi > v || (vi == v && i2 < j)) ? 1 : 0; }
            const unsigned long long bal = __ballot(rk < SLC_COUNT);
            if ((tid & 31) == 0) selmask[gq] = (lane < 32) ? (unsigned)bal : (unsigned)(bal >> 32); }
        __syncthreads();
        accum_out<true>(OUTw, o, gate0, wsf, r32, hi);
    }
    TOC(13); TIC(14);
    const int T0 = (qt * 32 - 511) > 0 ? ((qt * 32 - 511) >> 6) : 0, T1 = qt >> 1;
    {
        struct SlcMask { unsigned sel; int tq, hi, last;
            __device__ __forceinline__ void operator()(f32x16& c0, f32x16& c1, int t, float negm) const { cinit_splat(c0, negm); cinit_splat(c1, negm); }
            __device__ __forceinline__ void post(f32x16& p0, f32x16& p1, int t) const { const bool on = (sel >> t) & 1u;
                if (t == last) { const int lim = on ? tq - t * 64 - 4 * hi : -1;
#pragma unroll
                    for (int r = 0; r < 16; ++r) { p0[r] = (crow(r, 0) <= lim) ? p0[r] : NEG_INF; p1[r] = (crow(r, 0) + 32 <= lim) ? p1[r] : NEG_INF; }
                } else {
#pragma unroll
                    for (int r = 0; r < 16; ++r) { p0[r] = on ? p0[r] : NEG_INF; p1[r] = on ? p1[r] : NEG_INF; }
                } } };
        const int ntile = (qt >> 1) + 1;
        sg.kbase = ab + C_KSL; sg.vbase = ab + C_VSL; sg.kafter = ab + C_KWN; sg.vafter = ab + C_VWN; sg.key_after = T0 * 64;
        SlcMask mk{selmask[g * 32 + r32], tq, hi, ntile - 1}; const float gate1 = bf2f(gp[1]);
        float m = 0.f, l = 0.f; o[0] = f32x16{}; o[1] = f32x16{};
        flash_loop_b(0, ntile, sg, mk, qf, slot0 + g * 8192, slot0 + 16384 + g * 8192, 32768, m, l, o, wsf, lane, r32, hi, true);
        const float ltot = l + __shfl_xor(l, 32);
        accum_out<false>(OUTw, o, gate1 / fmaxf(ltot, 1e-30f), wsf, r32, hi);
    }
    TOC(14); TIC(15);
    {
        struct WinMask { int tq, hi, qt;
            __device__ __forceinline__ void operator()(f32x16& c0, f32x16& c1, int t, float negm) const { cinit_splat(c0, negm); cinit_splat(c1, negm); }
            __device__ __forceinline__ void post(f32x16& p0, f32x16& p1, int t) const {
                if (t * 64 < qt * 32 - 480 || t * 64 + 63 > qt * 32) { const int lim = tq - t * 64 - 4 * hi;
#pragma unroll
                    for (int r = 0; r < 16; ++r) {
                        p0[r] = ((unsigned)(lim - crow(r, 0)) < (unsigned)WINDOW) ? p0[r] : NEG_INF; p1[r] = ((unsigned)(lim - crow(r, 0) - 32) < (unsigned)WINDOW) ? p1[r] : NEG_INF; }
                } } };
        sg.kbase = ab + C_KWN; sg.vbase = ab + C_VWN; sg.kafter = nullptr; sg.vafter = nullptr;
        WinMask mk{tq, hi, qt}; const float gate2 = bf2f(gp[2]);
        float m = 0.f, l = 0.f; o[0] = f32x16{}; o[1] = f32x16{};
        flash_loop_b(T0, T1 - T0 + 1, sg, mk, qf, slot0 + g * 8192, slot0 + 16384 + g * 8192, 32768, m, l, o, wsf, lane, r32, hi, true);
        const float ltot = l + __shfl_xor(l, 32);
        accum_out<false>(OUTw, o, gate2 / fmaxf(ltot, 1e-30f), wsf, r32, hi);
    }
    KvStage pre0, pre1;
    {
        const unsigned rn = (unsigned)__builtin_amdgcn_readfirstlane((int)*nextp); const int next_b = (rn < 2048u && (rn & 255u) >= 128u) ? (int)(2u * (rn >> 8) + (rn & 1u)) : -1;
        prefetched = next_b >= 0;
        if (next_b >= 0) { const bf16* kcn = kcb + (size_t)next_b * 128 * 128; const bf16* vcn = kcb + (size_t)(BATCH + next_b) * 128 * 128;
            kv_load(pre0, kcn, vcn, 128, 0, w, lane); kv_load(pre1, kcn, vcn, 128, 64, w, lane); }
    }
    TOC(15); TIC(16);
    float ss = 0.f;
    { const LAS f32x4* rowp = (const LAS f32x4*)(OUTw + (lane >> 1) * 64 + (lane & 1) * 32);
#pragma unroll
      for (int i = 0; i < 8; ++i) { const f32x4 v = rowp[i]; ss += (v[0] * v[0] + v[1] * v[1]) + (v[2] * v[2] + v[3] * v[3]); }
      ss += __shfl_xor(ss, 1); }
    if ((lane & 1) == 0) rowsq[w * 32 + (lane >> 1)] = ss;
    if (prefetched) { kv_store(pre0, slot0, w, lane); kv_store(pre1, slot1, w, lane); }
    __syncthreads();
    float tot = 0.f;
#pragma unroll
    for (int h = 0; h < 8; ++h) tot += rowsq[h * 32 + (lane >> 1)];
    const float rinv = rsqrtf(tot * (1.f / 512.f) + LN_EPS);
    store_o(OUTw, rinv, mix_gain + 512 + w * 64, MIXED_F8 ? (bf16*)((unsigned char*)mixed + ((size_t)b * SEQ + qt * 32 + (lane >> 1)) * D_MODEL + 512 + w * 64) : mixed + ((size_t)b * SEQ + qt * 32 + (lane >> 1)) * D_MODEL + 512 + w * 64, lane);
    __syncthreads();
    TOC(16);
}
}
struct Args { const float* in[16]; float* out; unsigned char* ws; int ph_lo, ph_hi, li, pad; };
constexpr int N_PHASES = 8;
__global__ void __launch_bounds__(NT, 2) mk_fwd(Args args) {
    extern __shared__ __attribute__((aligned(16))) unsigned char lds_raw[];
    LAS unsigned char* lds = (LAS unsigned char*)lds_raw;
    volatile LAS unsigned* MISC = (volatile LAS unsigned*)(lds + MISC_OFF);
    const int tid = threadIdx.x, lane = tid & 63, wave = __builtin_amdgcn_readfirstlane(tid >> 6);
    const int G = gridDim.x; const int vcu = (G % 8 == 0) ? ((int)blockIdx.x % 8) * (G / 8) + (int)blockIdx.x / 8 : (int)blockIdx.x;
    unsigned char* ws = args.ws;
    gu32* ctl = (gu32*)(ws + WS_CTL);
    const float* x = args.in[0]; const int* pos = (const int*)args.in[1]; const float* w_in = args.in[2]; const float* b_in = args.in[3];
    const float* cmp_pos = args.in[4]; const float* cmp_w1 = args.in[5]; const float* cmp_w2 = args.in[6]; const float* mix_gain = args.in[7];
    const float* w_out = args.in[8]; const float* ln1_g = args.in[9]; const float* ln1_b = args.in[10]; const float* w_gate = args.in[11];
    const float* w_up = args.in[12]; const float* w_down = args.in[13]; const float* ln2_g = args.in[14]; const float* ln2_b = args.in[15];
    float* out = args.out;
    float* stats1 = (float*)(ws + CTL_STATS1); float* cs = (float*)(ws + CTL_CS); float* bs = cs + 5632;
    float* rope = (float*)(ws + WS_ROPE); float* biasP = (float*)(ws + WS_BIASP);
    bf16* Wt_in = (bf16*)(ws + WS_WIN); bf16* Wt_out = (bf16*)(ws + WS_WOUT); bf16* Wt_gu = (bf16*)(ws + WS_WGU); bf16* Wt_dn = (bf16*)(ws + WS_WDN);
    float* kcvc = (float*)(ws + WS_KC); bf16* kcb = (bf16*)(ws + WS_KCB); bf16* w1t = (bf16*)(ws + WS_W1T); bf16* w2t = (bf16*)(ws + WS_W2T); float* cb1 = (float*)(ws + CTL_CB1);
    bf16* act = (bf16*)(ws + WS_ACT); bf16* actf = (bf16*)(ws + WS_ACTF); bf16* xb = (bf16*)(ws + WS_XB); bf16* mixed = (bf16*)(ws + WS_MIXED); unsigned char* v1q = ws + WS_GCAND; unsigned char* actq = ws + WS_ACTF; unsigned char* xq = ws + WS_V1B; unsigned char* Wq_in = ws + WS_WINQ;
    bf16* v1b = (bf16*)(ws + WS_V1B); bf16* v2b = (bf16*)(ws + WS_MIXED);

    for (int u = tid; u < (LDS_BYTES - LDSCTL_OFF) / 4; u += NT) ((LAS unsigned*)(lds + LDSCTL_OFF))[u] = 0u;
    __syncthreads();
#if PROBE_T >= 0
    if (blockIdx.x == 0 && tid == 0) t_acc = 0ull;
#endif
    XcdBarrier bar = xcd_barrier_post((unsigned*)(ctl + CW_BAR) + args.li * XCD_BAR_WORDS, MISC + 8);
    const int lo = args.ph_lo, hi = args.ph_hi;
#ifndef PROBE_DUP
#define PROBE_DUP -1
#endif
#define NREP(k) ((PROBE_DUP == (k)) ? 2 : 1)
#define IN(k) (lo <= (k) && (k) < hi)
#define SEAM(k) do { if (IN(k) && IN((k) + 1)) { TIC(8); TIC(60 + (k)); xcd_barrier(bar); TOC(60 + (k)); TOC(8); } } while (0)

    TIC(0);
    if (IN(0)) for (int rep = 0; rep < NREP(0); ++rep) {
        float* cs_ = (rep == NREP(0) - 1) ? cs : nullptr;
        const int gw = vcu * NWAVES + wave, NGW = G * NWAVES;
        constexpr int I_IN = 16 * 36, I_OUT = 16 * 16, I_GU = 16 * 88, I_DN = 44 * 16, I_W1 = 2 * 64, I_W2 = 2 * 2, I_INQ = INPROJ_F8 ? 16 * 16 : 0, NITEMS = I_IN + I_OUT + I_GU + I_DN + I_W1 + I_W2 + I_INQ;
        TIC(30);
        for (int it = gw; it < NITEMS; it += NGW) {
            int r = it;
            if (r < I_GU) { const int kb = r / 88, nb = r % 88, n0 = 64 * nb, pn = n0 >> 8, within = n0 & 255; const bool isup = within >= 128;
                tr64<true>(isup ? w_up : w_gate, FFN, 1024, Wt_gu, n0, 64 * kb, pn * 128 + (within & 127) + lane, ln1_g, S_GU, ln1_b, cs_, cs_ ? bs : nullptr, lane); continue; } r -= I_GU;
            if (r < I_DN) { const int kb = r / 16, nb = r % 16; tr64<true>(w_down, 1024, FFN, Wt_dn, 64 * nb, 64 * kb, 64 * nb + lane, nullptr, S_DN, nullptr, nullptr, nullptr, lane); continue; } r -= I_DN;
            if (r < I_IN) { const int kb = r / 36, nb = r % 36; tr64<false>(w_in, IN_COLS, 1024, Wt_in, 64 * nb, 64 * kb, orig_col(64 * nb + lane), nullptr, 1.f, nullptr, nullptr, nullptr, lane); continue; } r -= I_IN;
            if (r < I_OUT) { const int kb = r / 16, nb = r % 16; if (MIXED_F8) tr64<true>(w_out, 1024, 1024, Wt_out, 64 * nb, 64 * kb, 64 * nb + lane, nullptr, S_OUT, nullptr, nullptr, nullptr, lane); else tr64<false>(w_out, 1024, 1024, Wt_out, 64 * nb, 64 * kb, 64 * nb + lane, nullptr, 1.f, nullptr, nullptr, nullptr, lane); continue; } r -= I_OUT;
            if (r < I_W1) { const int kv = r >> 6, kb = (r >> 1) & 31, nb = r & 1;
                tr64<false>(cmp_w1 + (size_t)kv * 2048 * 128, 128, 2048, w1t + (size_t)kv * 128 * 2048, 64 * nb, 64 * kb, 64 * nb + lane, nullptr, 1.f, cmp_pos + kv * 2048, nullptr, cs_ ? cb1 + kv * 128 : nullptr, lane); continue; } r -= I_W1;
            if (r < I_W2) { const int kv = r >> 1, kb = r & 1; tr64<false>(cmp_w2 + (size_t)kv * 128 * 64, 64, 128, w2t + (size_t)kv * 64 * 128, 0, 64 * kb, lane, nullptr, 1.f, nullptr, nullptr, nullptr, lane); continue; } r -= I_W2;
            { const int kb = r >> 4, nq = r & 15, tile = (nq >> 2) < 2 ? (nq >> 2) : (nq >> 2) + 4, n0 = tile * 256 + 64 * (nq & 3);
              tr64<true>(w_in, IN_COLS, 1024, Wq_in, n0, 64 * kb, orig_col(n0 + lane), nullptr, S_IN, nullptr, nullptr, nullptr, lane); }
        }
        TOC(30); TIC(31);
        for (int m0 = gw * 4; m0 < T; m0 += NGW * 4) {
            f32x4 v[4][2][2];
#pragma unroll
            for (int rr = 0; rr < 4; ++rr)
#pragma unroll
                for (int j = 0; j < 2; ++j) { const GAS f32x4* xr = (const GAS f32x4*)(x + (size_t)(m0 + rr) * 1024 + 512 * j) + 2 * lane; v[rr][j][0] = xr[0]; v[rr][j][1] = xr[1]; }
#pragma unroll
            for (int rr = 0; rr < 4; ++rr)
#pragma unroll
                for (int j = 0; j < 2; ++j) { v4u o; o.x = pk2(v[rr][j][0].x, v[rr][j][0].y); o.y = pk2(v[rr][j][0].z, v[rr][j][0].w); o.z = pk2(v[rr][j][1].x, v[rr][j][1].y); o.w = pk2(v[rr][j][1].z, v[rr][j][1].w);
                    *((GAS v4u*)(xb + (size_t)(m0 + rr) * 1024 + 512 * j) + lane) = o;
                    if (INPROJ_F8) { typedef unsigned u2_t __attribute__((ext_vector_type(2)));
                        int p0 = __builtin_amdgcn_cvt_pk_fp8_f32(v[rr][j][0].x, v[rr][j][0].y, 0, false); p0 = __builtin_amdgcn_cvt_pk_fp8_f32(v[rr][j][0].z, v[rr][j][0].w, p0, true);
                        int p1 = __builtin_amdgcn_cvt_pk_fp8_f32(v[rr][j][1].x, v[rr][j][1].y, 0, false); p1 = __builtin_amdgcn_cvt_pk_fp8_f32(v[rr][j][1].z, v[rr][j][1].w, p1, true);
                        *((GAS u2_t*)(xq + (size_t)(m0 + rr) * 1024 + 512 * j) + lane) = u2_t{(unsigned)p0, (unsigned)p1}; } }
        }
        TOC(31); TIC(32);
        for (int i = gw * 64 + lane; i < T * 8; i += NGW * 64) {
            const float inv[8] = {1.0f, 0.19392274474868576f, 0.03760603093086393f, 0.007292664737217109f, 0.001414213562373095f, 0.0002742481756762073f, 5.318295896944988e-05f, 1.031338537721246e-05f};
            const int t = i >> 3, j = i & 7; float sn, cn; sincosf((float)pos[t] * inv[j], &sn, &cn);
            rope[2 * i] = cn; rope[2 * i + 1] = sn;
        }
        for (int i = gw * 64 + lane; i < ACT_COLS; i += NGW * 64) { const int oc = orig_col(i); biasP[i] = oc >= 0 ? b_in[oc] : 0.f; }
        TOC(32);
    }
    TOC(0);
    SEAM(0);
    TIC(1);
    if (IN(1)) for (int rep = 0; rep < NREP(1); ++rep) {
        if constexpr (INPROJ_F8) {
            { pg8::Gemm g{xb, Wt_in, T, ACT_COLS, 1024}; pg8::SubOrderB S; S.init(T, G, (int)blockIdx.x);
              pg8::EpiInProj E{act, biasP, rope, att::C2, 1.f};
              pg8::gemm_phase<pg8::EpiInProj, pg8::SubOrderB, true, true>(lds, g, S, E); }
            { pg8::Gemm g{(const bf16*)xq, (const bf16*)Wq_in, T, ACT_COLS, 1024}; pg8::SubOrderQ S{G, (int)blockIdx.x};
              pg8::EpiInProj E{act, biasP, rope, att::C2, 1.f / S_IN};
              pg8::gemm_phase<pg8::EpiInProj, pg8::SubOrderQ, true, true, true>(lds, g, S, E); }
        } else {
            pg8::Gemm g{xb, Wt_in, T, ACT_COLS, 1024}; pg8::StaticOrder S; S.init(T, ACT_COLS, G, (int)blockIdx.x);
            pg8::EpiInProj E{act, biasP, rope, att::C2, 1.f};
            pg8::gemm_phase<pg8::EpiInProj, pg8::StaticOrder, true, true>(lds, g, S, E);
        }
    }
    TOC(1);
    SEAM(1);
#if PROBE_T == 50
    unsigned long long sp_t0 = __builtin_amdgcn_s_memrealtime();
#endif
    TIC(2);
    if (IN(2)) for (int rep = 0; rep < NREP(2); ++rep) {
        gu32* cmp_cnt = ctl + 8192;
        TIC(10);
        for (int u = vcu; u < 256; u += G) { cmp::compress_unit(lds, act, w1t, w2t, cb1, kcb, nullptr, u);
            asm volatile("s_waitcnt vmcnt(0)" ::: "memory"); __syncthreads();
            if (tid == 0 && rep == NREP(2) - 1) { __builtin_amdgcn_fence(__ATOMIC_RELEASE, "agent"); asm volatile("s_waitcnt vmcnt(0)" ::: "memory"); __hip_atomic_fetch_add(cmp_cnt, 1u, RLX_AGENT); } }
        TOC(10);
        att::DsaCand* gcand = (att::DsaCand*)(ws + WS_GCAND) + (size_t)blockIdx.x * 32 * SEQ;
        float* gidx = (float*)(ws + WS_V1B) + (size_t)blockIdx.x * 65536;
        gu32* qhead = ctl + 8320;
        unsigned curq = bar.x & 7u;
#define DRAW_UNIT(dst) do { unsigned u_ = 0xFFFFFFFFu; for (int t_ = 0; t_ < 8; ++t_) { const unsigned r_ = __hip_atomic_fetch_add(qhead + 64 * curq, 1u, RLX_AGENT); if (r_ < 256u) { u_ = curq * 256u + r_; break; } curq = (curq + 1u) & 7u; } (dst) = u_; } while (0)
        if (tid == 0) DRAW_UNIT(MISC[12]);
        __syncthreads();
        bool cmp_ok = false;
        for (int k = 0;;) {
            unsigned u = (unsigned)__builtin_amdgcn_readfirstlane((int)MISC[12 + (k & 1)]);
            if (u >= 2048u) break;
            if (tid == 0) DRAW_UNIT(MISC[12 + ((k + 1) & 1)]);
            if ((u & 255u) < 128u) { att::dsa_unit(lds, act, mix_gain, mixed, gcand, gidx, (int)(2u * (u >> 8) + (u & 1u)), 63 - (int)((u & 127u) >> 1)); ++k; continue; }
            if (!cmp_ok) {
                if (tid == 0) { unsigned sp = 0; while (__hip_atomic_load(cmp_cnt, RLX_AGENT) < 256u) { __builtin_amdgcn_s_sleep(2); if (++sp > (1u << 22)) break; }
                    __builtin_amdgcn_fence(__ATOMIC_ACQUIRE, "agent"); asm volatile("s_waitcnt vmcnt(0)" ::: "memory"); }
                __syncthreads(); cmp_ok = true; }
            bool pre_valid = false;
            for (;;) {
                bool pf = false; att::nsa_unit(lds, act, kcb, mix_gain, mixed, (int)(2u * (u >> 8) + (u & 1u)), 63 - (int)((u & 127u) >> 1), pre_valid, MISC + 12 + ((k + 1) & 1), pf);
                ++k;
                if (!pf) break;
                u = (unsigned)__builtin_amdgcn_readfirstlane((int)MISC[12 + (k & 1)]); pre_valid = true;
                if (tid == 0) DRAW_UNIT(MISC[12 + ((k + 1) & 1)]);
            }
        }
#undef DRAW_UNIT
    }
    TOC(2);
#if PROBE_T == 50
    if (tid == 0) { const unsigned long long d = __builtin_amdgcn_s_memrealtime() - sp_t0; atomicMax((unsigned long long*)(ctl + 8200), d); atomicMax((unsigned long long*)(ctl + 8202), 1000000000ull - d); }
#endif
    SEAM(3);
    TIC(4);
    if (IN(4)) for (int rep = 0; rep < NREP(4); ++rep) {
        pg8::Gemm g{mixed, Wt_out, T, 1024, 1024}; pg8::StaticOrder S; S.init(T, 1024, G, (int)blockIdx.x);
        pg8::EpiOutProj E{xb, v1b, v1q, (rep == NREP(4) - 1) ? stats1 : nullptr, ALPHA, MIXED_F8 ? 1.f / S_OUT : 1.f};
        if constexpr (MIXED_F8) pg8::gemm_phase<pg8::EpiOutProj, pg8::StaticOrder, true, true, true>(lds, g, S, E); else pg8::gemm_phase<pg8::EpiOutProj, pg8::StaticOrder, true, true>(lds, g, S, E);
    }
    TOC(4);
    SEAM(4);
    TIC(5);
    if (IN(5)) for (int rep = 0; rep < NREP(5); ++rep) {
        pg8::Gemm g{(const bf16*)v1q, Wt_gu, T, 2 * FFN, 1024}; pg8::StaticOrder S; S.init(T, 2 * FFN, G, (int)blockIdx.x);
        pg8::EpiGateUp E{actf, actq, stats1, cs, bs, 1.f / S_GU};
        pg8::gemm_phase<pg8::EpiGateUp, pg8::StaticOrder, true, true, true>(lds, g, S, E);
    }
    TOC(5);
#if PROBE_T == 40
    { xcd_barrier(bar); TIC(40);
      pg8::Gemm g{(const bf16*)v1q, Wt_gu, T, 2 * FFN, 1024}; pg8::StaticOrder S; S.init(T, 2 * FFN, G, (int)blockIdx.x);
      pg8::EpiNull E{(float*)(ws + WS_MIXED)};
      pg8::gemm_phase<pg8::EpiNull, pg8::StaticOrder, true, true, true>(lds, g, S, E); TOC(40); }
#endif
    SEAM(5);
    TIC(6);
    if (IN(6)) for (int rep = 0; rep < NREP(6); ++rep) {
        pg8::Gemm g{(const bf16*)actq, Wt_dn, T, 1024, FFN}; pg8::StaticOrder S; S.init(T, 1024, G, (int)blockIdx.x);
#ifdef NO_LN2_FUSE
        pg8::EpiDown E{v1b, v2b, stats1, ln1_g, ln1_b, ALPHA, 1.f / S_DN};
        pg8::gemm_phase<pg8::EpiDown, pg8::StaticOrder, true, true, true>(lds, g, S, E);
#else
        pg8::RowStatsX rx{(unsigned long long*)(ws + WS_XCH), (unsigned*)(ctl + 16384), lds + 135168, LN_EPS};
        pg8::EpiDownLn E{v1b, out, stats1, ln1_g, ln1_b, ln2_g, ln2_b, ALPHA, 1.f / S_DN, rx};
        pg8::gemm_phase<pg8::EpiDownLn, pg8::StaticOrder, true, true, true>(lds, g, S, E);
#endif
    }
    TOC(6);
#ifdef NO_LN2_FUSE
    SEAM(6);
#endif
    TIC(7);
#ifdef NO_LN2_FUSE
    if (IN(7)) for (int rep = 0; rep < NREP(7); ++rep) {
        const int gw = vcu * NWAVES + wave, NGW = G * NWAVES;
        for (int m = gw; m < T; m += NGW) {
            const GAS v4u* xr = (const GAS v4u*)(v2b + (size_t)m * 1024) + lane; GAS f32x4* xw = (GAS f32x4*)(out + (size_t)m * 1024) + 2 * lane; f32x4 v[4]; float s = 0.f;
#pragma unroll
            for (int j = 0; j < 2; ++j) { const v4u t = xr[64 * j];
                v[2 * j] = f32x4{__uint_as_float(t[0] << 16), __uint_as_float(t[0] & 0xffff0000u), __uint_as_float(t[1] << 16), __uint_as_float(t[1] & 0xffff0000u)};
                v[2 * j + 1] = f32x4{__uint_as_float(t[2] << 16), __uint_as_float(t[2] & 0xffff0000u), __uint_as_float(t[3] << 16), __uint_as_float(t[3] & 0xffff0000u)}; }
#pragma unroll
            for (int j = 0; j < 4; ++j) s += (v[j].x + v[j].y) + (v[j].z + v[j].w);
            const float mean = wave_sum(s) * (1.f / 1024.f); float s2 = 0.f;
#pragma unroll
            for (int j = 0; j < 4; ++j) { v[j] = v[j] - mean; s2 += (v[j].x * v[j].x + v[j].y * v[j].y) + (v[j].z * v[j].z + v[j].w * v[j].w); }
            const float rstd = rsqrtf(wave_sum(s2) * (1.f / 1024.f) + LN_EPS);
#pragma unroll
            for (int j = 0; j < 4; ++j) { const int ci = 2 * lane + (j & 1) + 128 * (j >> 1);
                const f32x4 gg = *((const f32x4*)ln2_g + ci), bb = *((const f32x4*)ln2_b + ci); xw[(j & 1) + 128 * (j >> 1)] = v[j] * rstd * gg + bb; }
        }
    }
#endif
    TOC(7);
#if PROBE_T == 50
    if (blockIdx.x == 0 && tid == 0) { const unsigned long long mx = __hip_atomic_load((unsigned long long*)(ctl + 8200), RLX_AGENT), mn = 1000000000ull - __hip_atomic_load((unsigned long long*)(ctl + 8202), RLX_AGENT); t_acc = mx - mn; }
#endif
#if PROBE_T >= 0
    if (blockIdx.x == 0 && tid == 0) { const unsigned long long t0 = __builtin_amdgcn_s_memrealtime(); while (__builtin_amdgcn_s_memrealtime() - t0 < t_acc) __builtin_amdgcn_s_sleep(8); }
#endif
#undef IN
#undef SEAM
}

extern "C" void kernel_launch(void* const* d_in, const int* in_sizes, int n_in, void* d_out, int out_size, void* d_ws, size_t ws_size, hipStream_t stream) {
    static int grid = 0;
    if (grid == 0) {
        if (n_in != 16 || in_sizes[0] != T * D_MODEL || out_size != T * D_MODEL || ws_size < WS_NEED) { fprintf(stderr, "kernel_launch: unexpected shapes / workspace (%d inputs, ws %zu); nothing launched\n", n_in, ws_size); grid = -1; return; }
        int dev = 0, cus = 0, per_cu = 0;
        if (hipGetDevice(&dev) != hipSuccess || hipDeviceGetAttribute(&cus, hipDeviceAttributeMultiprocessorCount, dev) != hipSuccess) { grid = -1; return; }
        if (hipFuncSetAttribute((const void*)mk_fwd, hipFuncAttributeMaxDynamicSharedMemorySize, LDS_BYTES) != hipSuccess) { fprintf(stderr, "kernel_launch: hipFuncSetAttribute failed\n"); grid = -1; return; }
        if (hipOccupancyMaxActiveBlocksPerMultiprocessor(&per_cu, (const void*)mk_fwd, NT, LDS_BYTES) != hipSuccess || per_cu < 1) { fprintf(stderr, "kernel_launch: occupancy query says %d blocks per CU; nothing launched\n", per_cu); (void)hipGetLastError(); grid = -1; return; }
        grid = cus;
    }
    if (grid < 0) return;
    if (hipMemsetAsync((char*)d_ws + WS_CTL, 0, CTL_ZERO_BYTES, stream) != hipSuccess) return;
    Args a{};
    for (int i = 0; i < 16; ++i) a.in[i] = (const float*)d_in[i];
    a.out = (float*)d_out; a.ws = (unsigned char*)d_ws;
#if MK_N_LAUNCHES == 1
    a.ph_lo = 0; a.ph_hi = N_PHASES; a.li = 0;
    hipLaunchKernelGGL(mk_fwd, dim3(grid), dim3(NT), LDS_BYTES, stream, a);
#else
    for (int p = 0; p < N_PHASES; ++p) { a.ph_lo = p; a.ph_hi = p + 1; a.li = 0; hipLaunchKernelGGL(mk_fwd, dim3(grid), dim3(NT), LDS_BYTES, stream, a); }
#endif
}
```

```cpp
#include <hip/hip_runtime.h>
#include <cstdio>
#include <cstdint>
#include <cmath>

#ifndef PROBE_DUP
#define PROBE_DUP -1
#endif
#ifndef PROBE_T
#define PROBE_T -1
#endif
#if PROBE_T >= 0
__device__ unsigned long long t_tic, t_acc;
#define TIC(k) do { if (PROBE_T == (k) && blockIdx.x == 0 && threadIdx.x == 0) { t_tic = __builtin_amdgcn_s_memrealtime(); } } while (0)
#define TOC(k) do { if (PROBE_T == (k) && blockIdx.x == 0 && threadIdx.x == 0) { t_acc += __builtin_amdgcn_s_memrealtime() - t_tic; } } while (0)
#else
#define TIC(k) do { } while (0)
#define TOC(k) do { } while (0)
#endif
#ifndef TAIL_FILL
#define TAIL_FILL 1
#endif
#ifndef INPROJ_F8
#define INPROJ_F8 1
#endif
#ifndef MIXED_F8
#define MIXED_F8 1
#endif
#ifndef MK_N_LAUNCHES
#define MK_N_LAUNCHES 1
#endif

constexpr int D_MODEL = 1024, BATCH = 16, SEQ = 2048, T = BATCH * SEQ;
constexpr int IDX_TOPK = 256;
constexpr int CMP_BLOCK = 32, CMP_STRIDE = 16, CMP_HIDDEN = 128, N_C = (SEQ - CMP_BLOCK) / CMP_STRIDE + 1;
constexpr int SLC_BLOCK = 64, SLC_COUNT = 8, N_S = SEQ / SLC_BLOCK, WINDOW = 512;
constexpr int FFN = 2816;
constexpr int IN_COLS = 2240, ACT_COLS = 2304;
constexpr float ALPHA = 1.189207115002721f;
constexpr float LN_EPS = 1e-5f;
constexpr float ATT_SCALE = 0.125f;
constexpr float IDX_SCALE = 0.0625f;
constexpr int C_DQ = 0, C_DK = 512, C_DV = 576, C_IQ = 640, C_NQ = 896, C_KCM = 1408, C_VCM = 1536, C_KSL = 1664, C_VSL = 1792,
              C_KWN = 1920, C_VWN = 2048, C_IK = 2176, C_IW = 2208, C_NG = 2216;
__host__ __device__ __forceinline__ int orig_col(int pc) {
    if (pc < 896) return pc;
    if (pc < 1408) return 936 + (pc - 896);
    if (pc < 2176) return 1448 + (pc - 1408);
    if (pc < 2208) return 904 + (pc - 2176);
    if (pc < 2216) return 896 + (pc - 2208);
    if (pc < IN_COLS) return pc;
    return -1;
}
constexpr size_t MiB = 1u << 20;
constexpr size_t WS_CTL = 0, CTL_ZERO_BYTES = 1 * MiB;
constexpr size_t CTL_STATS1 = 256 * 1024;
constexpr size_t CTL_CS = 512 * 1024;
constexpr size_t CTL_CB1 = 600 * 1024;
constexpr size_t WS_ROPE = 1 * MiB;
constexpr size_t WS_BIASP = 3 * MiB;
constexpr size_t WS_WIN = 4 * MiB;
constexpr size_t WS_WOUT = 9 * MiB;
constexpr size_t WS_WGU = 11 * MiB;
constexpr size_t WS_WDN = 22 * MiB;
constexpr size_t WS_W1T = 28 * MiB;
constexpr size_t WS_W2T = 29 * MiB;
constexpr size_t WS_CB1 = 29 * MiB + 512 * 1024;
constexpr size_t WS_KCB = 30 * MiB;
constexpr size_t WS_WINQ = 37 * MiB;
constexpr size_t WS_XCH = 36 * MiB;
constexpr size_t WS_KC = 32 * MiB;
constexpr size_t WS_ACT = 48 * MiB;
constexpr size_t WS_ACTF = 48 * MiB;
constexpr size_t WS_XB = 192 * MiB;
constexpr size_t WS_MIXED = 256 * MiB;
constexpr size_t WS_V1B = 320 * MiB;
constexpr size_t WS_KVC = 288 * MiB;
constexpr size_t WS_GCAND = 384 * MiB;
constexpr size_t WS_NEED = 512 * MiB;

namespace pg8 {
#define PG8_LAS __attribute__((address_space(3)))
typedef unsigned short bf16_t;
typedef short bf16x8 __attribute__((ext_vector_type(8)));
typedef float f32x4 __attribute__((ext_vector_type(4)));
typedef unsigned u32x4 __attribute__((ext_vector_type(4)));
constexpr int BM = 256, BK = 64, HALF = 128, HTB = HALF * BK * 2  , STAGE_BYTES = 8 * HTB, NXCD = 8, WGM = 8;

__host__ __device__ __forceinline__ int lds_byte(int r, int c) { const int st = (r >> 4) * 2 + (c >> 5), rr = r & 15, cc = c & 31, ob = rr * 64 + cc * 2; return st * 1024 + (ob ^ (((ob >> 9) & 1) << 5)); }
__host__ __device__ __forceinline__ void stage_rc(int b, int& R, int& C) { const int st = b / 1024, sb = b % 1024, swz = sb ^ (((sb >> 9) & 1) << 5); R = (st >> 1) * 16 + swz / 64; C = (st & 1) * 32 + (swz % 64) / 2; }
__host__ __device__ __forceinline__ int perm32(int rho) { const int n = rho >> 4, i = rho & 15; return 8 * (i >> 2) + 4 * n + (i & 3); }

struct Unit { int pm, pn; };
struct Gemm { const bf16_t* A; const bf16_t* Bt; int M, N, K; };

struct StaticOrder {
    int nM, nN, nwg, G, c;
    __host__ __device__ void init(int M, int N, int G_, int c_) { nM = M / BM; nN = N / BM; nwg = nM * nN; G = G_; c = c_; }
    __host__ __device__ bool next(int i, Unit& u, long Lx = -1) const {
        const long L = Lx >= 0 ? Lx : (long)i * G + c; if (L >= nwg) return false;
        int wgid = (int)L; { const int q = nwg / NXCD, r = nwg % NXCD, xcd = wgid % NXCD, off = wgid / NXCD; wgid = (xcd < r ? xcd * (q + 1) : r * (q + 1) + (xcd - r) * q) + off; }
        const int nig = WGM * nN, gid = wgid / nig, fm = gid * WGM, gsz = (nM - fm) < WGM ? (nM - fm) : WGM;
        u.pm = fm + ((wgid % nig) % gsz); u.pn = (wgid % nig) / gsz; return true;
    }
    __device__ __forceinline__ void a_ready(const Unit&) const {}
    __device__ __forceinline__ void done(const Unit&) const {}
};
__device__ __forceinline__ unsigned cvt_pk_bf16(float lo, float hi) { unsigned r; asm volatile("v_cvt_pk_bf16_f32 %0, %1, %2" : "=v"(r) : "v"(lo), "v"(hi)); return r; }
typedef float f32x2 __attribute__((ext_vector_type(2)));
__device__ __forceinline__ f32x4 shflx16(f32x4 v) { f32x4 r; r[0] = __shfl_xor(v[0], 16); r[1] = __shfl_xor(v[1], 16); r[2] = __shfl_xor(v[2], 16); r[3] = __shfl_xor(v[3], 16); return r; }
typedef unsigned u32x2 __attribute__((ext_vector_type(2)));
__device__ __forceinline__ u32x2 pack8_f8(f32x4 a, f32x4 b) {
    int p0 = __builtin_amdgcn_cvt_pk_fp8_f32(a[0], a[1], 0, false); p0 = __builtin_amdgcn_cvt_pk_fp8_f32(a[2], a[3], p0, true);
    int p1 = __builtin_amdgcn_cvt_pk_fp8_f32(b[0], b[1], 0, false); p1 = __builtin_amdgcn_cvt_pk_fp8_f32(b[2], b[3], p1, true);
    return u32x2{(unsigned)p0, (unsigned)p1}; }
__device__ __forceinline__ u32x4 pack8(f32x4 a, f32x4 b) { u32x4 w; w.x = cvt_pk_bf16(a[0], a[1]); w.y = cvt_pk_bf16(a[2], a[3]); w.z = cvt_pk_bf16(b[0], b[1]); w.w = cvt_pk_bf16(b[2], b[3]); return w; }
struct EpiNull {
    static constexpr bool PERM = true, AFTER_DRAIN = false, HAS_STAGE = false;
    float* o;
    __device__ __forceinline__ void operator()(const f32x4 (&acc)[2][2][4][2], const Unit& u, int wr, int wc, int fr, int fq) const {
        f32x4 s = acc[0][0][0][0];
#pragma unroll
        for (int ai = 0; ai < 2; ++ai)
#pragma unroll
            for (int bj = 0; bj < 2; ++bj)
#pragma unroll
                for (int m = 0; m < 4; ++m)
#pragma unroll
                    for (int n = 0; n < 2; ++n) s += acc[ai][bj][m][n];
        *(f32x4*)(o + ((size_t)(u.pm * 8 + u.pn % 8) * 512 + threadIdx.x) * 4) = s;
    }
};
struct SubOrderB {
    StaticOrder s; int G, c;
    __device__ void init(int M, int G_, int c_) { s.init(M, 5 * BM, G_, 0); G = G_; c = c_; }
    __device__ bool next(int i, Unit& u) const { int L;
        if (G == 256) { if (c < 128) { if (i >= 4) return false; L = c + 128 * i; } else { if (i >= 1) return false; L = 512 + (c - 128); } }
        else { L = i * G + c; }
        if (!s.next(0, u, L)) return false; u.pn = u.pn < 4 ? u.pn + 2 : 8; return true; }
    __device__ __forceinline__ void a_ready(const Unit&) const {}
    __device__ __forceinline__ void done(const Unit&) const {}
};
struct SubOrderQ {
    int G, c;
    __device__ bool next(int i, Unit& u) const { long L;
        if (G == 256) { if (c < 128 || i >= 4) return false; L = (long)(c - 128) * 4 + i; }
        else { L = (long)i * G + c; if (L >= 512) return false; }
        const int idx = (int)(L & 3); u.pm = (int)(L >> 2); u.pn = idx < 2 ? idx : idx + 4; return true; }
    __device__ __forceinline__ void a_ready(const Unit&) const {}
    __device__ __forceinline__ void done(const Unit&) const {}
};
struct EpiInProj {
    static constexpr bool PERM = true, AFTER_DRAIN = false, HAS_STAGE = false;
    bf16_t* act; const float* biasP; const float* rope; float qscale, inv_s; bf16_t* kvc;
    __device__ __forceinline__ void operator()(const f32x4 (&acc)[2][2][4][2], const Unit& u, int wr, int wc, int fr, int fq) const {
        const int row0 = u.pm * BM + wr * 64 + fr; const bool lo = (wc & 1) == 0;
        const int H0 = (u.pn * BM + wc * 32) >> 6, H1 = H0 + 2;
        const bool k64a = lo && ((0xCCFFC1FFull >> H0) & 1ull), k64b = lo && ((0xCCFFC1FFull >> H1) & 1ull);
        const bool k32a = (H0 >= 10 && H0 <= 13) || (H0 == 34 && lo), k32b = (H1 >= 10 && H1 <= 13) || (H1 == 34 && lo);
        const bool anyrope = k64a || k64b || k32a || k32b;
#pragma unroll
        for (int am = 0; am < 4; ++am) { const int ai = am >> 1, mh = am & 1;
            f32x4 rt[2][4];
            if (anyrope) {
#pragma unroll
                for (int m = 0; m < 2; ++m) { const f32x4* rp = (const f32x4*)(rope + (size_t)(row0 + ai * HALF + (2 * mh + m) * 16) * 16); rt[m][0] = rp[0]; rt[m][1] = rp[1]; rt[m][2] = rp[2]; rt[m][3] = rp[3]; }
            }
#pragma unroll
            for (int bj = 0; bj < 2; ++bj) {
                const int cgb = u.pn * BM + bj * HALF + wc * 32, H = cgb >> 6, col0 = cgb + 8 * fq;
                const f32x4 b0 = *(const f32x4*)(biasP + col0), b1 = *(const f32x4*)(biasP + col0 + 4);
                const bool k64 = bj ? k64b : k64a, k32 = bj ? k32b : k32a, ksig = (H == 34 && !lo);
                const float qs = (H < 8 || (H >= 14 && H < 22)) ? qscale : 1.f;
#pragma unroll
                for (int mm = 0; mm < 2; ++mm) { const int m = 2 * mh + mm;
                    const int row = row0 + ai * HALF + m * 16;
                    f32x4 v0 = acc[ai][bj][m][0] * inv_s + b0, v1 = acc[ai][bj][m][1] * inv_s + b1;
                    const f32x4 t0 = rt[mm][0], t1 = rt[mm][1], t2 = rt[mm][2], t3 = rt[mm][3];
                    if (k64) {
                        const f32x4 p0 = shflx16(v0), p1 = shflx16(v1);
                        if (fq < 2) {
                            const float sg = fq == 0 ? -1.f : 1.f;
                            v0[0] = v0[0] * t0[0] + sg * p0[0] * t0[1]; v0[1] = v0[1] * t0[2] + sg * p0[1] * t0[3];
                            v0[2] = v0[2] * t1[0] + sg * p0[2] * t1[1]; v0[3] = v0[3] * t1[2] + sg * p0[3] * t1[3];
                            v1[0] = v1[0] * t2[0] + sg * p1[0] * t2[1]; v1[1] = v1[1] * t2[2] + sg * p1[1] * t2[3];
                            v1[2] = v1[2] * t3[0] + sg * p1[2] * t3[1]; v1[3] = v1[3] * t3[2] + sg * p1[3] * t3[3];
                        }
                    } else if (k32) {
                        if (fq == 0) {
                            const f32x4 x1 = v0, x2 = v1;
                            v0[0] = x1[0] * t0[0] - x2[0] * t0[1]; v1[0] = x2[0] * t0[0] + x1[0] * t0[1];
                            v0[1] = x1[1] * t1[0] - x2[1] * t1[1]; v1[1] = x2[1] * t1[0] + x1[1] * t1[1];
                            v0[2] = x1[2] * t2[0] - x2[2] * t2[1]; v1[2] = x2[2] * t2[0] + x1[2] * t2[1];
                            v0[3] = x1[3] * t3[0] - x2[3] * t3[1]; v1[3] = x2[3] * t3[0] + x1[3] * t3[1];
                        }
                    } else if (ksig) {
                        if (fq >= 1) {
#pragma unroll
                            for (int e = 0; e < 4; ++e) { v0[e] = 1.f / (1.f + __expf(-v0[e])); v1[e] = 1.f / (1.f + __expf(-v1[e])); }
                        }
                    }
                    { const u32x4 pk_ = pack8(v0 * qs, v1 * qs);
                      if (cgb >= 1408 && cgb < 1664) *(u32x4*)(kvc + (size_t)row * 256 + (col0 - 1408)) = pk_; else if (cgb < 2240) *(u32x4*)(act + (size_t)row * 2304 + col0) = pk_; }
                }
            }
        }
    }
};
struct EpiOutProj {
    static constexpr bool PERM = true, AFTER_DRAIN = false, HAS_STAGE = false;
    const bf16_t* xb; bf16_t* v1b; unsigned char* v1q; float* stats; float alpha, inv_s;
    __device__ __forceinline__ void operator()(const f32x4 (&acc)[2][2][4][2], const Unit& u, int wr, int wc, int fr, int fq) const {
        const int row0 = u.pm * BM + wr * 64 + fr;
#pragma unroll
        for (int ai = 0; ai < 2; ++ai) {
            u32x4 xr[4][2];
#pragma unroll
            for (int m = 0; m < 4; ++m)
#pragma unroll
                for (int bj = 0; bj < 2; ++bj) xr[m][bj] = *(const u32x4*)(xb + (size_t)(row0 + ai * HALF + m * 16) * 1024 + u.pn * BM + bj * HALF + wc * 32 + 8 * fq);
#pragma unroll
            for (int m = 0; m < 4; ++m) {
                const int row = row0 + ai * HALF + m * 16; float s = 0.f, q = 0.f;
#pragma unroll
                for (int bj = 0; bj < 2; ++bj) {
                    const size_t off = (size_t)row * 1024 + u.pn * BM + bj * HALF + wc * 32 + 8 * fq;
                    const u32x4 xv = xr[m][bj];
                    const f32x4 xa = {__uint_as_float(xv[0] << 16), __uint_as_float(xv[0] & 0xffff0000u), __uint_as_float(xv[1] << 16), __uint_as_float(xv[1] & 0xffff0000u)};
                    const f32x4 xc = {__uint_as_float(xv[2] << 16), __uint_as_float(xv[2] & 0xffff0000u), __uint_as_float(xv[3] << 16), __uint_as_float(xv[3] & 0xffff0000u)};
                    const f32x4 a = xa * alpha + acc[ai][bj][m][0] * inv_s, b = xc * alpha + acc[ai][bj][m][1] * inv_s;
                    *(u32x4*)(v1b + off) = pack8(a, b); if (v1q) *(u32x2*)(v1q + off) = pack8_f8(a, b);
                    s += ((a[0] + a[1]) + (a[2] + a[3])) + ((b[0] + b[1]) + (b[2] + b[3]));
                    q += ((a[0] * a[0] + a[1] * a[1]) + (a[2] * a[2] + a[3] * a[3])) + ((b[0] * b[0] + b[1] * b[1]) + (b[2] * b[2] + b[3] * b[3]));
                }
                s += __shfl_xor(s, 16); s += __shfl_xor(s, 32); q += __shfl_xor(q, 16); q += __shfl_xor(q, 32);
                if (fq == 0 && stats) { atomicAdd(stats + 2 * row, s); atomicAdd(stats + 2 * row + 1, q); }
            }
        }
    }
};
struct EpiGateUp {
    static constexpr bool PERM = true, AFTER_DRAIN = false, HAS_STAGE = true;
    bf16_t* actf; unsigned char* actq; const float* stats; const float* cs; const float* bs; float inv_s; PG8_LAS unsigned char* sp;
    __device__ __forceinline__ void stage(const Unit& u, int ui, int wid, int lane) const {
        if (wid < 4) { const float* src = wid == 0 ? cs + u.pn * BM + lane * 4 : wid == 1 ? bs + u.pn * BM + lane * 4 : stats + (size_t)u.pm * BM * 2 + (wid - 2) * 256 + lane * 4;
            __builtin_amdgcn_global_load_lds((const unsigned*)src, (PG8_LAS unsigned*)(sp + (ui & 1) * 4096 + wid * 1024), 16, 0, 0); }
    }
    __device__ __forceinline__ void operator()(const f32x4 (&acc)[2][2][4][2], const Unit& u, int wr, int wc, int fr, int fq, int ui) const {
        const PG8_LAS float* SP = (const PG8_LAS float*)(sp + (ui & 1) * 4096);
        const int row0 = u.pm * BM + wr * 64 + fr; const int ng = u.pn * BM + wc * 32 + 8 * fq, nu = ng + HALF, jc = u.pn * HALF + wc * 32 + 8 * fq;
        f32x4 csg[2], bsg[2], csu[2], bsu[2];
#pragma unroll
        for (int n = 0; n < 2; ++n) { const int cl = wc * 32 + 8 * fq + 4 * n; csg[n] = *(const PG8_LAS f32x4*)(SP + cl); bsg[n] = *(const PG8_LAS f32x4*)(SP + 256 + cl); csu[n] = *(const PG8_LAS f32x4*)(SP + HALF + cl); bsu[n] = *(const PG8_LAS f32x4*)(SP + 256 + HALF + cl); }   (void)nu; (void)ng;
        typedef float f2_t __attribute__((ext_vector_type(2)));
        f2_t stv[2][4];
#pragma unroll
        for (int ai = 0; ai < 2; ++ai)
#pragma unroll
            for (int m = 0; m < 4; ++m) stv[ai][m] = *(const PG8_LAS f2_t*)(SP + 512 + 2 * (wr * 64 + fr + ai * HALF + m * 16));
#pragma unroll
        for (int ai = 0; ai < 2; ++ai)
#pragma unroll
            for (int m = 0; m < 4; ++m) {
                const int row = row0 + ai * HALF + m * 16;
                const f2_t st = stv[ai][m];
                const float mean = st[0] * (1.f / 1024.f), var = st[1] * (1.f / 1024.f) - mean * mean, rstd = __builtin_amdgcn_rsqf(fmaxf(var, 0.f) + 1e-5f);
                const float a1 = inv_s * rstd, a0 = -mean * rstd;
                f32x4 o[2];
#pragma unroll
                for (int n = 0; n < 2; ++n) {
                    const f32x4 g = acc[ai][0][m][n] * a1 + (csg[n] * a0 + bsg[n]), up = acc[ai][1][m][n] * a1 + (csu[n] * a0 + bsu[n]);
#pragma unroll
                    for (int e = 0; e < 4; ++e) o[n][e] = g[e] * __builtin_amdgcn_rcpf(1.f + __builtin_amdgcn_exp2f(g[e] * -1.4426950408889634f)) * up[e];
                }
                if (actq) *(u32x2*)(actq + (size_t)row * 2816 + jc) = pack8_f8(o[0], o[1]); else *(u32x4*)(actf + (size_t)row * 2816 + jc) = pack8(o[0], o[1]);
            }
    }
};
struct RowStatsX {
    unsigned long long* xbuf;
    unsigned* cnt;
    PG8_LAS unsigned char* tab;
    float eps;
    __device__ __forceinline__ void run(const f32x4 (&v)[2][2][4][2], const Unit& u, int wr, int wc, int fr, int fq, int wid, int lane) const {
        typedef float f32x2v __attribute__((ext_vector_type(2)));
        PG8_LAS f32x2v* P = (PG8_LAS f32x2v*)tab; PG8_LAS f32x2v* S = (PG8_LAS f32x2v*)(tab + 8192);
#pragma unroll
        for (int ai = 0; ai < 2; ++ai)
#pragma unroll
            for (int m = 0; m < 4; ++m) {
                float s = 0.f;
#pragma unroll
                for (int bj = 0; bj < 2; ++bj)
#pragma unroll
                    for (int n = 0; n < 2; ++n) { const f32x4 x = v[ai][bj][m][n]; s += (x[0] + x[1]) + (x[2] + x[3]); }
                s += __shfl_xor(s, 16); s += __shfl_xor(s, 32);
                const float mw = s * (1.0f / 64.0f); float q = 0.f;
#pragma unroll
                for (int bj = 0; bj < 2; ++bj)
#pragma unroll
                    for (int n = 0; n < 2; ++n) { const f32x4 d = v[ai][bj][m][n] - mw; q += (d[0] * d[0] + d[1] * d[1]) + (d[2] * d[2] + d[3] * d[3]); }
                q += __shfl_xor(q, 16); q += __shfl_xor(q, 32);
                if (fq == 0) P[(ai * HALF + wr * 64 + m * 16 + fr) * 4 + wc] = (f32x2v){mw, q};
            }
        asm volatile("s_waitcnt lgkmcnt(0)" ::: "memory"); __builtin_amdgcn_s_barrier(); asm volatile("" ::: "memory");
        const int row = wid * 32 + (lane & 31);
        if (lane < 32) {
            const f32x2v a = P[row * 4 + 0], b = P[row * 4 + 1], c = P[row * 4 + 2], d = P[row * 4 + 3];
            const float mt = (a.x + b.x + c.x + d.x) * 0.25f;
            const float da = a.x - mt, db = b.x - mt, dc = c.x - mt, dd = d.x - mt;
            const float m2 = (a.y + b.y) + (c.y + d.y) + 64.0f * ((da * da + db * db) + (dc * dc + dd * dd));
            __hip_atomic_store(xbuf + ((size_t)(u.pm * BM + row) * 4 + u.pn), ((unsigned long long)__float_as_uint(m2) << 32) | __float_as_uint(mt), __ATOMIC_RELAXED, __HIP_MEMORY_SCOPE_AGENT);
        }
        asm volatile("s_waitcnt vmcnt(0)" ::: "memory");
        if (lane == 0) __hip_atomic_fetch_add(cnt + 64 * u.pm, 1u, __ATOMIC_RELAXED, __HIP_MEMORY_SCOPE_AGENT);
        if (wid == 0) {
            unsigned sp = 0;
            while ((unsigned)__builtin_amdgcn_readfirstlane((int)__hip_atomic_load(cnt + 64 * u.pm, __ATOMIC_RELAXED, __HIP_MEMORY_SCOPE_AGENT)) < 32u) { __builtin_amdgcn_s_sleep(2); if (++sp > (1u << 22)) break; }
            __builtin_amdgcn_fence(__ATOMIC_ACQUIRE, "agent");
        }
        asm volatile("s_waitcnt vmcnt(0) lgkmcnt(0)" ::: "memory"); __builtin_amdgcn_s_barrier(); asm volatile("" ::: "memory");
        if (lane < 32) {
            const unsigned long long* slot = xbuf + (size_t)(u.pm * BM + row) * 4; float mt[4], m2[4]; float ms = 0.f;
#pragma unroll
            for (int t = 0; t < 4; ++t) { const unsigned long long w = __hip_atomic_load(slot + t, __ATOMIC_RELAXED, __HIP_MEMORY_SCOPE_AGENT); mt[t] = __uint_as_float((unsigned)w); m2[t] = __uint_as_float((unsigned)(w >> 32)); ms += mt[t]; }
            const float mean = ms * 0.25f; float q = 0.f;
#pragma unroll
            for (int t = 0; t < 4; ++t) { const float dm = mt[t] - mean; q += m2[t] + 256.0f * dm * dm; }
            S[row] = (f32x2v){mean, __builtin_amdgcn_rsqf(q * (1.0f / 1024.0f) + eps)};
        }
        asm volatile("s_waitcnt lgkmcnt(0)" ::: "memory"); __builtin_amdgcn_s_barrier(); asm volatile("" ::: "memory");
    }
};
struct EpiDownLn {
    static constexpr bool PERM = true, AFTER_DRAIN = false, HAS_STAGE = false;
    const bf16_t* v1b; float* out; const float* stats; const float* g1; const float* b1; const float* g2; const float* b2; float alpha, inv_s; RowStatsX rx;
    __device__ __forceinline__ void operator()(const f32x4 (&acc_)[2][2][4][2], const Unit& u, int wr, int wc, int fr, int fq) const {
        typedef float f32x2v __attribute__((ext_vector_type(2)));
        f32x4 (&acc)[2][2][4][2] = const_cast<f32x4 (&)[2][2][4][2]>(acc_);
        const int row0 = u.pm * BM + wr * 64 + fr; const int wid = wr * 4 + wc, lane = fq * 16 + fr;
        f32x2v mr[2][4];
#pragma unroll
        for (int ai = 0; ai < 2; ++ai)
#pragma unroll
            for (int m = 0; m < 4; ++m) mr[ai][m] = *(const f32x2v*)(stats + 2 * (row0 + ai * HALF + m * 16));
#pragma unroll
        for (int ai = 0; ai < 2; ++ai)
#pragma unroll
            for (int m = 0; m < 4; ++m) { const float mean = mr[ai][m][0] * (1.f / 1024.f), var = mr[ai][m][1] * (1.f / 1024.f) - mean * mean; mr[ai][m] = f32x2v{mean, __builtin_amdgcn_rsqf(fmaxf(var, 0.f) + 1e-5f)}; }
#pragma unroll
        for (int bj = 0; bj < 2; ++bj) {
            const int col0 = u.pn * BM + bj * HALF + wc * 32 + 8 * fq;
            const f32x4 ga = *(const f32x4*)(g1 + col0), gb = *(const f32x4*)(g1 + col0 + 4), ba = *(const f32x4*)(b1 + col0), bb = *(const f32x4*)(b1 + col0 + 4);
#pragma unroll
            for (int ai = 0; ai < 2; ++ai) {
                u32x4 vr[4];
#pragma unroll
                for (int m = 0; m < 4; ++m) vr[m] = *(const u32x4*)(v1b + (size_t)(row0 + ai * HALF + m * 16) * 1024 + col0);
#pragma unroll
                for (int m = 0; m < 4; ++m) {
                    const float mean = mr[ai][m][0], rstd = mr[ai][m][1];
                    const u32x4 vv = vr[m];
                    const f32x4 va = {__uint_as_float(vv[0] << 16), __uint_as_float(vv[0] & 0xffff0000u), __uint_as_float(vv[1] << 16), __uint_as_float(vv[1] & 0xffff0000u)};
                    const f32x4 vb = {__uint_as_float(vv[2] << 16), __uint_as_float(vv[2] & 0xffff0000u), __uint_as_float(vv[3] << 16), __uint_as_float(vv[3] & 0xffff0000u)};
                    acc[ai][bj][m][0] = ((va - mean) * rstd * ga + ba) * alpha + acc[ai][bj][m][0] * inv_s;
                    acc[ai][bj][m][1] = ((vb - mean) * rstd * gb + bb) * alpha + acc[ai][bj][m][1] * inv_s;
                    asm volatile("" : "+v"(acc[ai][bj][m][0]), "+v"(acc[ai][bj][m][1]));
                }
                asm volatile("" ::: "memory");
            }
        }
        rx.run(acc, u, wr, wc, fr, fq, wid, lane);
        const PG8_LAS f32x2v* S = (const PG8_LAS f32x2v*)(rx.tab + 8192);
#pragma unroll
        for (int bj = 0; bj < 2; ++bj) {
            const int col0 = u.pn * BM + bj * HALF + wc * 32 + 8 * fq;
            const f32x4 ga = *(const f32x4*)(g2 + col0), gb = *(const f32x4*)(g2 + col0 + 4), ba = *(const f32x4*)(b2 + col0), bb = *(const f32x4*)(b2 + col0 + 4);
#pragma unroll
            for (int ai = 0; ai < 2; ++ai)
#pragma unroll
                for (int m = 0; m < 4; ++m) {
                    const int r = ai * HALF + wr * 64 + m * 16 + fr; const f32x2v sr = S[r]; float* po = out + (size_t)(u.pm * BM + r) * 1024 + col0;
                    *(f32x4*)po = (acc[ai][bj][m][0] - sr.x) * sr.y * ga + ba; *(f32x4*)(po + 4) = (acc[ai][bj][m][1] - sr.x) * sr.y * gb + bb;
                    if (m & 1) asm volatile("" ::: "memory");
                }
        }
        asm volatile("s_waitcnt lgkmcnt(0)" ::: "memory"); __builtin_amdgcn_s_barrier(); asm volatile("" ::: "memory");
    }
};
struct EpiDown {
    static constexpr bool PERM = true, AFTER_DRAIN = false, HAS_STAGE = false;
    const bf16_t* v1b; bf16_t* v2b; const float* stats; const float* g1; const float* b1; float alpha, inv_s;
    __device__ __forceinline__ void operator()(const f32x4 (&acc)[2][2][4][2], const Unit& u, int wr, int wc, int fr, int fq) const {
        const int row0 = u.pm * BM + wr * 64 + fr;
#pragma unroll
        for (int bj = 0; bj < 2; ++bj) {
            const int col0 = u.pn * BM + bj * HALF + wc * 32 + 8 * fq;
            const f32x4 ga = *(const f32x4*)(g1 + col0), gb = *(const f32x4*)(g1 + col0 + 4), ba = *(const f32x4*)(b1 + col0), bb = *(const f32x4*)(b1 + col0 + 4);
#pragma unroll
            for (int ai = 0; ai < 2; ++ai)
#pragma unroll
                for (int m = 0; m < 4; ++m) {
                    const int row = row0 + ai * HALF + m * 16;
                    const float sm = stats[2 * row], sq = stats[2 * row + 1];
                    const float mean = sm * (1.f / 1024.f), var = sq * (1.f / 1024.f) - mean * mean, rstd = rsqrtf(fmaxf(var, 0.f) + 1e-5f);
                    const u32x4 vv = *(const u32x4*)(v1b + (size_t)row * 1024 + col0);
                    const f32x4 va = {__uint_as_float(vv[0] << 16), __uint_as_float(vv[0] & 0xffff0000u), __uint_as_float(vv[1] << 16), __uint_as_float(vv[1] & 0xffff0000u)};
                    const f32x4 vb = {__uint_as_float(vv[2] << 16), __uint_as_float(vv[2] & 0xffff0000u), __uint_as_float(vv[3] << 16), __uint_as_float(vv[3] & 0xffff0000u)};
                    const f32x4 ha = (va - mean) * rstd * ga + ba, hb = (vb - mean) * rstd * gb + bb;
                    *(u32x4*)(v2b + (size_t)row * 1024 + col0) = pack8(ha * alpha + acc[ai][bj][m][0] * inv_s, hb * alpha + acc[ai][bj][m][1] * inv_s);
                }
        }
    }
};

typedef int i32x8 __attribute__((ext_vector_type(8))); typedef int i32x4 __attribute__((ext_vector_type(4)));
__device__ __forceinline__ i32x8 cat8(bf16x8 a, bf16x8 b) { return __builtin_shufflevector(__builtin_bit_cast(i32x4, a), __builtin_bit_cast(i32x4, b), 0, 1, 2, 3, 4, 5, 6, 7); }
template <class Epi, class Sched, bool ALIGN_EPI = false, bool SP2 = false, bool F8 = false>
__device__ __forceinline__ void gemm_phase(PG8_LAS unsigned char* lds, const Gemm g, const Sched& S, const Epi& E) {
    int tid_ = threadIdx.x; asm volatile("" : "+v"(tid_));
    const int tid = tid_, wid = __builtin_amdgcn_readfirstlane(tid >> 6), lane = tid & 63, wr = wid >> 2, wc = wid & 3, fr = lane & 15, fq = lane >> 4;
    const int RB = F8 ? g.K : 2 * g.K  , nt = RB / 128;
    int sc7f = 0x7F7F7F7F; asm volatile("" : "+v"(sc7f));
    unsigned voffA[2], voffB[2];
#pragma unroll
    for (int i = 0; i < 2; ++i) { int R, C; stage_rc(tid * 16 + i * 8192, R, C); const int Rb = Epi::PERM ? ((R & ~31) + perm32(R & 31)) : R;
        voffA[i] = (unsigned)(R * RB + C * 2); voffB[i] = (unsigned)(Rb * RB + C * 2); }
    const size_t kstep = (size_t)(BK * 2);
    const size_t hstep = (size_t)HALF * RB;
    const size_t tstep = 2 * hstep;
    const unsigned ldsw = (unsigned)wid * 1024u;
    const int aoff = lds_byte(wr * 64 + fr, fq * 8), boff = lds_byte(wc * 32 + fr, fq * 8);
#define PG8_SA(b, h) (((b) * 2 + (h)) * HTB)
#define PG8_SB(b, h) ((4 + (b) * 2 + (h)) * HTB)
#define PG8_STAGE(bufoff, gbase, voff) do { _Pragma("unroll") for (int _i = 0; _i < 2; ++_i) \
        __builtin_amdgcn_global_load_lds((const unsigned*)((const char*)(gbase) + (voff)[_i]), (PG8_LAS unsigned*)(lds + (bufoff) + ldsw + _i * 8192), 16, 0, 0); } while (0)
#define PG8_LDA(dst, b, h) do { _Pragma("unroll") for (int m = 0; m < 4; ++m) _Pragma("unroll") for (int k = 0; k < 2; ++k) dst[m][k] = *(const PG8_LAS bf16x8*)(lds + PG8_SA(b, h) + aoff + m * 2048 + k * 1024); } while (0)
#define PG8_LDB(dst, b, h) do { _Pragma("unroll") for (int n = 0; n < 2; ++n) _Pragma("unroll") for (int k = 0; k < 2; ++k) dst[n][k] = *(const PG8_LAS bf16x8*)(lds + PG8_SB(b, h) + boff + n * 2048 + k * 1024); } while (0)
#define PG8_MMA(ai, bj, At, Bt) do { if constexpr (F8) __builtin_amdgcn_sched_barrier(0); __builtin_amdgcn_s_setprio(1); \
        if constexpr (F8) { _Pragma("unroll") for (int m = 0; m < 4; ++m) _Pragma("unroll") for (int n = 0; n < 2; ++n) \
            asm volatile("v_mfma_scale_f32_16x16x128_f8f6f4 %0, %1, %2, %0, %3, %3 op_sel_hi:[0,0,0]" : "+v"(acc[ai][bj][m][n]) : "v"(cat8(Bt[n][0], Bt[n][1])), "v"(cat8(At[m][0], At[m][1])), "v"(sc7f)); } \
        else { _Pragma("unroll") for (int m = 0; m < 4; ++m) _Pragma("unroll") for (int n = 0; n < 2; ++n) _Pragma("unroll") for (int k = 0; k < 2; ++k) \
            acc[ai][bj][m][n] = __builtin_amdgcn_mfma_f32_16x16x32_bf16(Bt[n][k], At[m][k], acc[ai][bj][m][n], 0, 0, 0); } \
        __builtin_amdgcn_s_setprio(0); if constexpr (F8) __builtin_amdgcn_sched_barrier(0); } while (0)
#define PG8_WAIT_V(n) asm volatile("s_waitcnt vmcnt(" #n ")" ::: "memory")
#define PG8_WAIT_L(n) asm volatile("s_waitcnt lgkmcnt(" #n ")" ::: "memory")
#define PG8_BAR __builtin_amdgcn_s_barrier()
#define PG8_SCHED __builtin_amdgcn_sched_barrier(0)
    Unit cur, nxt; int ui = 0;
    if (!S.next(0, cur)) return;
    f32x4 acc[2][2][4][2];
#pragma unroll
    for (int a = 0; a < 2; ++a)
#pragma unroll
        for (int b = 0; b < 2; ++b)
#pragma unroll
            for (int m = 0; m < 4; ++m)
#pragma unroll
                for (int n = 0; n < 2; ++n) acc[a][b][m][n] = (f32x4){0.f, 0.f, 0.f, 0.f};
    bf16x8 At[4][2], B0[2][2], B1[2][2];
    const char* cA = (const char*)g.A + (size_t)cur.pm * tstep; const char* cB = (const char*)g.Bt + (size_t)cur.pn * tstep;
    S.a_ready(cur);
    if constexpr (SP2) {
        PG8_STAGE(PG8_SB(0, 0), cB, voffB); PG8_STAGE(PG8_SB(0, 1), cB + hstep, voffB); PG8_STAGE(PG8_SA(0, 0), cA, voffA); PG8_STAGE(PG8_SA(0, 1), cA + hstep, voffA);
        if (wr == 1) PG8_BAR;
        PG8_WAIT_V(2); PG8_BAR;
        PG8_STAGE(PG8_SB(1, 0), cB + kstep, voffB); PG8_STAGE(PG8_SA(1, 0), cA + kstep, voffA); PG8_STAGE(PG8_SB(1, 1), cB + hstep + kstep, voffB);
        PG8_WAIT_V(6); PG8_BAR;
    } else {
        PG8_STAGE(PG8_SB(0, 0), cB, voffB); PG8_STAGE(PG8_SA(0, 0), cA, voffA); PG8_STAGE(PG8_SB(0, 1), cB + hstep, voffB); PG8_STAGE(PG8_SA(0, 1), cA + hstep, voffA);
        if (wr == 1) PG8_BAR;
        PG8_WAIT_V(4); PG8_BAR;
        PG8_STAGE(PG8_SB(1, 0), cB + kstep, voffB); PG8_STAGE(PG8_SA(1, 0), cA + kstep, voffA); PG8_STAGE(PG8_SB(1, 1), cB + hstep + kstep, voffB);
        PG8_WAIT_V(6); PG8_BAR;
    }
    for (;;) {
        const bool has_next = S.next(ui + 1, nxt);
        const char* nA = has_next ? (const char*)g.A + (size_t)nxt.pm * tstep : cA; const char* nB = has_next ? (const char*)g.Bt + (size_t)nxt.pn * tstep : cB;
        for (int t = 0; t < nt; t += 2) {
            if constexpr (Epi::HAS_STAGE) { if (t == 0) E.stage(cur, ui, wid, lane); }
            const bool last = (t == nt - 2);
            const char* a1 = cA + (size_t)(t + 1) * kstep;
            const char* a2 = last ? nA : cA + (size_t)(t + 2) * kstep; const char* b2 = last ? nB : cB + (size_t)(t + 2) * kstep;
            const char* a3 = a2 + kstep; const char* b3 = b2 + kstep;
            if (last && has_next) S.a_ready(nxt);
            if constexpr (SP2) {
            PG8_LDB(B0, 0, 0); PG8_LDB(B1, 0, 1); PG8_SCHED; PG8_LDA(At, 0, 0); PG8_STAGE(PG8_SA(1, 1), a1 + hstep, voffA);
            PG8_WAIT_V(8); PG8_WAIT_L(0); PG8_BAR; PG8_MMA(0, 0, At, B0); PG8_MMA(0, 1, At, B1); PG8_BAR; PG8_SCHED;
            PG8_LDA(At, 0, 1); PG8_STAGE(PG8_SB(0, 0), b2, voffB); PG8_STAGE(PG8_SB(0, 1), b2 + hstep, voffB); PG8_STAGE(PG8_SA(0, 0), a2, voffA);
            PG8_WAIT_V(8); PG8_WAIT_L(0); PG8_BAR; PG8_MMA(1, 0, At, B0); PG8_MMA(1, 1, At, B1); PG8_BAR; PG8_SCHED;
            PG8_LDB(B0, 1, 0); PG8_LDB(B1, 1, 1); PG8_SCHED; PG8_LDA(At, 1, 0); PG8_STAGE(PG8_SA(0, 1), a2 + hstep, voffA);
            PG8_WAIT_V(8); PG8_WAIT_L(0); PG8_BAR; PG8_MMA(0, 0, At, B0); PG8_MMA(0, 1, At, B1); PG8_BAR; PG8_SCHED;
            PG8_LDA(At, 1, 1); PG8_STAGE(PG8_SB(1, 0), b3, voffB); PG8_STAGE(PG8_SB(1, 1), b3 + hstep, voffB); PG8_STAGE(PG8_SA(1, 0), a3, voffA);
            PG8_WAIT_V(8); PG8_WAIT_L(0); PG8_BAR; PG8_MMA(1, 0, At, B0); PG8_MMA(1, 1, At, B1); PG8_BAR; PG8_SCHED;
            } else {
            PG8_LDB(B0, 0, 0); PG8_SCHED; PG8_LDA(At, 0, 0); PG8_STAGE(PG8_SA(1, 1), a1 + hstep, voffA);
            PG8_WAIT_L(8); PG8_BAR; PG8_WAIT_L(0); PG8_MMA(0, 0, At, B0); PG8_BAR; PG8_SCHED;
            PG8_LDB(B1, 0, 1); PG8_STAGE(PG8_SB(0, 0), b2, voffB);
            PG8_BAR; PG8_WAIT_L(0); PG8_MMA(0, 1, At, B1); PG8_BAR;
            PG8_LDA(At, 0, 1); PG8_STAGE(PG8_SA(0, 0), a2, voffA);
            PG8_BAR; PG8_WAIT_L(0); PG8_MMA(1, 0, At, B0); PG8_BAR; PG8_SCHED;
            PG8_STAGE(PG8_SB(0, 1), b2 + hstep, voffB);
            PG8_WAIT_V(6); PG8_BAR; PG8_MMA(1, 1, At, B1); PG8_BAR;
            PG8_LDB(B0, 1, 0); PG8_SCHED; PG8_LDA(At, 1, 0); PG8_STAGE(PG8_SA(0, 1), a2 + hstep, voffA);
            PG8_WAIT_L(8); PG8_BAR; PG8_WAIT_L(0); PG8_MMA(0, 0, At, B0); PG8_BAR; PG8_SCHED;
            PG8_LDB(B1, 1, 1); PG8_STAGE(PG8_SB(1, 0), b3, voffB);
            PG8_BAR; PG8_WAIT_L(0); PG8_MMA(0, 1, At, B1); PG8_BAR;
            PG8_LDA(At, 1, 1); PG8_STAGE(PG8_SA(1, 0), a3, voffA);
            PG8_BAR; PG8_WAIT_L(0); PG8_MMA(1, 0, At, B0); PG8_BAR; PG8_SCHED;
            PG8_STAGE(PG8_SB(1, 1), b3 + hstep, voffB);
            PG8_WAIT_V(6); PG8_BAR; PG8_MMA(1, 1, At, B1); PG8_BAR;
            }
        }
        if constexpr (ALIGN_EPI) { if (wr == 0) PG8_BAR; }
        if constexpr (F8) asm volatile("s_nop 15\n\ts_nop 7" ::: "memory");
        if constexpr (!Epi::AFTER_DRAIN) { if constexpr (Epi::HAS_STAGE) E(acc, cur, wr, wc, fr, fq, ui); else E(acc, cur, wr, wc, fr, fq); S.done(cur); }
        if (!has_next) break;
#pragma unroll
        for (int a = 0; a < 2; ++a)
#pragma unroll
            for (int b = 0; b < 2; ++b)
#pragma unroll
                for (int m = 0; m < 4; ++m)
#pragma unroll
                    for (int n = 0; n < 2; ++n) acc[a][b][m][n] = (f32x4){0.f, 0.f, 0.f, 0.f};
        cur = nxt; cA = nA; cB = nB; ++ui;
        if constexpr (ALIGN_EPI) { if (wr == 1) PG8_BAR; }
    }
    PG8_WAIT_V(0);
    if constexpr (!ALIGN_EPI) { if (wr == 0) PG8_BAR; }
    PG8_BAR;
    if constexpr (Epi::AFTER_DRAIN) { E.fused(acc, cur, wr, wc, fr, fq, lds, wid, lane); S.done(cur); }
#undef PG8_SA
#undef PG8_SB
#undef PG8_STAGE
#undef PG8_LDA
#undef PG8_LDB
#undef PG8_MMA
#undef PG8_WAIT_V
#undef PG8_WAIT_L
#undef PG8_BAR
#undef PG8_SCHED
}
}
#define GAS __attribute__((address_space(1)))
#define LAS __attribute__((address_space(3)))
typedef unsigned short bf16;
typedef unsigned v4u __attribute__((ext_vector_type(4)));
typedef float f32x4 __attribute__((ext_vector_type(4)));
typedef short bf16x8 __attribute__((ext_vector_type(8)));
typedef GAS unsigned gu32;
typedef GAS unsigned long long gu64;
#define RLX_AGENT __ATOMIC_RELAXED, __HIP_MEMORY_SCOPE_AGENT
#define LDS_WAIT() asm volatile("s_waitcnt lgkmcnt(0)" ::: "memory")
#define VM_WAIT() asm volatile("s_waitcnt vmcnt(0)" ::: "memory")
__device__ __forceinline__ unsigned long long rt() { return __builtin_amdgcn_s_memrealtime(); }
__device__ __forceinline__ unsigned f2bf(float f) { unsigned u = __builtin_bit_cast(unsigned, f); return (u + 0x7fffu + ((u >> 16) & 1u)) >> 16; }
__device__ __forceinline__ unsigned pk2(float lo, float hi) { return f2bf(lo) | (f2bf(hi) << 16); }

#define XB_TMO      128
#define XB_XCNT(j)  (256  + 64 * (j))
#define XB_XSUB(j)  (1280 + 64 * (j))
#define XB_XGEN(j)  (2304 + 64 * (j))
#define XB_TOP      3328
#define XB_TOPGEN   3392
#define XCD_BAR_WORDS 3456
#define XB_SPIN_CAP (1u << 18)

__device__ __forceinline__ unsigned xb_ld(unsigned* p)              { return __hip_atomic_load(p, __ATOMIC_RELAXED, __HIP_MEMORY_SCOPE_AGENT); }
__device__ __forceinline__ unsigned xb_add(unsigned* p, unsigned v) { return __hip_atomic_fetch_add(p, v, __ATOMIC_RELAXED, __HIP_MEMORY_SCOPE_AGENT); }
__device__ __forceinline__ unsigned xb_xcc_id() { return (unsigned)__builtin_amdgcn_s_getreg((3 << 11) | 20) & 0xFu; }
#define XB_SPIN(cond, bar) do { unsigned _sp = 0; while (cond) { __builtin_amdgcn_s_sleep(1); \
    if ((++_sp & 255u) == 0u) { if (xb_ld(&(bar)[XB_TMO])) break; if (_sp > XB_SPIN_CAP) { atomicAdd(&(bar)[XB_TMO], 1u); break; } } } } while (0)

struct XcdBarrier {
    unsigned* bar; unsigned x;
    volatile LAS unsigned* st;
};

__device__ __forceinline__ XcdBarrier xcd_barrier_post(unsigned* bar, volatile LAS unsigned* st) {
    XcdBarrier b; b.bar = bar; b.x = xb_xcc_id(); b.st = st;
    if (threadIdx.x == 0) (void)xb_add(&bar[XB_XCNT(b.x)], 1u);
    return b;
}
__device__ __forceinline__ void xcd_barrier_complete(unsigned* bar, unsigned x, unsigned& nloc, unsigned& nx) {
    const unsigned G = gridDim.x * gridDim.y * gridDim.z;
    unsigned sum, cnt, mine, sp = 0u;
    for (;;) {
        sum = 0u; cnt = 0u; mine = 0u;
#pragma unroll
        for (unsigned j = 0; j < 16; ++j) { const unsigned c = xb_ld(&bar[XB_XCNT(j)]); sum += c; cnt += (c > 0u) ? 1u : 0u; mine = (j == x) ? c : mine; }
        if (sum == G) break;
        __builtin_amdgcn_s_sleep(1);
        if ((++sp & 255u) == 0u) { if (xb_ld(&bar[XB_TMO])) break; if (sp > XB_SPIN_CAP) { atomicAdd(&bar[XB_TMO], 1u); break; } }
    }
    nloc = mine > 0u ? mine : 1u; nx = cnt > 0u ? cnt : 1u;
}

__device__ __forceinline__ void xcd_barrier(const XcdBarrier& b) {
    asm volatile("s_waitcnt vmcnt(0)" ::: "memory");
    __syncthreads();
    if (threadIdx.x == 0) {
        unsigned* bar = b.bar;
        __builtin_amdgcn_s_waitcnt(0);
        unsigned nloc = b.st[0], nx = b.st[1];
        if (nloc == 0u) { xcd_barrier_complete(bar, b.x, nloc, nx); b.st[0] = nloc; b.st[1] = nx; }
        const unsigned old = xb_add(&bar[XB_XSUB(b.x)], 1u);
        const unsigned gen = old / nloc;
        if (old + 1u == (gen + 1u) * nloc) {
            __builtin_amdgcn_fence(__ATOMIC_RELEASE, "agent");
            asm volatile("s_waitcnt vmcnt(0)" ::: "memory");
            const unsigned og = xb_add(&bar[XB_TOP], 1u);
            const unsigned tg = og / nx;
            if (og + 1u == (tg + 1u) * nx) xb_add(&bar[XB_TOPGEN], 1u);
            else XB_SPIN(xb_ld(&bar[XB_TOPGEN]) == tg, bar);
            __builtin_amdgcn_fence(__ATOMIC_ACQUIRE, "agent");
            xb_add(&bar[XB_XGEN(b.x)], 1u);
            asm volatile("s_waitcnt vmcnt(0)" ::: "memory");
        } else {
            XB_SPIN(xb_ld(&bar[XB_XGEN(b.x)]) == gen, bar);
            __builtin_amdgcn_fence(__ATOMIC_ACQUIRE, "agent");
            asm volatile("s_waitcnt vmcnt(0)" ::: "memory");
        }
    }
    __syncthreads();
}
constexpr int NWAVES = 8, NT = 512;
constexpr float S_GU = 32.f, S_DN = 64.f, S_OUT = 32.f, S_IN = 32.f;
constexpr int RING_BYTES = 131072, LDSCTL_OFF = RING_BYTES, MISC_OFF = LDSCTL_OFF + 320, LDS_BYTES = 147456;
constexpr int CW_TMO = 0, CW_BAR = 4096;
__device__ __forceinline__ float bf2f(bf16 v) { return __uint_as_float(((unsigned)v) << 16); }
__device__ __forceinline__ float bfr(float f) { return __uint_as_float(f2bf(f) << 16); }
__device__ __forceinline__ float wave_sum(float v) {
#pragma unroll
    for (int o = 1; o < 64; o <<= 1) v += __shfl_xor(v, o);
    return v;
}
template <bool F8, bool FRAG = false>
__device__ __forceinline__ void tr64(const float* __restrict__ W, int Nsrc, int K, void* WT, int n0, int k0, int srccol, const float* __restrict__ kscale, float S, const float* __restrict__ kbias, float* csum, float* bsum, int lane) {
    const float* wp = W + (size_t)k0 * Nsrc + (srccol >= 0 ? srccol : 0); float cs = 0.f, bs = 0.f; const float rS = 1.f / S;
#pragma unroll 1
    for (int ch = 0; ch < 4; ++ch) {
        float v[16];
#pragma unroll
        for (int i = 0; i < 16; ++i) v[i] = srccol >= 0 ? wp[(size_t)(ch * 16 + i) * Nsrc] : 0.f;
        if (bsum) {
#pragma unroll
            for (int i = 0; i < 16; ++i) bs = fmaf(kbias[k0 + ch * 16 + i], v[i], bs); }
        if (kscale) {
#pragma unroll
            for (int i = 0; i < 16; ++i) v[i] *= kscale[k0 + ch * 16 + i]; }
        if constexpr (F8) {
            v4u o;
#pragma unroll
            for (int d = 0; d < 4; ++d) { int p = __builtin_amdgcn_cvt_pk_fp8_f32(v[4 * d] * S, v[4 * d + 1] * S, 0, false); p = __builtin_amdgcn_cvt_pk_fp8_f32(v[4 * d + 2] * S, v[4 * d + 3] * S, p, true); o[d] = (unsigned)p;
                if (csum) cs += ((__builtin_amdgcn_cvt_f32_fp8(p, 0) + __builtin_amdgcn_cvt_f32_fp8(p, 1)) + (__builtin_amdgcn_cvt_f32_fp8(p, 2) + __builtin_amdgcn_cvt_f32_fp8(p, 3))) * rS; }
            *(GAS v4u*)((unsigned char*)WT + (size_t)(n0 + lane) * K + k0 + ch * 16) = o;
        } else {
            v4u o0, o1;
#pragma unroll
            for (int d = 0; d < 4; ++d) { o0[d] = pk2(v[2 * d], v[2 * d + 1]); o1[d] = pk2(v[8 + 2 * d], v[8 + 2 * d + 1]); }
            if constexpr (FRAG) { const int n = n0 + lane; GAS v4u* dst = (GAS v4u*)((bf16*)WT + ((size_t)((n >> 5) * (K >> 4) + (k0 >> 4) + ch) * 64 + (n & 31)) * 8); dst[0] = o0; dst[32] = o1; }
            else { GAS v4u* dst = (GAS v4u*)((bf16*)WT + (size_t)(n0 + lane) * K + k0 + ch * 16); dst[0] = o0; dst[1] = o1; }
        }
    }
    if (csum) atomicAdd(csum + n0 + lane, cs);
    if (bsum) atomicAdd(bsum + n0 + lane, bs);
}


namespace att {
typedef short bf16x8 __attribute__((ext_vector_type(8)));
typedef short s16x4 __attribute__((ext_vector_type(4)));
typedef short v4i16_t __attribute__((ext_vector_type(4)));
typedef float f32x16 __attribute__((ext_vector_type(16)));
typedef unsigned u32x4 __attribute__((ext_vector_type(4)));
typedef unsigned u32x2 __attribute__((ext_vector_type(2)));
constexpr float C2 = 0.125f * 1.4426950408889634f;
constexpr float NEG_INF = -INFINITY;
__device__ __forceinline__ int crow(int r, int hi) { return (r & 3) + 8 * (r >> 2) + 4 * hi; }
__device__ __forceinline__ s16x4 vtr(const LAS unsigned char* p) { return __builtin_bit_cast(s16x4, __builtin_amdgcn_ds_read_tr16_b64_v4i16((LAS v4i16_t*)p)); }
__device__ __forceinline__ unsigned cvtpk(float lo, float hi) { typedef float f2_t __attribute__((ext_vector_type(2))); typedef __bf16 b2_t __attribute__((ext_vector_type(2))); f2_t v = {lo, hi}; b2_t b = __builtin_convertvector(v, b2_t); return __builtin_bit_cast(unsigned, b); }
__device__ __forceinline__ float ex2(float x) { return __builtin_amdgcn_exp2f(x); }

__device__ __forceinline__ void qkt(f32x16& p0, f32x16& p1, const LAS unsigned char* Ks, const bf16x8* qf, int r32, int hi) {
    const LAS unsigned char* kb = Ks + hi * 1024 + r32 * 16;
#pragma unroll
    for (int dh = 0; dh < 2; ++dh) {
        const bf16x8 b0 = *(const LAS bf16x8*)(kb + (2 * dh) * 2048), b1 = *(const LAS bf16x8*)(kb + (2 * dh) * 2048 + 512);
        const bf16x8 b2 = *(const LAS bf16x8*)(kb + (2 * dh + 1) * 2048), b3 = *(const LAS bf16x8*)(kb + (2 * dh + 1) * 2048 + 512);
        __builtin_amdgcn_s_setprio(1);
        p0 = __builtin_amdgcn_mfma_f32_32x32x16_bf16(b0, qf[2 * dh], p0, 0, 0, 0); p1 = __builtin_amdgcn_mfma_f32_32x32x16_bf16(b1, qf[2 * dh], p1, 0, 0, 0);
        p0 = __builtin_amdgcn_mfma_f32_32x32x16_bf16(b2, qf[2 * dh + 1], p0, 0, 0, 0); p1 = __builtin_amdgcn_mfma_f32_32x32x16_bf16(b3, qf[2 * dh + 1], p1, 0, 0, 0);
        __builtin_amdgcn_s_setprio(0);
        if (dh == 0) __builtin_amdgcn_sched_barrier(0);
    }
}
__device__ __forceinline__ void qkt_c(f32x16& p0, f32x16& p1, const f32x16& cn, const LAS unsigned char* Ks, const bf16x8* qf, int r32, int hi) {
    const LAS unsigned char* kb = Ks + hi * 1024 + r32 * 16;
    {   const bf16x8 b0 = *(const LAS bf16x8*)(kb), b1 = *(const LAS bf16x8*)(kb + 512);
        const bf16x8 b2 = *(const LAS bf16x8*)(kb + 2048), b3 = *(const LAS bf16x8*)(kb + 2048 + 512);
        __builtin_amdgcn_s_setprio(1);
        p0 = __builtin_amdgcn_mfma_f32_32x32x16_bf16(b0, qf[0], cn, 0, 0, 0); p1 = __builtin_amdgcn_mfma_f32_32x32x16_bf16(b1, qf[0], cn, 0, 0, 0);
        p0 = __builtin_amdgcn_mfma_f32_32x32x16_bf16(b2, qf[1], p0, 0, 0, 0); p1 = __builtin_amdgcn_mfma_f32_32x32x16_bf16(b3, qf[1], p1, 0, 0, 0);
        __builtin_amdgcn_s_setprio(0);
        __builtin_amdgcn_sched_barrier(0); }
    {   const bf16x8 b0 = *(const LAS bf16x8*)(kb + 4096), b1 = *(const LAS bf16x8*)(kb + 4096 + 512);
        const bf16x8 b2 = *(const LAS bf16x8*)(kb + 6144), b3 = *(const LAS bf16x8*)(kb + 6144 + 512);
        __builtin_amdgcn_s_setprio(1);
        p0 = __builtin_amdgcn_mfma_f32_32x32x16_bf16(b0, qf[2], p0, 0, 0, 0); p1 = __builtin_amdgcn_mfma_f32_32x32x16_bf16(b1, qf[2], p1, 0, 0, 0);
        p0 = __builtin_amdgcn_mfma_f32_32x32x16_bf16(b2, qf[3], p0, 0, 0, 0); p1 = __builtin_amdgcn_mfma_f32_32x32x16_bf16(b3, qf[3], p1, 0, 0, 0);
        __builtin_amdgcn_s_setprio(0); }
}
__device__ __forceinline__ float max3f(float a, float b, float c) { float r; asm("v_max3_f32 %0, %1, %2, %3" : "=v"(r) : "v"(a), "v"(b), "v"(c)); return r; }
__device__ __forceinline__ void cinit_bits(f32x16& c, unsigned w, int hi, float negm) {
    const unsigned w2 = w >> (4 * hi), nb = __float_as_uint(negm);
#pragma unroll
    for (int r = 0; r < 16; ++r) { const unsigned mm = (unsigned)__builtin_amdgcn_sbfe((int)w2, crow(r, 0), 1); c[r] = __uint_as_float((nb & mm) | (0xFF800000u & ~mm)); }
}
__device__ __forceinline__ void cinit_splat(f32x16& c, float v) {
#pragma unroll
    for (int r = 0; r < 16; ++r) c[r] = v;
}
__device__ __forceinline__ void pv(f32x16* o, const LAS unsigned char* Vs, int lane, int hi, const u32x4 (&pw)[4]) {
    const LAS unsigned char* vb = Vs + ((lane >> 4) & 1) * 32 + (lane & 3) * 8 + (4 * hi + ((lane & 15) >> 2)) * 64;
#pragma unroll
    for (int d0 = 0; d0 < 2; ++d0) {
        s16x4 lo[4], hh[4];
#pragma unroll
        for (int ks = 0; ks < 4; ++ks) { lo[ks] = vtr(vb + d0 * 4096 + ks * 1024); hh[ks] = vtr(vb + d0 * 4096 + ks * 1024 + 512); }
        asm volatile("s_waitcnt lgkmcnt(0)" ::: "memory"); __builtin_amdgcn_sched_barrier(0);
        __builtin_amdgcn_s_setprio(1);
#pragma unroll
        for (int ks = 0; ks < 4; ++ks) { const bf16x8 vf = {lo[ks][0], lo[ks][1], lo[ks][2], lo[ks][3], hh[ks][0], hh[ks][1], hh[ks][2], hh[ks][3]};
            o[d0] = __builtin_amdgcn_mfma_f32_32x32x16_bf16(__builtin_bit_cast(bf16x8, pw[ks]), vf, o[d0], 0, 0, 0); }
        __builtin_amdgcn_s_setprio(0);
    }
}
__device__ __forceinline__ void softmax_step(f32x16& p0, f32x16& p1, float& m, float& l, f32x16* o, LAS float* wsf, int r32, int hi, u32x4 (&pw)[4]) {
    float rm = fmaxf(p0[0], p1[0]);
#pragma unroll
    for (int r = 1; r < 16; ++r) rm = fmaxf(rm, fmaxf(p0[r], p1[r]));
    rm = fmaxf(rm, __shfl_xor(rm, 32));
    if (__any(rm > m)) {
        const float mn = fmaxf(m, rm), f = ex2(m - mn);
        l *= f; m = mn;
        if (hi == 0) wsf[r32] = f;
#pragma unroll
        for (int r = 0; r < 16; ++r) { const float fr = wsf[crow(r, hi)]; o[0][r] *= fr; o[1][r] *= fr; }
    }
    float s = 0.f;
#pragma unroll
    for (int r = 0; r < 16; ++r) { p0[r] = ex2(p0[r] - m); p1[r] = ex2(p1[r] - m); s += p0[r] + p1[r]; }
    l += s;
    pw[0] = u32x4{cvtpk(p0[0], p0[1]), cvtpk(p0[2], p0[3]), cvtpk(p0[4], p0[5]), cvtpk(p0[6], p0[7])};
    pw[1] = u32x4{cvtpk(p0[8], p0[9]), cvtpk(p0[10], p0[11]), cvtpk(p0[12], p0[13]), cvtpk(p0[14], p0[15])};
    pw[2] = u32x4{cvtpk(p1[0], p1[1]), cvtpk(p1[2], p1[3]), cvtpk(p1[4], p1[5]), cvtpk(p1[6], p1[7])};
    pw[3] = u32x4{cvtpk(p1[8], p1[9]), cvtpk(p1[10], p1[11]), cvtpk(p1[12], p1[13]), cvtpk(p1[14], p1[15])};
}
__device__ __forceinline__ unsigned mbit(unsigned c) { return 16u * ((c >> 2) & 1u) + 15u - ((c & 3u) + 4u * (c >> 3)); }
__device__ __forceinline__ void mask_bits(f32x16& p, unsigned w, int hi) {
    unsigned w2 = w << (16 * (1 - hi)); const float ninf = NEG_INF;
#pragma unroll
    for (int r = 0; r < 16; ++r) { float pr = p[r]; asm("v_add_co_u32 %0, vcc, %0, %0\n\tv_cndmask_b32 %1, %2, %1, vcc" : "+v"(w2), "+v"(pr) : "v"(ninf) : "vcc"); p[r] = pr; }
}
constexpr float THRL = 8.f;
__device__ __forceinline__ void partialSM(f32x16& p0, f32x16& p1, float& m_reg, float& alpha, bool& seen, f32x16& cneg, bool off = false) {
    float a = max3f(p0[0], p0[1], p1[0]), b = max3f(p0[2], p0[3], p1[1]); a = max3f(a, p1[2], p1[3]);
#pragma unroll
    for (int r = 4; r < 16; r += 4) { a = max3f(a, p0[r], p0[r + 1]); b = max3f(b, p0[r + 2], p0[r + 3]); a = max3f(a, p1[r], p1[r + 1]); b = max3f(b, p1[r + 2], p1[r + 3]); }
    float pmax = max3f(a, b, b);
    { auto rr = __builtin_amdgcn_permlane32_swap(__float_as_uint(pmax), __float_as_uint(pmax), false, false); pmax = max3f(__uint_as_float(rr[0]), __uint_as_float(rr[1]), __uint_as_float(rr[1])); }
    if (off) pmax = NEG_INF;
    const bool fin = pmax > NEG_INF, init = fin && !seen, up = seen && pmax > THRL;
    alpha = 1.f;
    if (__builtin_expect(__any(init || up), 0)) { const float dl = (init || up) ? pmax : 0.f; alpha = up ? ex2(-dl) : 1.f; m_reg += dl; cinit_splat(cneg, -m_reg);
#pragma unroll
        for (int r = 0; r < 16; ++r) { p0[r] -= dl; p1[r] -= dl; } }
    seen = seen || fin;
#pragma unroll
    for (int r = 0; r < 16; ++r) p0[r] = ex2(p0[r]);
}
__device__ __forceinline__ void finishSM(f32x16& p0, f32x16& p1, float alpha, float& l_reg, u32x4 (&pw)[4], bool off = false) {
#pragma unroll
    for (int r = 0; r < 16; ++r) p1[r] = ex2(p1[r]);
    float ps = 0.f;
#pragma unroll
    for (int r = 0; r < 16; ++r) ps += p0[r] + p1[r];
    if (off) ps = 0.f;
    l_reg = l_reg * alpha + ps;
    pw[0] = u32x4{cvtpk(p0[0], p0[1]), cvtpk(p0[2], p0[3]), cvtpk(p0[4], p0[5]), cvtpk(p0[6], p0[7])};
    pw[1] = u32x4{cvtpk(p0[8], p0[9]), cvtpk(p0[10], p0[11]), cvtpk(p0[12], p0[13]), cvtpk(p0[14], p0[15])};
    pw[2] = u32x4{cvtpk(p1[0], p1[1]), cvtpk(p1[2], p1[3]), cvtpk(p1[4], p1[5]), cvtpk(p1[6], p1[7])};
    pw[3] = u32x4{cvtpk(p1[8], p1[9]), cvtpk(p1[10], p1[11]), cvtpk(p1[12], p1[13]), cvtpk(p1[14], p1[15])};
    if (off) { pw[0] = u32x4{0u, 0u, 0u, 0u}; pw[1] = pw[0]; pw[2] = pw[0]; pw[3] = pw[0]; }
}
__device__ __forceinline__ void rescale_o(f32x16* o, float alpha, LAS float* wsf, int r32, int hi) {
    if (__any(alpha < 1.f)) { if (hi == 0) wsf[r32] = alpha;
#pragma unroll
        for (int r = 0; r < 16; ++r) { const float fr = wsf[crow(r, hi)]; o[0][r] *= fr; o[1][r] *= fr; } }
}
#define SBAR_() __builtin_amdgcn_sched_barrier(0)
template <class Stg, class MaskF>
__device__ __forceinline__ void flash_loop(int t0, int nt, Stg& sg, const MaskF& mk, const bf16x8* qf, LAS unsigned char* kb, LAS unsigned char* vb, int bstride,
                                           float& m_reg, float& l_reg, f32x16* o, LAS float* wsf, int lane, int r32, int hi, bool preloaded = false) {
    f32x16 pA0, pA1, pB0, pB1, cneg; float alA = 1.f, alB = 1.f; u32x4 pw[4]; bool seen = false; cinit_splat(cneg, -m_reg);
    if (!preloaded) sg.load(t0);
    sg.store(0); __syncthreads();
    if (nt > 1) sg.load(t0 + 1); else sg.load_after();
    qkt_c(pA0, pA1, cneg, kb, qf, r32, hi); mk.post(pA0, pA1, t0); partialSM(pA0, pA1, m_reg, alA, seen, cneg);
    if (nt > 1) sg.store(1);
    __syncthreads();
#define FL_STEP(C0, C1, ALC, P0, P1, ALP, J) do { const int cb_ = ((J) & 1) * bstride, pb_ = (((J) - 1) & 1) * bstride; \
        if ((J) + 1 < nt) sg.load(t0 + (J) + 1); else sg.load_after(); \
        SBAR_(); qkt_c(C0, C1, cneg, kb + cb_, qf, r32, hi); \
        finishSM(P0, P1, ALP, l_reg, pw); SBAR_(); \
        pv(o, vb + pb_, lane, hi, pw); mk.post(C0, C1, t0 + (J)); partialSM(C0, C1, m_reg, ALC, seen, cneg); \
        __syncthreads(); \
        if ((J) + 1 < nt) sg.store(((J) + 1) & 1); \
        rescale_o(o, ALC, wsf, r32, hi); \
        __syncthreads(); } while (0)
    int j = 1;
    for (; j + 1 < nt; j += 2) { FL_STEP(pB0, pB1, alB, pA0, pA1, alA, j); FL_STEP(pA0, pA1, alA, pB0, pB1, alB, j + 1); }
    if (j < nt) { FL_STEP(pB0, pB1, alB, pA0, pA1, alA, j); ++j; }
    if (nt & 1) { finishSM(pA0, pA1, alA, l_reg, pw); SBAR_(); pv(o, vb, lane, hi, pw); }
    else { finishSM(pB0, pB1, alB, l_reg, pw); SBAR_(); pv(o, vb + bstride, lane, hi, pw); }
#undef FL_STEP
    __syncthreads();
}
template <class Stg, class MaskF>
__device__ __forceinline__ void flash_loop_r(int t0, int nt, Stg& sg, const MaskF& mk, const bf16x8* qf, LAS unsigned char* kb, int kstride, LAS unsigned char* vb, int vstride,
                                             float& m_reg, float& l_reg, f32x16* o, LAS float* wsf, int lane, int r32, int hi, bool preloaded = false) {
    f32x16 pA0, pA1, pB0, pB1, cneg; float alA = 1.f, alB = 1.f; u32x4 pw[4]; bool seen = false; cinit_splat(cneg, -m_reg);
    if (!preloaded) sg.load(t0);
    sg.store(0, 0); __syncthreads();
    if (nt > 1) sg.load(t0 + 1); else sg.load_after();
    qkt_c(pA0, pA1, cneg, kb, qf, r32, hi); mk.post(pA0, pA1, t0); partialSM(pA0, pA1, m_reg, alA, seen, cneg);
    if (nt > 1) sg.store(1, 1);
    __syncthreads();
    int vprev = 0, vcur = 1, vnext = 2;
#define FR_STEP(C0, C1, ALC, P0, P1, ALP, J) do { \
        if ((J) + 1 < nt) sg.load(t0 + (J) + 1); else sg.load_after(); \
        SBAR_(); qkt_c(C0, C1, cneg, kb + ((J) & 1) * kstride, qf, r32, hi); \
        finishSM(P0, P1, ALP, l_reg, pw); SBAR_(); \
        pv(o, vb + vprev * vstride, lane, hi, pw); mk.post(C0, C1, t0 + (J)); partialSM(C0, C1, m_reg, ALC, seen, cneg); \
        rescale_o(o, ALC, wsf, r32, hi); \
        if ((J) + 1 < nt) sg.store(((J) + 1) & 1, vnext); \
        __syncthreads(); \
        { const int t_ = vprev; vprev = vcur; vcur = vnext; vnext = t_; } } while (0)
    int j = 1;
    for (; j + 1 < nt; j += 2) { FR_STEP(pB0, pB1, alB, pA0, pA1, alA, j); FR_STEP(pA0, pA1, alA, pB0, pB1, alB, j + 1); }
    if (j < nt) { FR_STEP(pB0, pB1, alB, pA0, pA1, alA, j); ++j; }
    if (nt & 1) { finishSM(pA0, pA1, alA, l_reg, pw); SBAR_(); pv(o, vb + vprev * vstride, lane, hi, pw); }
    else { finishSM(pB0, pB1, alB, l_reg, pw); SBAR_(); pv(o, vb + vprev * vstride, lane, hi, pw); }
#undef FR_STEP
    __syncthreads();
}
template <class Stg, class MaskF>
__device__ __forceinline__ void flash_loop_b(int t0, int nt, Stg& sg, const MaskF& mk, const bf16x8* qf, LAS unsigned char* kb, LAS unsigned char* vb, int bstride,
                                             float& m_reg, float& l_reg, f32x16* o, LAS float* wsf, int lane, int r32, int hi, bool preloaded = false) {
    f32x16 c0, c1, cneg; u32x4 pw[4]; float alpha = 1.f; bool seen = false; cinit_splat(cneg, -m_reg);
    if (!preloaded) sg.load(t0);
    sg.store(0); __syncthreads();
    if (nt > 1) sg.load(t0 + 1); else sg.load_after();
    qkt_c(c0, c1, cneg, kb, qf, r32, hi); mk.post(c0, c1, t0);
    { const bool off = mk.lane_off(t0); partialSM(c0, c1, m_reg, alpha, seen, cneg, off); finishSM(c0, c1, alpha, l_reg, pw, off); }
    if (nt > 1) sg.store(1);
    __syncthreads();
    for (int j = 1; j < nt; ++j) {
        const int cb_ = (j & 1) * bstride, pb_ = ((j - 1) & 1) * bstride;
        if (j + 1 < nt) sg.load(t0 + j + 1); else sg.load_after();
        SBAR_(); qkt_c(c0, c1, cneg, kb + cb_, qf, r32, hi);
        pv(o, vb + pb_, lane, hi, pw);
        mk.post(c0, c1, t0 + j);
        { const bool off = mk.lane_off(t0 + j); partialSM(c0, c1, m_reg, alpha, seen, cneg, off); finishSM(c0, c1, alpha, l_reg, pw, off); }
        __syncthreads();
        if (j + 1 < nt) sg.store((j + 1) & 1);
        rescale_o(o, alpha, wsf, r32, hi);
        __syncthreads();
    }
    pv(o, vb + ((nt - 1) & 1) * bstride, lane, hi, pw);
    __syncthreads();
}
__device__ __forceinline__ float stage_o(const f32x16* o, float ltot, LAS float* wsf, LAS float* stg, int lane, int r32, int hi) {
    if (hi == 0) wsf[r32] = 1.f / fmaxf(ltot, 1e-30f);
#pragma unroll
    for (int r = 0; r < 16; ++r) { const int q = crow(r, hi), sw = r32 ^ ((q & 7) << 2); const float rl = wsf[q]; stg[q * 64 + sw] = o[0][r] * rl; stg[q * 64 + 32 + sw] = o[1][r] * rl; }
    const LAS f32x4* rowp = (const LAS f32x4*)(stg + (lane >> 1) * 64 + (lane & 1) * 32); float ss = 0.f; const int qs = (lane >> 1) & 7;
#pragma unroll
    for (int i = 0; i < 8; ++i) { const f32x4 v = rowp[i ^ qs]; ss += (v[0] * v[0] + v[1] * v[1]) + (v[2] * v[2] + v[3] * v[3]); }
    ss += __shfl_xor(ss, 1);
    return ss;
}
__device__ __forceinline__ void store_o(const LAS float* stg, float rinv, const float* __restrict__ gain, bf16* __restrict__ dst, int lane) {
    const LAS f32x4* rowp = (const LAS f32x4*)(stg + (lane >> 1) * 64 + (lane & 1) * 32); const f32x4* gp = (const f32x4*)(gain + (lane & 1) * 32); const int qs = (lane >> 1) & 7;
#if MIXED_F8
    u32x4* dp = (u32x4*)((unsigned char*)dst + (lane & 1) * 32);
#pragma unroll
    for (int i = 0; i < 2; ++i) { u32x4 o;
#pragma unroll
        for (int d = 0; d < 4; ++d) { const f32x4 a = rowp[(4 * i + d) ^ qs] * rinv * gp[4 * i + d];
            int p = __builtin_amdgcn_cvt_pk_fp8_f32(a[0], a[1], 0, false); p = __builtin_amdgcn_cvt_pk_fp8_f32(a[2], a[3], p, true); o[d] = (unsigned)p; }
        dp[i] = o; }
#else
    u32x4* dp = (u32x4*)(dst + (lane & 1) * 32);
#pragma unroll
    for (int i = 0; i < 4; ++i) { const f32x4 a = rowp[(2 * i) ^ qs] * rinv * gp[2 * i], b2 = rowp[(2 * i + 1) ^ qs] * rinv * gp[2 * i + 1];
        dp[i] = u32x4{cvtpk(a[0], a[1]), cvtpk(a[2], a[3]), cvtpk(b2[0], b2[1]), cvtpk(b2[2], b2[3])}; }
#endif
}

constexpr int NB = 256, CAP = 64;
constexpr int L_IQ = 0, L_NRM = 16384, L_KV = 0, L_HIST = 32768, HSTR = 257  , L_MASK = 65792, MSTR = 66  , L_CAND = 74240, L_QI = 90624, L_WSF = 98304, L_ROWSQ = 100352, L_STG = 32768;
typedef u32x2 DsaCand;
__device__ __forceinline__ int idx_bin(float v, float lo, float invw, bool filt) { const float f = (v - lo) * invw; int b = (int)f; b = b > NB - 1 ? NB - 1 : b; return (f >= 0.f) ? b : (filt ? -1 : 0); }
__device__ __forceinline__ void idx_tile(float (&idx)[16], const bf16x8 a0, const bf16x8 a1, const LAS unsigned char* iqs, const float (&w)[8], int lane) {
#pragma unroll
    for (int r = 0; r < 16; ++r) idx[r] = 0.f;
    const LAS bf16x8* fq = (const LAS bf16x8*)(iqs + lane * 16);
    bf16x8 b0 = fq[0], b1 = fq[64], n0 = fq[128], n1 = fq[192];
    f32x16 c = __builtin_amdgcn_mfma_f32_32x32x16_bf16(a0, b0, f32x16{}, 0, 0, 0);
    c = __builtin_amdgcn_mfma_f32_32x32x16_bf16(a1, b1, c, 0, 0, 0);
#pragma unroll
    for (int h = 0; h < 8; ++h) {
        f32x16 cn = c;
        if (h < 7) { b0 = n0; b1 = n1;
            if (h < 6) { n0 = fq[((h + 2) * 2 + 0) * 64]; n1 = fq[((h + 2) * 2 + 1) * 64]; }
            cn = __builtin_amdgcn_mfma_f32_32x32x16_bf16(a0, b0, f32x16{}, 0, 0, 0);
            cn = __builtin_amdgcn_mfma_f32_32x32x16_bf16(a1, b1, cn, 0, 0, 0); }
#pragma unroll
        for (int r = 0; r < 16; ++r) idx[r] = fmaf(w[h], fmaxf(c[r], 0.f), idx[r]);
        c = cn;
        __builtin_amdgcn_sched_barrier(0);
    }
#pragma unroll
    for (int r = 0; r < 16; ++r) idx[r] *= IDX_SCALE;
}
__device__ __forceinline__ void dsa_unit(LAS unsigned char* L, const bf16* __restrict__ act, const float* __restrict__ mix_gain, bf16* __restrict__ mixed, DsaCand* __restrict__ gcand, float* __restrict__ gidx, int b, int qt) {
    int tid = threadIdx.x; asm volatile("" : "+v"(tid));
    const int lane = tid & 63, r32 = lane & 31, hi = lane >> 5; const int w = __builtin_amdgcn_readfirstlane(tid >> 6);
    LAS unsigned* hist = (LAS unsigned*)(L + L_HIST); LAS unsigned* mask = (LAS unsigned*)(L + L_MASK); LAS DsaCand* cand = (LAS DsaCand*)(L + L_CAND);
    LAS unsigned* q_cnt = (LAS unsigned*)(L + L_QI); LAS int* q_B = (LAS int*)(L + L_QI + 128); LAS int* q_need = (LAS int*)(L + L_QI + 256);
    LAS float* wsf = (LAS float*)(L + L_WSF) + w * 64; LAS float* rowsq = (LAS float*)(L + L_ROWSQ);
    const int tq = qt * 32 + r32; const size_t rowq = (size_t)b * SEQ + tq; const bf16* ab = act + (size_t)b * SEQ * ACT_COLS;
    bf16x8 qf[4]; u32x4 kpre, vpre;
    const bf16* kg0 = ab + (size_t)lane * ACT_COLS + C_DK + 8 * w;
    const bf16* vg0 = ab + (size_t)(16 * (w & 3) + (lane >> 2)) * ACT_COLS + C_DV + 32 * (w >> 2) + 8 * (lane & 3);
    TIC(11); TIC(20);
    {
        if (w == 0) { __builtin_amdgcn_fence(__ATOMIC_ACQUIRE, "agent"); asm volatile("s_waitcnt vmcnt(0)" ::: "memory"); }
        const bf16* ar = act + rowq * ACT_COLS;
        const bf16x8 i0 = *(const bf16x8*)(ar + C_IQ + w * 32 + 8 * hi), i1 = *(const bf16x8*)(ar + C_IQ + w * 32 + 16 + 8 * hi);
        const u32x4 wv = *(const u32x4*)(ar + C_IW);
        for (int i = tid; i < (L_CAND - L_HIST) / 16; i += NT) ((LAS u32x4*)(L + L_HIST))[i] = u32x4{0u, 0u, 0u, 0u};
        if (tid < 128) ((LAS unsigned*)(L + L_QI))[tid] = (tid >= 32 && tid < 64) ? 0xFFFFFFFFu : 0u;
        __syncthreads();
        float wq[8];
        const LAS unsigned char* iqs = L + L_IQ; LAS float* nrm = (LAS float*)(L + L_NRM);
        {
            *(LAS bf16x8*)(L + L_IQ + ((w * 2 + 0) * 64 + lane) * 16) = i0; *(LAS bf16x8*)(L + L_IQ + ((w * 2 + 1) * 64 + lane) * 16) = i1;
            float n2 = 0.f;
#pragma unroll
            for (int j = 0; j < 8; ++j) { const float a = __uint_as_float(((unsigned)(unsigned short)i0[j]) << 16), c = __uint_as_float(((unsigned)(unsigned short)i1[j]) << 16); n2 += a * a + c * c; }
            n2 += __shfl_xor(n2, 32);
            if (hi == 0) nrm[w * 32 + r32] = n2;
        }
        {
#pragma unroll
          for (int e = 0; e < 4; ++e) { wq[2 * e] = __uint_as_float(wv[e] << 16); wq[2 * e + 1] = __uint_as_float(wv[e] & 0xffff0000u); } }
        __syncthreads();
        TOC(20);
        float lo = 0.f, invw = 0.f; bool filtF = true;
        if (qt >= 8) {
            float sk2;
            { const bf16x8 k0 = *(const bf16x8*)(ar + C_IK + 8 * hi), k1 = *(const bf16x8*)(ar + C_IK + 16 + 8 * hi); float s = 0.f;
#pragma unroll
              for (int j = 0; j < 8; ++j) { const float a = __uint_as_float(((unsigned)(unsigned short)k0[j]) << 16), c = __uint_as_float(((unsigned)(unsigned short)k1[j]) << 16); s += a * a + c * c; }
              sk2 = wave_sum(s) * (1.f / 1024.f); }
            float sm = 0.f, sv = 0.f;
#pragma unroll
            for (int h = 0; h < 8; ++h) { const float n2 = nrm[h * 32 + r32]; sm += wq[h] * sqrtf(n2); sv += wq[h] * wq[h] * n2; }
            const float sk = sqrtf(sk2), mu = IDX_SCALE * sk * 0.3989423f * sm, sig = fmaxf(IDX_SCALE * sk * sqrtf(0.3408f * sv), 1e-20f);
            const float tail = fminf(1.f, 700.f / (float)(tq + 1));
            const float zq = tail < 0.95f ? -__logf(tail / (1.f - tail)) * (1.f / 1.702f) : -6.f;
            LAS unsigned* q_fail = (LAS unsigned*)(L + L_QI + 384);
            for (int attempt = 0; attempt < 2; ++attempt) {
                const bool filt = attempt == 0; filtF = filt;
                lo = mu + (filt ? zq : -6.f) * sig; invw = (float)NB / ((mu + 6.f * sig) - lo);
                if (attempt == 1) { for (int i = tid; i < (L_MASK - L_HIST) / 16; i += NT) ((LAS u32x4*)(L + L_HIST))[i] = u32x4{0u, 0u, 0u, 0u}; __syncthreads(); }
                TIC(21);
                for (int repH = 0; repH < ((PROBE_DUP == 28) ? 2 : 1); ++repH) {
                    const float lo_h = (PROBE_DUP == 28 && repH == 0) ? 3.0e38f : lo;
                    const bf16* ikp = ab + (size_t)r32 * ACT_COLS + C_IK + 8 * hi;
                    bf16x8 a0 = *(const bf16x8*)(ikp + (size_t)w * 32 * ACT_COLS), a1 = *(const bf16x8*)(ikp + (size_t)w * 32 * ACT_COLS + 16);
                    for (int kt = w; kt <= qt; kt += 8) {
                        const bf16x8 c0 = a0, c1 = a1;
                        if (kt + 8 <= qt) { a0 = *(const bf16x8*)(ikp + (size_t)(kt + 8) * 32 * ACT_COLS); a1 = *(const bf16x8*)(ikp + (size_t)(kt + 8) * 32 * ACT_COLS + 16); }
                        float idx[16]; idx_tile(idx, c0, c1, iqs, wq, lane);
                        if (filt) { f32x4* gp = (f32x4*)(gidx + ((size_t)kt * 64 + lane) * 16);
#pragma unroll
                            for (int i = 0; i < 4; ++i) gp[i] = f32x4{idx[4 * i], idx[4 * i + 1], idx[4 * i + 2], idx[4 * i + 3]}; }
                        const int lim = tq - kt * 32 - 4 * hi;
#pragma unroll
                        for (int r = 0; r < 16; ++r) { const int bn = idx_bin(idx[r], lo_h, invw, filt);
                            if (crow(r, 0) <= lim && bn >= 0) { __hip_atomic_fetch_add(hist + r32 * HSTR + bn, 1u, __ATOMIC_RELAXED, __HIP_MEMORY_SCOPE_WORKGROUP);
#if PROBE_DUP == 26
                                __hip_atomic_fetch_add((LAS unsigned*)(L + 17408) + tid * 7 + (bn % 7), 1u, __ATOMIC_RELAXED, __HIP_MEMORY_SCOPE_WORKGROUP);
#endif
#if PROBE_DUP == 27
                                { LAS unsigned* pp = (LAS unsigned*)(L + 17408) + tid * 7 + (bn % 7); *pp = *pp + 1u; }
#endif
                            } }
                    }
                }
                asm volatile("s_waitcnt vmcnt(0)" ::: "memory");
                __syncthreads();
                TOC(21); TIC(22);
                {
                    const int grp = lane >> 4, sl = lane & 15, q = w * 4 + grp; const LAS unsigned* hrow = hist + q * HSTR + 16 * sl;
                    int c[16];
#pragma unroll
                    for (int i = 0; i < 16; ++i) c[i] = (int)hrow[i];
                    int cl = 0;
#pragma unroll
                    for (int i = 0; i < 16; ++i) cl += c[i];
                    int S = cl;
#pragma unroll
                    for (int o = 1; o < 16; o <<= 1) { const int v = __shfl_down(S, o, 16); if (sl + o < 16) S += v; }
                    const unsigned long long bal = __ballot(S >= IDX_TOPK);
                    const unsigned gb = (unsigned)(bal >> (16 * grp)) & 0xFFFFu;
                    if (gb == 0u) { if (sl == 0) q_fail[0] = 1u; }
                    else {
                        const int Lh = 31 - __clz((int)gb);
                        int above = S - cl, Bq = -1, ca = 0;
#pragma unroll
                        for (int i = 15; i >= 0; --i) { if (Bq < 0) { if (above + c[i] >= IDX_TOPK) { Bq = 16 * sl + i; ca = above; } else above += c[i]; } }
                        if (sl == Lh) { q_B[q] = Bq; q_need[q] = IDX_TOPK - ca; }
                    }
                }
                __syncthreads();
                TOC(22);
                const bool failed = q_fail[0] != 0u;
                if (!failed || attempt == 1) break;
                __syncthreads();
                if (tid == 0) q_fail[0] = 0u;
            }
        }
        TIC(23);
        const int Bq = q_B[r32];
        if (qt >= 8) {
            const f32x4* gp0 = (const f32x4*)(gidx + (size_t)lane * 16);
            f32x4 v0 = gp0[(size_t)w * 256], v1 = gp0[(size_t)w * 256 + 1], v2 = gp0[(size_t)w * 256 + 2], v3 = gp0[(size_t)w * 256 + 3];
            for (int kt = w; kt <= qt; kt += 8) {
                const float idx[16] = {v0[0], v0[1], v0[2], v0[3], v1[0], v1[1], v1[2], v1[3], v2[0], v2[1], v2[2], v2[3], v3[0], v3[1], v3[2], v3[3]};
                if (kt + 8 <= qt) { const f32x4* gn = gp0 + (size_t)(kt + 8) * 256; v0 = gn[0]; v1 = gn[1]; v2 = gn[2]; v3 = gn[3]; }
                unsigned word = 0u, cb = 0u; const int lim = tq - kt * 32 - 4 * hi;
#pragma unroll
                for (int r = 0; r < 16; ++r) {
                    if (crow(r, 0) <= lim) { const int bn = idx_bin(idx[r], lo, invw, filtF);
                        if (bn > Bq) word |= 1u << (15 - r);
                        else if (bn == Bq) cb |= 1u << r; } }
                if (word) __hip_atomic_fetch_or(mask + r32 * MSTR + kt, word << (16 * hi), __ATOMIC_RELAXED, __HIP_MEMORY_SCOPE_WORKGROUP);
                while (__any(cb != 0u)) {
                    if (cb != 0u) { const int r = __builtin_ctz(cb); cb &= cb - 1u;
                        float v = idx[0];
#pragma unroll
                        for (int e = 1; e < 16; ++e) v = (r == e) ? idx[e] : v;
                        const int c = (r & 3) + 8 * (r >> 2) + 4 * hi;
                        const unsigned slot = __hip_atomic_fetch_add(q_cnt + r32, 1u, __ATOMIC_RELAXED, __HIP_MEMORY_SCOPE_WORKGROUP); const DsaCand cnd = {__float_as_uint(v), (unsigned)(kt * 32 + c)};
                        if (slot < (unsigned)CAP) cand[r32 * CAP + slot] = cnd;
                        gcand[(size_t)r32 * SEQ + slot] = cnd; } }
            }
        } else {
            for (int kt = w; kt <= qt; kt += 8) { const int lim = tq - kt * 32 - 4 * hi; unsigned word = 0u;
#pragma unroll
                for (int r = 0; r < 16; ++r) if (crow(r, 0) <= lim) word |= 1u << (15 - r);
                if (word) __hip_atomic_fetch_or(mask + r32 * MSTR + kt, word << (16 * hi), __ATOMIC_RELAXED, __HIP_MEMORY_SCOPE_WORKGROUP); }
        }
        asm volatile("s_waitcnt vmcnt(0)" ::: "memory");
        __syncthreads();
        TOC(23); TIC(24);
        { const bf16* qp = ab + (size_t)tq * ACT_COLS + C_DQ + w * 64 + 8 * hi;
#pragma unroll
          for (int d0 = 0; d0 < 4; ++d0) qf[d0] = *(const bf16x8*)(qp + d0 * 16);
          kpre = *(const u32x4*)kg0; vpre = *(const u32x4*)vg0; }
#pragma unroll 1
        for (int qq = 0; qq < ((PROBE_DUP == 29) ? 8 : 4); ++qq) {
            const int q = w * 4 + (qq & 3); const int nc = (int)q_cnt[q], need = q_need[q];
            if (nc <= CAP) {
                DsaCand me = {0u, 0u}; if (lane < nc) me = cand[q * CAP + lane];
                const float mv = __uint_as_float(me[0]); int rk = 0;
                for (int j = 0; j < nc; ++j) { const float ov = __uint_as_float((unsigned)__builtin_amdgcn_readlane((int)me[0], j)); const unsigned ok = (unsigned)__builtin_amdgcn_readlane((int)me[1], j);
                    rk += (ov > mv || (ov == mv && ok < me[1])) ? 1 : 0; }
                if (lane < nc && rk < need) __hip_atomic_fetch_or(mask + q * MSTR + (me[1] >> 5), 1u << mbit(me[1] & 31u), __ATOMIC_RELAXED, __HIP_MEMORY_SCOPE_WORKGROUP);
            } else {
                const unsigned long long* gc = (const unsigned long long*)(gcand + (size_t)q * SEQ);
                for (int i0 = 0; i0 < nc; i0 += 64) { const int i = i0 + lane;
                    if (i < nc) { const unsigned long long me = __hip_atomic_load(gc + i, __ATOMIC_RELAXED, __HIP_MEMORY_SCOPE_AGENT); const float mv = __uint_as_float((unsigned)me); const unsigned mk = (unsigned)(me >> 32); int rk = 0;
                        for (int j = 0; j < nc; ++j) { const unsigned long long ot = __hip_atomic_load(gc + j, __ATOMIC_RELAXED, __HIP_MEMORY_SCOPE_AGENT); const float ov = __uint_as_float((unsigned)ot); const unsigned ok = (unsigned)(ot >> 32);
                            rk += (ov > mv || (ov == mv && ok < mk)) ? 1 : 0; }
                        if (rk < need) __hip_atomic_fetch_or(mask + q * MSTR + (mk >> 5), 1u << mbit(mk & 31u), __ATOMIC_RELAXED, __HIP_MEMORY_SCOPE_WORKGROUP); } }
            }
        }
        __syncthreads();
    }
    TOC(24); TOC(11);
    TIC(12);
    const int ntile = (qt >> 1) + 1;
    struct DsaStg { const bf16* kg; const bf16* vg; LAS unsigned char* kdst; u32x4 kreg, vreg;
        __device__ __forceinline__ void load(int t) { kreg = *(const u32x4*)(kg + (size_t)t * 64 * ACT_COLS); vreg = *(const u32x4*)(vg + (size_t)t * 64 * ACT_COLS); }
        __device__ __forceinline__ void store(int ks, int vs) { *(LAS u32x4*)(kdst + ks * 8192) = kreg; *(LAS u32x4*)(kdst + 16384 + vs * 8192) = vreg; }
        __device__ __forceinline__ void load_after() {} };
    struct DsaMask { const LAS unsigned* mrow; int hi;
        __device__ __forceinline__ void operator()(f32x16& c0, f32x16& c1, int t, float negm) const { cinit_splat(c0, negm); cinit_splat(c1, negm); }
        __device__ __forceinline__ void post(f32x16& p0, f32x16& p1, int t) const { const u32x2 mw = *(const LAS u32x2*)(mrow + 2 * t); mask_bits(p0, mw[0], hi); mask_bits(p1, mw[1], hi); } };
    DsaStg sg; sg.kg = kg0; sg.vg = vg0; sg.kreg = kpre; sg.vreg = vpre;
    sg.kdst = L + L_KV + w * 1024 + lane * 16;
    DsaMask mk{mask + r32 * MSTR, hi};
    float m = 0.f, l = 0.f; f32x16 o[2]; o[0] = f32x16{}; o[1] = f32x16{};
    flash_loop_r(0, ntile, sg, mk, qf, L + L_KV, 8192, L + L_KV + 16384, 8192, m, l, o, wsf, lane, r32, hi, true);
    const float ltot = l + __shfl_xor(l, 32);
    LAS float* stg = (LAS float*)(L + L_STG) + w * 2048;
    const float ss = stage_o(o, ltot, wsf, stg, lane, r32, hi);
    if ((lane & 1) == 0) rowsq[w * 32 + (lane >> 1)] = ss;
    __syncthreads();
    float tot = 0.f;
#pragma unroll
    for (int h = 0; h < 8; ++h) tot += rowsq[h * 32 + (lane >> 1)];
    const float rinv = rsqrtf(tot * (1.f / 512.f) + LN_EPS);
    store_o(stg, rinv, mix_gain + w * 64, MIXED_F8 ? (bf16*)((unsigned char*)mixed + ((size_t)b * SEQ + qt * 32 + (lane >> 1)) * D_MODEL + w * 64) : mixed + ((size_t)b * SEQ + qt * 32 + (lane >> 1)) * D_MODEL + w * 64, lane);
    __syncthreads();
    TOC(12);
}
}


namespace cmp {
using att::bf16x8; using att::f32x16; using att::crow; using att::cvtpk;
__device__ __forceinline__ void compress_unit(LAS unsigned char* L, const bf16* __restrict__ act, const bf16* __restrict__ w1t, const bf16* __restrict__ w2t, const float* __restrict__ bias1,
                                              bf16* __restrict__ kcb, float* __restrict__ kcf, int u) {
    const int tid = threadIdx.x, lane = tid & 63, r32 = lane & 31, hi = lane >> 5; const int w = __builtin_amdgcn_readfirstlane(tid >> 6);
    const int cb = u & 3, g = (u >> 2) & 1, b = (u >> 3) & 15, kv = u >> 7;
    const int c = cb * 32 + r32, cc = c < N_C ? c : N_C - 1;
    LAS float* part = (LAS float*)L;
    float b1v[8]; att::u32x2 w2lo[2], w2hh[2];
    { const int nb = w >> 1, s2 = w & 1;
#pragma unroll
      for (int j = 0; j < 8; ++j) b1v[j] = bias1[kv * CMP_HIDDEN + 32 * nb + crow(8 * s2 + j, hi)];
#pragma unroll
      for (int db = 0; db < 2; ++db) { const bf16* wp = w2t + ((size_t)kv * 64 + 32 * db + r32) * CMP_HIDDEN + 32 * nb + 16 * s2 + 4 * hi; w2lo[db] = *(const att::u32x2*)wp; w2hh[db] = *(const att::u32x2*)(wp + 8); } }
    TIC(25);
    {
        const bf16* arow = act + ((size_t)b * SEQ + cc * CMP_STRIDE) * 256 + (kv ? 128 : 0) + g * 64 + 8 * hi;
        const bf16* wrow = w1t + (size_t)kv * CMP_HIDDEN * 2048 + lane * 8;
        f32x16 acc[4]; acc[0] = f32x16{}; acc[1] = f32x16{}; acc[2] = f32x16{}; acc[3] = f32x16{};
#pragma unroll 8
        for (int i = 0; i < 16; ++i) { const int s = 16 * w + i;
            const bf16x8 bfr_ = *(const bf16x8*)(arow + (size_t)(s >> 2) * 256 + 16 * (s & 3));
#pragma unroll
            for (int nb = 0; nb < 4; ++nb) { const bf16x8 af = *(const bf16x8*)(wrow + ((size_t)nb * 128 + s) * 512); acc[nb] = __builtin_amdgcn_mfma_f32_32x32x16_bf16(af, bfr_, acc[nb], 0, 0, 0); } }
#pragma unroll
        for (int nb = 0; nb < 4; ++nb)
#pragma unroll
            for (int r = 0; r < 16; ++r) part[((w * 4 + nb) * 16 + r) * 64 + lane] = acc[nb][r];
    }
    __syncthreads();
    TOC(25); TIC(26);
    f32x16 acc2[2]; acc2[0] = f32x16{}; acc2[1] = f32x16{};
    {
        const int nb = w >> 1, s2 = w & 1; float x[8];
#pragma unroll
        for (int j = 0; j < 8; ++j) { const int r = 8 * s2 + j; float a = 0.f;
#pragma unroll
            for (int p = 0; p < 8; ++p) a += part[((p * 4 + nb) * 16 + r) * 64 + lane];
            a += b1v[j];
            const float uu = 0.7978845608028654f * (a + 0.044715f * a * a * a); x[j] = 0.5f * a * (1.f + tanhf(uu)); }
        const att::u32x4 xb = {cvtpk(x[0], x[1]), cvtpk(x[2], x[3]), cvtpk(x[4], x[5]), cvtpk(x[6], x[7])};
#pragma unroll
        for (int db = 0; db < 2; ++db) { const att::u32x2 lo = w2lo[db], hh = w2hh[db];
            const att::u32x4 af = {lo[0], lo[1], hh[0], hh[1]};
            acc2[db] = __builtin_amdgcn_mfma_f32_32x32x16_bf16(__builtin_bit_cast(bf16x8, af), __builtin_bit_cast(bf16x8, xb), acc2[db], 0, 0, 0); }
    }
    __syncthreads();
    TOC(26); TIC(27);
#pragma unroll
    for (int db = 0; db < 2; ++db)
#pragma unroll
        for (int r = 0; r < 16; ++r) part[((w * 2 + db) * 16 + r) * 64 + lane] = acc2[db][r];
    __syncthreads();
#pragma unroll
    for (int i = 0; i < 4; ++i) { const int e = tid + i * NT;
        const int ln = e & 63, r = (e >> 6) & 15, db = e >> 10; float a = 0.f;
#pragma unroll
        for (int p = 0; p < 8; ++p) a += part[((p * 2 + db) * 16 + r) * 64 + ln];
        const int c2 = cb * 32 + (ln & 31), d = 32 * db + crow(r, ln >> 5);
        const float v = c2 < N_C ? a : 0.f;
        kcb[(((size_t)kv * BATCH + b) * 128 + c2) * 128 + g * 64 + d] = (bf16)f2bf(v);
        if (kcf && c2 < N_C) kcf[(size_t)kv * BATCH * N_C * 128 + ((size_t)(b * N_C + c2) * 2 + g) * 64 + d] = bfr(v); }
    __syncthreads();
    TOC(27);
}
}

namespace att {
constexpr int N_SLAB = 65536, N_OUT = 65536, N_WSF = 135168, N_ROWSQ = 137216, N_SEL = 138240, N_IMPF = 139264;
struct KvStage { u32x4 k[2], v[2]; };
__device__ __forceinline__ void kv_load(KvStage& st, const bf16* __restrict__ kbase, const bf16* __restrict__ vbase, int pitch, int key0, int w, int lane) {
    const bf16* kp = kbase + (size_t)(key0 + lane) * pitch + 8 * w; const bf16* vp = vbase + (size_t)(key0 + 16 * (w & 3) + (lane >> 2)) * pitch + 32 * (w >> 2) + 8 * (lane & 3);
    st.k[0] = *(const u32x4*)kp; st.k[1] = *(const u32x4*)(kp + 64); st.v[0] = *(const u32x4*)vp; st.v[1] = *(const u32x4*)(vp + 64);
}
__device__ __forceinline__ void kv_store(const KvStage& st, LAS unsigned char* slot, int w, int lane) {
    LAS unsigned char* d = slot + w * 1024 + lane * 16;
    *(LAS u32x4*)d = st.k[0]; *(LAS u32x4*)(d + 8192) = st.k[1]; *(LAS u32x4*)(d + 16384) = st.v[0]; *(LAS u32x4*)(d + 24576) = st.v[1];
}
__device__ __forceinline__ void pack_p(u32x4 (&pw)[4], const f32x16& p0, const f32x16& p1) {
    pw[0] = u32x4{cvtpk(p0[0], p0[1]), cvtpk(p0[2], p0[3]), cvtpk(p0[4], p0[5]), cvtpk(p0[6], p0[7])};
    pw[1] = u32x4{cvtpk(p0[8], p0[9]), cvtpk(p0[10], p0[11]), cvtpk(p0[12], p0[13]), cvtpk(p0[14], p0[15])};
    pw[2] = u32x4{cvtpk(p1[0], p1[1]), cvtpk(p1[2], p1[3]), cvtpk(p1[4], p1[5]), cvtpk(p1[6], p1[7])};
    pw[3] = u32x4{cvtpk(p1[8], p1[9]), cvtpk(p1[10], p1[11]), cvtpk(p1[12], p1[13]), cvtpk(p1[14], p1[15])};
}
template <bool FIRST> __device__ __forceinline__ void accum_out(LAS float* OUTw, const f32x16* o, float fac, LAS float* wsf, int r32, int hi) {
    if (hi == 0) wsf[r32] = fac;
#pragma unroll
    for (int r = 0; r < 16; ++r) { const int q = crow(r, hi), sw = r32 ^ ((q & 7) << 2); const float f = wsf[q];
        if (FIRST) { OUTw[q * 64 + sw] = f * o[0][r]; OUTw[q * 64 + 32 + sw] = f * o[1][r]; }
        else { OUTw[q * 64 + sw] += f * o[0][r]; OUTw[q * 64 + 32 + sw] += f * o[1][r]; } }
}
__device__ __forceinline__ void nsa_unit(LAS unsigned char* L, const bf16* __restrict__ act, const bf16* __restrict__ kcb, const float* __restrict__ mix_gain, bf16* __restrict__ mixed, int b, int qt,
                                         bool pre_valid  , volatile LAS unsigned* nextp  , bool& prefetched) {
    int tid = threadIdx.x; asm volatile("" : "+v"(tid));
    const int lane = tid & 63, r32 = lane & 31, hi = lane >> 5; const int w = __builtin_amdgcn_readfirstlane(tid >> 6); const int g = w >> 2;
    LAS float* slab = (LAS float*)(L + N_SLAB); LAS float* OUTw = (LAS float*)(L + N_OUT) + w * 2048; LAS float* wsf = (LAS float*)(L + N_WSF) + w * 64;
    LAS float* rowsq = (LAS float*)(L + N_ROWSQ); LAS unsigned* selmask = (LAS unsigned*)(L + N_SEL); LAS float* impf = (LAS float*)(L + N_IMPF);
    const int tq = qt * 32 + r32; const size_t rowq = (size_t)b * SEQ + tq; const bf16* ab = act + (size_t)b * SEQ * ACT_COLS;
    bf16x8 qf[4];
    { const bf16* qp = act + rowq * ACT_COLS + C_NQ + w * 64 + 8 * hi;
#pragma unroll
      for (int d0 = 0; d0 < 4; ++d0) qf[d0] = *(const bf16x8*)(qp + d0 * 16); }
    const bf16* gp = act + rowq * ACT_COLS + C_NG + w * 3;
    const float gate0 = bf2f(gp[0]);
    LAS unsigned char* slot0 = L; LAS unsigned char* slot1 = L + 32768;
    f32x16 o[2];
    struct NsaStg { const bf16* kbase; const bf16* vbase; const bf16* kafter; const bf16* vafter; int key_after; LAS unsigned char* slot0; int w, lane; KvStage st;
        __device__ __forceinline__ void load(int t) { kv_load(st, kbase, vbase, ACT_COLS, t * 64, w, lane); }
        __device__ __forceinline__ void store(int bsel) { kv_store(st, slot0 + bsel * 32768, w, lane); }
        __device__ __forceinline__ void load_after() { if (kafter) kv_load(st, kafter, vafter, ACT_COLS, key_after, w, lane); } };
    NsaStg sg; sg.slot0 = slot0; sg.w = w; sg.lane = lane;
    TIC(13);
    {
        const bf16* kc = kcb + (size_t)b * 128 * 128; const bf16* vc = kcb + (size_t)(BATCH + b) * 128 * 128;
        if (!pre_valid) { KvStage a0, a1; kv_load(a0, kc, vc, 128, 0, w, lane); kv_load(a1, kc, vc, 128, 64, w, lane); kv_store(a0, slot0, w, lane); kv_store(a1, slot1, w, lane); }
        __syncthreads();
        kv_load(sg.st, ab + C_KSL, ab + C_VSL, ACT_COLS, 0, w, lane);
        f32x16 p[4];
        p[0] = f32x16{}; p[1] = f32x16{}; p[2] = f32x16{}; p[3] = f32x16{};
        qkt(p[0], p[1], slot0 + g * 8192, qf, r32, hi); qkt(p[2], p[3], slot1 + g * 8192, qf, r32, hi);
        const int n_adm = tq >= 31 ? min((tq - 31) / 16 + 1, N_C) : 0;
        float rm = NEG_INF;
#pragma unroll
        for (int u = 0; u < 4; ++u)
#pragma unroll
            for (int r = 0; r < 16; ++r) { const int c = 32 * u + crow(r, hi); p[u][r] = c < n_adm ? p[u][r] : NEG_INF; rm = fmaxf(rm, p[u][r]); }
        rm = fmaxf(rm, __shfl_xor(rm, 32));
        const float mc = rm > NEG_INF ? rm : 0.f; float s = 0.f;
#pragma unroll
        for (int u = 0; u < 4; ++u)
#pragma unroll
            for (int r = 0; r < 16; ++r) { p[u][r] = ex2(p[u][r] - mc); s += p[u][r]; }
        s += __shfl_xor(s, 32);
        const float inv = 1.f / fmaxf(s, 1e-30f);
#pragma unroll
        for (int u = 0; u < 4; ++u)
#pragma unroll
            for (int r = 0; r < 16; ++r) p[u][r] *= inv;
        float xl[16];
#pragma unroll
        for (int u = 0; u < 4; ++u)
#pragma unroll
            for (int k = 0; k < 4; ++k) xl[u * 4 + k] = __shfl_xor(p[u][4 * k + 3], 32);
#pragma unroll
        for (int u = 0; u < 4; ++u)
#pragma unroll
            for (int k = 0; k < 4; ++k) {
                const float A = (p[u][4 * k] + p[u][4 * k + 1]) + (p[u][4 * k + 2] + p[u][4 * k + 3]);
                const float xprev = (u * 4 + k) > 0 ? xl[(u * 4 + k) > 0 ? u * 4 + k - 1 : 0] : 0.f;
                const float val = A + (hi ? xl[u * 4 + k] : xprev);
                slab[(w * 32 + r32) * 33 + 8 * u + 2 * k + hi] = val;
            }
        u32x4 pw[4]; o[0] = f32x16{}; o[1] = f32x16{};
        pack_p(pw, p[0], p[1]); pv(o, slot0 + 16384 + g * 8192, lane, hi, pw);
        pack_p(pw, p[2], p[3]); pv(o, slot1 + 16384 + g * 8192, lane, hi, pw);
        __syncthreads();
#pragma unroll
        for (int i = 0; i < 4; ++i) { const int e = tid + i * NT, j = e & 31, q = (e >> 5) & 31, gg = e >> 10;
            float v = ((slab[((gg * 4 + 0) * 32 + q) * 33 + j] + slab[((gg * 4 + 1) * 32 + q) * 33 + j]) + slab[((gg * 4 + 2) * 32 + q) * 33 + j]) + slab[((gg * 4 + 3) * 32 + q) * 33 + j];
            const int cur = (qt * 32 + q) >> 6;
            if (j == 0 || j == cur || j == cur - 1) v = 1.0e4f;
            if (j > cur) v = -1.0f;
            impf[e] = v; }
        __syncthreads();
#pragma unroll
        for (int i = 0; i < 4; ++i) { const int gq = i * 16 + (tid >> 5), j = tid & 31; const float v = impf[gq * 32 + j]; int rk = 0;
#pragma unroll
            for (int i2 = 0; i2 < 32; ++i2) { const float vi = impf[gq * 32 + i2]; rk += (vi > v || (vi == v && i2 < j)) ? 1 : 0; }
            const unsigned long long bal = __ballot(rk < SLC_COUNT);
            if ((tid & 31) == 0) selmask[gq] = (lane < 32) ? (unsigned)bal : (unsigned)(bal >> 32); }
        __syncthreads();
        accum_out<true>(OUTw, o, gate0, wsf, r32, hi);
    }
    TOC(13); TIC(14);
    const int T0 = (qt * 32 - 511) > 0 ? ((qt * 32 - 511) >> 6) : 0, T1 = qt >> 1;
    {
        struct SlcMask { unsigned sel; int tq, hi, last;
            __device__ __forceinline__ void operator()(f32x16& c0, f32x16& c1, int t, float negm) const { cinit_splat(c0, negm); cinit_splat(c1, negm); }
            __device__ __forceinline__ void post(f32x16& p0, f32x16& p1, int t) const { const bool on = (sel >> t) & 1u;
                if (t == last) { const int lim = on ? tq - t * 64 - 4 * hi : -1;
#pragma unroll
                    for (int r = 0; r < 16; ++r) { p0[r] = (crow(r, 0) <= lim) ? p0[r] : NEG_INF; p1[r] = (crow(r, 0) + 32 <= lim) ? p1[r] : NEG_INF; }
                } }
            __device__ __forceinline__ bool lane_off(int t) const { return t != last && !((sel >> t) & 1u); } };
        const int ntile = (qt >> 1) + 1;
        sg.kbase = ab + C_KSL; sg.vbase = ab + C_VSL; sg.kafter = ab + C_KWN; sg.vafter = ab + C_VWN; sg.key_after = T0 * 64;
        SlcMask mk{selmask[g * 32 + r32], tq, hi, ntile - 1}; const float gate1 = bf2f(gp[1]);
        float m = 0.f, l = 0.f; o[0] = f32x16{}; o[1] = f32x16{};
        flash_loop_b(0, ntile, sg, mk, qf, slot0 + g * 8192, slot0 + 16384 + g * 8192, 32768, m, l, o, wsf, lane, r32, hi, true);
        const float ltot = l + __shfl_xor(l, 32);
        accum_out<false>(OUTw, o, gate1 / fmaxf(ltot, 1e-30f), wsf, r32, hi);
    }
    TOC(14); TIC(15);
    {
        struct WinMask { int tq, hi, qt;
            __device__ __forceinline__ void operator()(f32x16& c0, f32x16& c1, int t, float negm) const { cinit_splat(c0, negm); cinit_splat(c1, negm); }
            __device__ __forceinline__ void post(f32x16& p0, f32x16& p1, int t) const {
                if (t * 64 < qt * 32 - 480 || t * 64 + 63 > qt * 32) { const int lim = tq - t * 64 - 4 * hi;
#pragma unroll
                    for (int r = 0; r < 16; ++r) {
                        p0[r] = ((unsigned)(lim - crow(r, 0)) < (unsigned)WINDOW) ? p0[r] : NEG_INF; p1[r] = ((unsigned)(lim - crow(r, 0) - 32) < (unsigned)WINDOW) ? p1[r] : NEG_INF; }
                } }
            __device__ __forceinline__ bool lane_off(int) const { return false; } };
        sg.kbase = ab + C_KWN; sg.vbase = ab + C_VWN; sg.kafter = nullptr; sg.vafter = nullptr;
        WinMask mk{tq, hi, qt}; const float gate2 = bf2f(gp[2]);
        float m = 0.f, l = 0.f; o[0] = f32x16{}; o[1] = f32x16{};
        flash_loop_b(T0, T1 - T0 + 1, sg, mk, qf, slot0 + g * 8192, slot0 + 16384 + g * 8192, 32768, m, l, o, wsf, lane, r32, hi, true);
        const float ltot = l + __shfl_xor(l, 32);
        accum_out<false>(OUTw, o, gate2 / fmaxf(ltot, 1e-30f), wsf, r32, hi);
    }
    KvStage pre0, pre1;
    {
        const unsigned rn = (unsigned)__builtin_amdgcn_readfirstlane((int)*nextp); const int next_b = (rn < 2048u && (rn & 2u) != 0u) ? (int)(2u * (rn >> 8) + (rn & 1u)) : -1;
        prefetched = next_b >= 0;
        if (next_b >= 0) { const bf16* kcn = kcb + (size_t)next_b * 128 * 128; const bf16* vcn = kcb + (size_t)(BATCH + next_b) * 128 * 128;
            kv_load(pre0, kcn, vcn, 128, 0, w, lane); kv_load(pre1, kcn, vcn, 128, 64, w, lane); }
    }
    TOC(15); TIC(16);
    float ss = 0.f;
    { const LAS f32x4* rowp = (const LAS f32x4*)(OUTw + (lane >> 1) * 64 + (lane & 1) * 32);
      const int qs = (lane >> 1) & 7;
#pragma unroll
      for (int i = 0; i < 8; ++i) { const f32x4 v = rowp[i ^ qs]; ss += (v[0] * v[0] + v[1] * v[1]) + (v[2] * v[2] + v[3] * v[3]); }
      ss += __shfl_xor(ss, 1); }
    if ((lane & 1) == 0) rowsq[w * 32 + (lane >> 1)] = ss;
    if (prefetched) { kv_store(pre0, slot0, w, lane); kv_store(pre1, slot1, w, lane); }
    __syncthreads();
    float tot = 0.f;
#pragma unroll
    for (int h = 0; h < 8; ++h) tot += rowsq[h * 32 + (lane >> 1)];
    const float rinv = rsqrtf(tot * (1.f / 512.f) + LN_EPS);
    store_o(OUTw, rinv, mix_gain + 512 + w * 64, MIXED_F8 ? (bf16*)((unsigned char*)mixed + ((size_t)b * SEQ + qt * 32 + (lane >> 1)) * D_MODEL + 512 + w * 64) : mixed + ((size_t)b * SEQ + qt * 32 + (lane >> 1)) * D_MODEL + 512 + w * 64, lane);
    __syncthreads();
    TOC(16);
}
}
struct Args { const float* in[16]; float* out; unsigned char* ws; int ph_lo, ph_hi, li, pad; };
constexpr int N_PHASES = 8;
__global__ void __launch_bounds__(NT, 2) mk_fwd(Args args) {
    extern __shared__ __attribute__((aligned(16))) unsigned char lds_raw[];
    LAS unsigned char* lds = (LAS unsigned char*)lds_raw;
    volatile LAS unsigned* MISC = (volatile LAS unsigned*)(lds + MISC_OFF);
    const int tid = threadIdx.x, lane = tid & 63, wave = __builtin_amdgcn_readfirstlane(tid >> 6);
    const int G = gridDim.x; const int vcu = (G % 8 == 0) ? ((int)blockIdx.x % 8) * (G / 8) + (int)blockIdx.x / 8 : (int)blockIdx.x;
    unsigned char* ws = args.ws;
    gu32* ctl = (gu32*)(ws + WS_CTL);
    const float* x = args.in[0]; const int* pos = (const int*)args.in[1]; const float* w_in = args.in[2]; const float* b_in = args.in[3];
    const float* cmp_pos = args.in[4]; const float* cmp_w1 = args.in[5]; const float* cmp_w2 = args.in[6]; const float* mix_gain = args.in[7];
    const float* w_out = args.in[8]; const float* ln1_g = args.in[9]; const float* ln1_b = args.in[10]; const float* w_gate = args.in[11];
    const float* w_up = args.in[12]; const float* w_down = args.in[13]; const float* ln2_g = args.in[14]; const float* ln2_b = args.in[15];
    float* out = args.out;
    float* stats1 = (float*)(ws + CTL_STATS1); float* cs = (float*)(ws + CTL_CS); float* bs = cs + 5632;
    float* rope = (float*)(ws + WS_ROPE); float* biasP = (float*)(ws + WS_BIASP);
    bf16* Wt_in = (bf16*)(ws + WS_WIN); bf16* Wt_out = (bf16*)(ws + WS_WOUT); bf16* Wt_gu = (bf16*)(ws + WS_WGU); bf16* Wt_dn = (bf16*)(ws + WS_WDN);
    float* kcvc = (float*)(ws + WS_KC); bf16* kcb = (bf16*)(ws + WS_KCB); bf16* w1t = (bf16*)(ws + WS_W1T); bf16* w2t = (bf16*)(ws + WS_W2T); float* cb1 = (float*)(ws + CTL_CB1);
    bf16* act = (bf16*)(ws + WS_ACT); bf16* actf = (bf16*)(ws + WS_ACTF); bf16* xb = (bf16*)(ws + WS_XB); bf16* mixed = (bf16*)(ws + WS_MIXED); unsigned char* v1q = ws + WS_GCAND; unsigned char* actq = ws + WS_ACTF; unsigned char* xq = ws + WS_V1B; unsigned char* Wq_in = ws + WS_WINQ;
    bf16* v1b = (bf16*)(ws + WS_V1B); bf16* v2b = (bf16*)(ws + WS_MIXED);

    for (int u = tid; u < (LDS_BYTES - LDSCTL_OFF) / 4; u += NT) ((LAS unsigned*)(lds + LDSCTL_OFF))[u] = 0u;
    __syncthreads();
#if PROBE_T >= 0
    if (blockIdx.x == 0 && tid == 0) t_acc = 0ull;
#endif
    XcdBarrier bar = xcd_barrier_post((unsigned*)(ctl + CW_BAR) + args.li * XCD_BAR_WORDS, MISC + 8);
    const int lo = args.ph_lo, hi = args.ph_hi;
#if PROBE_T == 71
    const unsigned long long k_t0 = __builtin_amdgcn_s_memrealtime();
#endif
#if PROBE_T == 70
    if (tid == 0 && ((unsigned)blockIdx.x & 7u) != (bar.x & 7u)) __hip_atomic_fetch_add(ctl + 8204, 1u, RLX_AGENT);
#endif
#ifndef PROBE_DUP
#define PROBE_DUP -1
#endif
#define NREP(k) ((PROBE_DUP == (k)) ? 2 : 1)
#define IN(k) (lo <= (k) && (k) < hi)
#define SEAM(k) do { if (IN(k) && IN((k) + 1)) { TIC(8); TIC(60 + (k)); xcd_barrier(bar); TOC(60 + (k)); TOC(8); } } while (0)

    TIC(0);
    if (IN(0)) for (int rep = 0; rep < NREP(0); ++rep) {
        float* cs_ = (rep == NREP(0) - 1) ? cs : nullptr;
        const int gw = vcu * NWAVES + wave, NGW = G * NWAVES;
        constexpr int I_IN = 16 * 36, I_OUT = 16 * 16, I_GU = 16 * 88, I_DN = 44 * 16, I_W1 = 2 * 64, I_W2 = 2 * 2, I_INQ = INPROJ_F8 ? 16 * 16 : 0, NITEMS = I_IN + I_OUT + I_GU + I_DN + I_W1 + I_W2 + I_INQ;
        TIC(30);
        for (int it = wave * G + vcu + (TAIL_FILL ? I_GU + I_DN : 0); it < NITEMS; it += NGW) {
            int r = it;
            if (r < I_GU) { const int kb = r / 88, nb = r % 88, n0 = 64 * nb, pn = n0 >> 8, within = n0 & 255; const bool isup = within >= 128;
                tr64<true>(isup ? w_up : w_gate, FFN, 1024, Wt_gu, n0, 64 * kb, pn * 128 + (within & 127) + lane, ln1_g, S_GU, ln1_b, cs_, cs_ ? bs : nullptr, lane); continue; } r -= I_GU;
            if (r < I_DN) { const int kb = r / 16, nb = r % 16; tr64<true>(w_down, 1024, FFN, Wt_dn, 64 * nb, 64 * kb, 64 * nb + lane, nullptr, S_DN, nullptr, nullptr, nullptr, lane); continue; } r -= I_DN;
            if (r < I_IN) { const int kb = r / 36, nb = r % 36; if (INPROJ_F8 && ((0xC3u >> (nb >> 2)) & 1u)) continue;
                tr64<false>(w_in, IN_COLS, 1024, Wt_in, 64 * nb, 64 * kb, orig_col(64 * nb + lane), nullptr, 1.f, nullptr, nullptr, nullptr, lane); continue; } r -= I_IN;
            if (r < I_OUT) { if (TAIL_FILL) continue; const int kb = r / 16, nb = r % 16; if (MIXED_F8) tr64<true>(w_out, 1024, 1024, Wt_out, 64 * nb, 64 * kb, 64 * nb + lane, nullptr, S_OUT, nullptr, nullptr, nullptr, lane); else tr64<false>(w_out, 1024, 1024, Wt_out, 64 * nb, 64 * kb, 64 * nb + lane, nullptr, 1.f, nullptr, nullptr, nullptr, lane); continue; } r -= I_OUT;
            if (r < I_W1) { const int kv = r >> 6, kb = (r >> 1) & 31, nb = r & 1;
                tr64<false, true>(cmp_w1 + (size_t)kv * 2048 * 128, 128, 2048, w1t + (size_t)kv * 128 * 2048, 64 * nb, 64 * kb, 64 * nb + lane, nullptr, 1.f, cmp_pos + kv * 2048, nullptr, cs_ ? cb1 + kv * 128 : nullptr, lane); continue; } r -= I_W1;
            if (r < I_W2) { const int kv = r >> 1, kb = r & 1; tr64<false>(cmp_w2 + (size_t)kv * 128 * 64, 64, 128, w2t + (size_t)kv * 64 * 128, 0, 64 * kb, lane, nullptr, 1.f, nullptr, nullptr, nullptr, lane); continue; } r -= I_W2;
            { const int kb = r >> 4, nq = r & 15, tile = (nq >> 2) < 2 ? (nq >> 2) : (nq >> 2) + 4, n0 = tile * 256 + 64 * (nq & 3);
              tr64<true>(w_in, IN_COLS, 1024, Wq_in, n0, 64 * kb, orig_col(n0 + lane), nullptr, S_IN, nullptr, nullptr, nullptr, lane); }
        }
        TOC(30); TIC(31);
        for (int m0 = gw * 4; m0 < T; m0 += NGW * 4) {
            f32x4 v[4][2][2];
#pragma unroll
            for (int rr = 0; rr < 4; ++rr)
#pragma unroll
                for (int j = 0; j < 2; ++j) { const GAS f32x4* xr = (const GAS f32x4*)(x + (size_t)(m0 + rr) * 1024 + 512 * j) + 2 * lane; v[rr][j][0] = xr[0]; v[rr][j][1] = xr[1]; }
#pragma unroll
            for (int rr = 0; rr < 4; ++rr)
#pragma unroll
                for (int j = 0; j < 2; ++j) { v4u o; o.x = pk2(v[rr][j][0].x, v[rr][j][0].y); o.y = pk2(v[rr][j][0].z, v[rr][j][0].w); o.z = pk2(v[rr][j][1].x, v[rr][j][1].y); o.w = pk2(v[rr][j][1].z, v[rr][j][1].w);
                    *((GAS v4u*)(xb + (size_t)(m0 + rr) * 1024 + 512 * j) + lane) = o;
                    if (INPROJ_F8) { typedef unsigned u2_t __attribute__((ext_vector_type(2)));
                        int p0 = __builtin_amdgcn_cvt_pk_fp8_f32(v[rr][j][0].x, v[rr][j][0].y, 0, false); p0 = __builtin_amdgcn_cvt_pk_fp8_f32(v[rr][j][0].z, v[rr][j][0].w, p0, true);
                        int p1 = __builtin_amdgcn_cvt_pk_fp8_f32(v[rr][j][1].x, v[rr][j][1].y, 0, false); p1 = __builtin_amdgcn_cvt_pk_fp8_f32(v[rr][j][1].z, v[rr][j][1].w, p1, true);
                        *((GAS u2_t*)(xq + (size_t)(m0 + rr) * 1024 + 512 * j) + lane) = u2_t{(unsigned)p0, (unsigned)p1}; } }
        }
        TOC(31); TIC(32);
        for (int i = gw * 64 + lane; i < T * 8; i += NGW * 64) {
            const float inv[8] = {1.0f, 0.19392274474868576f, 0.03760603093086393f, 0.007292664737217109f, 0.001414213562373095f, 0.0002742481756762073f, 5.318295896944988e-05f, 1.031338537721246e-05f};
            const int t = i >> 3, j = i & 7; float sn, cn; sincosf((float)pos[t] * inv[j], &sn, &cn);
            rope[2 * i] = cn; rope[2 * i + 1] = sn;
        }
        for (int i = gw * 64 + lane; i < ACT_COLS; i += NGW * 64) { const int oc = orig_col(i); biasP[i] = oc >= 0 ? b_in[oc] : 0.f; }
        TOC(32);
    }
    TOC(0);
    SEAM(0);
    TIC(1);
    if (IN(1)) for (int rep = 0; rep < NREP(1); ++rep) {
        if constexpr (INPROJ_F8) {
            { pg8::Gemm g{xb, Wt_in, T, ACT_COLS, 1024}; pg8::SubOrderB S; S.init(T, G, (int)blockIdx.x);
              pg8::EpiInProj E{act, biasP, rope, att::C2, 1.f, (bf16*)(ws + WS_KVC)};
              pg8::gemm_phase<pg8::EpiInProj, pg8::SubOrderB, true, true>(lds, g, S, E); }
            { pg8::Gemm g{(const bf16*)xq, (const bf16*)Wq_in, T, ACT_COLS, 1024}; pg8::SubOrderQ S{G, (int)blockIdx.x};
              pg8::EpiInProj E{act, biasP, rope, att::C2, 1.f / S_IN, (bf16*)(ws + WS_KVC)};
              pg8::gemm_phase<pg8::EpiInProj, pg8::SubOrderQ, true, true, true>(lds, g, S, E); }
        } else {
            pg8::Gemm g{xb, Wt_in, T, ACT_COLS, 1024}; pg8::StaticOrder S; S.init(T, ACT_COLS, G, (int)blockIdx.x);
            pg8::EpiInProj E{act, biasP, rope, att::C2, 1.f, (bf16*)(ws + WS_KVC)};
            pg8::gemm_phase<pg8::EpiInProj, pg8::StaticOrder, true, true>(lds, g, S, E);
        }
    }
    TOC(1);
    SEAM(1);
#if PROBE_T == 50 || PROBE_T == 52
    unsigned long long sp_t0 = __builtin_amdgcn_s_memrealtime();
#endif
    TIC(2);
    if (IN(2)) for (int rep = 0; rep < NREP(2); ++rep) {
        gu32* cmp_cnt = ctl + 8192;
        TIC(10);
        for (int u = vcu; u < 256; u += G) cmp::compress_unit(lds, (const bf16*)(ws + WS_KVC), w1t, w2t, cb1, kcb, nullptr, u);
        TOC(10); TIC(19);
        xcd_barrier(bar);
        (void)cmp_cnt;
        TOC(19);
        att::DsaCand* gcand = (att::DsaCand*)(ws + WS_GCAND) + (size_t)blockIdx.x * 32 * SEQ;
        float* gidx = (float*)(ws + WS_V1B) + (size_t)blockIdx.x * 65536;
        gu32* qhead = ctl + 8320;
        unsigned curq = bar.x & 7u;
#define DRAW_UNIT(dst) do { unsigned u_ = 0xFFFFFFFFu; for (int t_ = 0; t_ < 8; ++t_) { const unsigned r_ = __hip_atomic_fetch_add(qhead + 64 * curq, 1u, RLX_AGENT); if (r_ < 256u) { u_ = curq * 256u + r_; break; } curq = (curq + 1u) & 7u; } (dst) = u_; } while (0)
        if (tid == 0) DRAW_UNIT(MISC[12]);
        __syncthreads();
        for (int k = 0;;) {
            unsigned u = (unsigned)__builtin_amdgcn_readfirstlane((int)MISC[12 + (k & 1)]);
            if (u >= 2048u) break;
            TIC(17); if (tid == 0) DRAW_UNIT(MISC[12 + ((k + 1) & 1)]); TOC(17);
            if ((u & 2u) == 0u) { att::dsa_unit(lds, act, mix_gain, mixed, gcand, gidx, (int)(2u * (u >> 8) + (u & 1u)), 63 - (int)((u & 255u) >> 2)); ++k; continue; }
            bool pre_valid = false;
            for (;;) {
                bool pf = false; att::nsa_unit(lds, act, kcb, mix_gain, mixed, (int)(2u * (u >> 8) + (u & 1u)), 63 - (int)((u & 255u) >> 2), pre_valid, MISC + 12 + ((k + 1) & 1), pf);
                ++k;
                if (!pf) break;
                u = (unsigned)__builtin_amdgcn_readfirstlane((int)MISC[12 + (k & 1)]); pre_valid = true;
                TIC(17); if (tid == 0) DRAW_UNIT(MISC[12 + ((k + 1) & 1)]); TOC(17);
            }
        }
#undef DRAW_UNIT
#if PROBE_T == 52
        if (tid == 0) { const unsigned long long d = __builtin_amdgcn_s_memrealtime() - sp_t0; atomicMax((unsigned long long*)(ctl + 8200), d); atomicMax((unsigned long long*)(ctl + 8202), 1000000000ull - d); }
#endif
        TIC(18);
        if (TAIL_FILL) {
            gu32* fhead = ctl + 8832; float* cs_ = (rep == NREP(2) - 1) ? cs : nullptr;
            constexpr int I_GU = 16 * 88, I_DN = 44 * 16, I_OUT = 16 * 16;
            for (;;) {
                __syncthreads();
                if (tid == 0) MISC[14] = __hip_atomic_fetch_add(fhead, 1u, RLX_AGENT);
                __syncthreads();
                const unsigned ch = (unsigned)__builtin_amdgcn_readfirstlane((int)MISC[14]);
                if (ch >= (unsigned)((I_GU + I_DN + I_OUT) / 8)) break;
                int r = (int)ch * 8 + wave;
                if (r < I_GU) { const int kb = r / 88, nb = r % 88, n0 = 64 * nb, pn = n0 >> 8, within = n0 & 255; const bool isup = within >= 128;
                    tr64<true>(isup ? w_up : w_gate, FFN, 1024, Wt_gu, n0, 64 * kb, pn * 128 + (within & 127) + lane, ln1_g, S_GU, ln1_b, cs_, cs_ ? bs : nullptr, lane); continue; } r -= I_GU;
                if (r < I_DN) { const int kb = r / 16, nb = r % 16; tr64<true>(w_down, 1024, FFN, Wt_dn, 64 * nb, 64 * kb, 64 * nb + lane, nullptr, S_DN, nullptr, nullptr, nullptr, lane); continue; } r -= I_DN;
                { const int kb = r / 16, nb = r % 16; if (MIXED_F8) tr64<true>(w_out, 1024, 1024, Wt_out, 64 * nb, 64 * kb, 64 * nb + lane, nullptr, S_OUT, nullptr, nullptr, nullptr, lane); else tr64<false>(w_out, 1024, 1024, Wt_out, 64 * nb, 64 * kb, 64 * nb + lane, nullptr, 1.f, nullptr, nullptr, nullptr, lane); }
            }
        }
        TOC(18);
    }
    TOC(2);
#if PROBE_T == 50
    if (tid == 0) { const unsigned long long d = __builtin_amdgcn_s_memrealtime() - sp_t0; atomicMax((unsigned long long*)(ctl + 8200), d); atomicMax((unsigned long long*)(ctl + 8202), 1000000000ull - d); }
#endif
    SEAM(3);
    TIC(4);
    if (IN(4)) for (int rep = 0; rep < NREP(4); ++rep) {
        pg8::Gemm g{mixed, Wt_out, T, 1024, 1024}; pg8::StaticOrder S; S.init(T, 1024, G, (int)blockIdx.x);
        pg8::EpiOutProj E{xb, v1b, v1q, (rep == NREP(4) - 1) ? stats1 : nullptr, ALPHA, MIXED_F8 ? 1.f / S_OUT : 1.f};
        if constexpr (MIXED_F8) pg8::gemm_phase<pg8::EpiOutProj, pg8::StaticOrder, true, true, true>(lds, g, S, E); else pg8::gemm_phase<pg8::EpiOutProj, pg8::StaticOrder, true, true>(lds, g, S, E);
    }
    TOC(4);
    SEAM(4);
    TIC(5);
    if (IN(5)) for (int rep = 0; rep < NREP(5); ++rep) {
        pg8::Gemm g{(const bf16*)v1q, Wt_gu, T, 2 * FFN, 1024}; pg8::StaticOrder S; S.init(T, 2 * FFN, G, (int)blockIdx.x);
        pg8::EpiGateUp E{actf, actq, stats1, cs, bs, 1.f / S_GU, lds + 135168};
        pg8::gemm_phase<pg8::EpiGateUp, pg8::StaticOrder, true, true, true>(lds, g, S, E);
    }
    TOC(5);
#if PROBE_T == 40
    { xcd_barrier(bar); TIC(40);
      pg8::Gemm g{(const bf16*)v1q, Wt_gu, T, 2 * FFN, 1024}; pg8::StaticOrder S; S.init(T, 2 * FFN, G, (int)blockIdx.x);
      pg8::EpiNull E{(float*)(ws + WS_MIXED)};
      pg8::gemm_phase<pg8::EpiNull, pg8::StaticOrder, true, true, true>(lds, g, S, E); TOC(40); }
#endif
    SEAM(5);
    TIC(6);
    if (IN(6)) for (int rep = 0; rep < NREP(6); ++rep) {
        pg8::Gemm g{(const bf16*)actq, Wt_dn, T, 1024, FFN}; pg8::StaticOrder S; S.init(T, 1024, G, (int)blockIdx.x);
#ifdef NO_LN2_FUSE
        pg8::EpiDown E{v1b, v2b, stats1, ln1_g, ln1_b, ALPHA, 1.f / S_DN};
        pg8::gemm_phase<pg8::EpiDown, pg8::StaticOrder, true, true, true>(lds, g, S, E);
#else
        pg8::RowStatsX rx{(unsigned long long*)(ws + WS_XCH), (unsigned*)(ctl + 16384), lds + 135168, LN_EPS};
        pg8::EpiDownLn E{v1b, out, stats1, ln1_g, ln1_b, ln2_g, ln2_b, ALPHA, 1.f / S_DN, rx};
        pg8::gemm_phase<pg8::EpiDownLn, pg8::StaticOrder, true, true, true>(lds, g, S, E);
#endif
    }
    TOC(6);
#ifdef NO_LN2_FUSE
    SEAM(6);
#endif
    TIC(7);
#ifdef NO_LN2_FUSE
    if (IN(7)) for (int rep = 0; rep < NREP(7); ++rep) {
        const int gw = vcu * NWAVES + wave, NGW = G * NWAVES;
        for (int m = gw; m < T; m += NGW) {
            const GAS v4u* xr = (const GAS v4u*)(v2b + (size_t)m * 1024) + lane; GAS f32x4* xw = (GAS f32x4*)(out + (size_t)m * 1024) + 2 * lane; f32x4 v[4]; float s = 0.f;
#pragma unroll
            for (int j = 0; j < 2; ++j) { const v4u t = xr[64 * j];
                v[2 * j] = f32x4{__uint_as_float(t[0] << 16), __uint_as_float(t[0] & 0xffff0000u), __uint_as_float(t[1] << 16), __uint_as_float(t[1] & 0xffff0000u)};
                v[2 * j + 1] = f32x4{__uint_as_float(t[2] << 16), __uint_as_float(t[2] & 0xffff0000u), __uint_as_float(t[3] << 16), __uint_as_float(t[3] & 0xffff0000u)}; }
#pragma unroll
            for (int j = 0; j < 4; ++j) s += (v[j].x + v[j].y) + (v[j].z + v[j].w);
            const float mean = wave_sum(s) * (1.f / 1024.f); float s2 = 0.f;
#pragma unroll
            for (int j = 0; j < 4; ++j) { v[j] = v[j] - mean; s2 += (v[j].x * v[j].x + v[j].y * v[j].y) + (v[j].z * v[j].z + v[j].w * v[j].w); }
            const float rstd = rsqrtf(wave_sum(s2) * (1.f / 1024.f) + LN_EPS);
#pragma unroll
            for (int j = 0; j < 4; ++j) { const int ci = 2 * lane + (j & 1) + 128 * (j >> 1);
                const f32x4 gg = *((const f32x4*)ln2_g + ci), bb = *((const f32x4*)ln2_b + ci); xw[(j & 1) + 128 * (j >> 1)] = v[j] * rstd * gg + bb; }
        }
    }
#endif
    TOC(7);
#if PROBE_T == 50 || PROBE_T == 52
    if (blockIdx.x == 0 && tid == 0) { const unsigned long long mx = __hip_atomic_load((unsigned long long*)(ctl + 8200), RLX_AGENT), mn = 1000000000ull - __hip_atomic_load((unsigned long long*)(ctl + 8202), RLX_AGENT); t_acc = mx - mn; }
#endif
#if PROBE_T == 71
    if (blockIdx.x == 0 && tid == 0) t_acc = __builtin_amdgcn_s_memrealtime() - k_t0;
#endif
#if PROBE_T == 70
    if (blockIdx.x == 0 && tid == 0) t_acc = 100ull * __hip_atomic_load(ctl + 8204, RLX_AGENT);
#endif
#if PROBE_T >= 0
    if (blockIdx.x == 0 && tid == 0) { const unsigned long long t0 = __builtin_amdgcn_s_memrealtime(); while (__builtin_amdgcn_s_memrealtime() - t0 < t_acc) __builtin_amdgcn_s_sleep(8); }
#endif
#undef IN
#undef SEAM
}

extern "C" void kernel_launch(void* const* d_in, const int* in_sizes, int n_in, void* d_out, int out_size, void* d_ws, size_t ws_size, hipStream_t stream) {
    static int grid = 0;
    if (grid == 0) {
        if (n_in != 16 || in_sizes[0] != T * D_MODEL || out_size != T * D_MODEL || ws_size < WS_NEED) { fprintf(stderr, "kernel_launch: unexpected shapes / workspace (%d inputs, ws %zu); nothing launched\n", n_in, ws_size); grid = -1; return; }
        int dev = 0, cus = 0, per_cu = 0;
        if (hipGetDevice(&dev) != hipSuccess || hipDeviceGetAttribute(&cus, hipDeviceAttributeMultiprocessorCount, dev) != hipSuccess) { grid = -1; return; }
        if (hipFuncSetAttribute((const void*)mk_fwd, hipFuncAttributeMaxDynamicSharedMemorySize, LDS_BYTES) != hipSuccess) { fprintf(stderr, "kernel_launch: hipFuncSetAttribute failed\n"); grid = -1; return; }
        if (hipOccupancyMaxActiveBlocksPerMultiprocessor(&per_cu, (const void*)mk_fwd, NT, LDS_BYTES) != hipSuccess || per_cu < 1) { fprintf(stderr, "kernel_launch: occupancy query says %d blocks per CU; nothing launched\n", per_cu); (void)hipGetLastError(); grid = -1; return; }
        grid = cus;
    }
    if (grid < 0) return;
    if (hipMemsetAsync((char*)d_ws + WS_CTL, 0, CTL_ZERO_BYTES, stream) != hipSuccess) return;
    Args a{};
    for (int i = 0; i < 16; ++i) a.in[i] = (const float*)d_in[i];
    a.out = (float*)d_out; a.ws = (unsigned char*)d_ws;
#if MK_N_LAUNCHES == 1
    a.ph_lo = 0; a.ph_hi = N_PHASES; a.li = 0;
    hipLaunchKernelGGL(mk_fwd, dim3(grid), dim3(NT), LDS_BYTES, stream, a);
#else
    for (int p = 0; p < N_PHASES; ++p) { a.ph_lo = p; a.ph_hi = p + 1; a.li = 0; hipLaunchKernelGGL(mk_fwd, dim3(grid), dim3(NT), LDS_BYTES, stream, a); }
#endif
}
```
